# Optimizing an MI355X kernel written in HIP

```python
import math
import jax, jax.numpy as jnp
from jax import lax
import numpy as np

D_MODEL = 1024
BATCH = 8
SEQ = 2048
DEPTH = 1
DEC_BATCH = 8
DEC_SEQ = 64
PAST_LEN = 2048

CHUNK = 64
N_META = 16
MIX_W = D_MODEL
ATT_W = MIX_W // 2
HEAD_DIM = 64
N_HEADS = ATT_W // HEAD_DIM
KV_HEADS = 2
GQA_GROUP = N_HEADS // KV_HEADS
WINDOW = 128
N_BACK = WINDOW // CHUNK
BAND = (N_BACK + 1) * CHUNK
N_BUCKETS = 32
MAX_DISTANCE = 128
RET_W = MIX_W - ATT_W
RET_HEADS = 4
RET_DK = RET_W // RET_HEADS
RET_DV = RET_W // RET_HEADS
ROPE_BASE = 10000.0
PROJ_SPLITS = (ATT_W, KV_HEADS * HEAD_DIM, KV_HEADS * HEAD_DIM, RET_W, RET_W, RET_W, RET_W)
PROJ_W = sum(PROJ_SPLITS)
N_KEYS = 128
N_EXPERTS = N_KEYS * N_KEYS
PEER_HEADS = 8
PEER_TOPK = 16
PEER_DK = 128
PEER_DK_HALF = PEER_DK // 2
PEER_BLOCK = 256
ALPHA = (2.0 * DEPTH) ** 0.25
BETA = (8.0 * DEPTH) ** -0.25
LN_EPS = 1e-5
NEG_INF = -1e30

kernel_name = 'hymba_swa_retention_peer_stream_step'


def layer_norm(x, g, b):
    xf = x.astype(jnp.float32)
    mu = xf.mean(-1, keepdims=True)
    var = jnp.square(xf - mu).mean(-1, keepdims=True)
    y = (xf - mu) * lax.rsqrt(var + LN_EPS) * g.astype(jnp.float32) + b.astype(jnp.float32)
    return y.astype(x.dtype)


def t5_bucket(rel):
    nb = N_BUCKETS // 2
    max_exact = nb // 2
    n = jnp.abs(rel)
    large = max_exact + (jnp.log(jnp.maximum(n, max_exact).astype(jnp.float32) / max_exact)
                         / math.log(MAX_DISTANCE / max_exact) * (nb - max_exact)).astype(jnp.int32)
    large = jnp.minimum(large, nb - 1)
    return jnp.where(rel > 0, nb, 0) + jnp.where(n < max_exact, n, large)


def rel_bias_lookup(rel_bias, rel_np):
    return rel_bias[t5_bucket(jnp.asarray(rel_np, jnp.int32))]


def rotary(x, pos):
    half = x.shape[-1] // 2
    inv = ROPE_BASE ** (-jnp.arange(half, dtype=jnp.float32) / half)
    ang = jnp.asarray(pos, jnp.float32)[:, None] * inv[None, :]
    cos = jnp.cos(ang)[None, :, None, :]
    sin = jnp.sin(ang)[None, :, None, :]
    x1, x2 = x[..., :half], x[..., half:]
    return jnp.concatenate([x1 * cos - x2 * sin, x1 * sin + x2 * cos], axis=-1)


def project(h, w, pos):
    p = jnp.einsum('bsd,de->bse', h, w)
    q, k, v, rq, rk, rv, rg = jnp.split(p, np.cumsum(PROJ_SPLITS)[:-1].tolist(), axis=-1)
    B, L = h.shape[:2]
    q = q.reshape(B, L, KV_HEADS, GQA_GROUP, HEAD_DIM)
    k = k.reshape(B, L, KV_HEADS, HEAD_DIM)
    v = v.reshape(B, L, KV_HEADS, HEAD_DIM)
    rq = rotary(rq.reshape(B, L, RET_HEADS, RET_DK).astype(jnp.float32), pos)
    rk = rotary(rk.reshape(B, L, RET_HEADS, RET_DK).astype(jnp.float32), pos) * (RET_DK ** -0.5)
    rv = rv.reshape(B, L, RET_HEADS, RET_DV).astype(jnp.float32)
    return q, k, v, rq, rk, rv, rg


def sink_attention(q, k, v, bias, mask, sinks):
    s = jnp.einsum('bnqhgd,bnkhd->bnhgqk', q, k, preferred_element_type=jnp.float32) * (HEAD_DIM ** -0.5)
    nb, nq, nk = bias.shape[:3]
    s = s + bias.astype(jnp.float32).reshape(nb, nq, nk, KV_HEADS, GQA_GROUP).transpose(0, 3, 4, 1, 2)[None]
    s = jnp.where(mask[None, :, None, None], s, NEG_INF)
    sink = sinks.astype(jnp.float32).reshape(KV_HEADS, GQA_GROUP)[None, None, :, :, None, None]
    m = jnp.maximum(s.max(-1, keepdims=True), sink)
    p = jnp.exp(s - m)
    denom = p.sum(-1, keepdims=True) + jnp.exp(sink - m)
    return jnp.einsum('bnhgqk,bnkhd->bnqhgd', p / denom, v.astype(jnp.float32))


def prompt_window_attention(q, k, v, mk, mv, rel_bias, sinks):
    B, S = q.shape[:2]
    nC = S // CHUNK
    qb = q.reshape(B, nC, CHUNK, KV_HEADS, GQA_GROUP, HEAD_DIM)
    pad = ((0, 0), (N_BACK * CHUNK, 0), (0, 0), (0, 0))
    kp = jnp.pad(k, pad).reshape(B, nC + N_BACK, CHUNK, KV_HEADS, HEAD_DIM)
    vp = jnp.pad(v, pad).reshape(B, nC + N_BACK, CHUNK, KV_HEADS, HEAD_DIM)
    meta_shape = (B, nC, N_META, KV_HEADS, HEAD_DIM)
    kb = jnp.concatenate([jnp.broadcast_to(mk[:, None], meta_shape)]
                         + [kp[:, j:j + nC] for j in range(N_BACK + 1)], axis=2)
    vb = jnp.concatenate([jnp.broadcast_to(mv[:, None], meta_shape)]
                         + [vp[:, j:j + nC] for j in range(N_BACK + 1)], axis=2)
    i = np.arange(CHUNK)
    jb = np.arange(BAND)
    c = np.arange(nC)
    m = np.arange(N_META)
    rel_meta = m[None, None, :] - (N_META + c[:, None, None] * CHUNK + i[None, :, None])
    rel_band = np.broadcast_to(jb[None, None, :] - N_BACK * CHUNK - i[None, :, None], (nC, CHUNK, BAND))
    rel = np.concatenate([rel_meta, rel_band], axis=-1)
    band_ok = np.broadcast_to((c[:, None, None] - N_BACK) * CHUNK + jb[None, None, :] >= 0, (nC, CHUNK, BAND))
    mask = np.concatenate([np.ones((nC, CHUNK, N_META), dtype=bool), band_ok], axis=-1)
    o = sink_attention(qb, kb, vb, rel_bias_lookup(rel_bias, rel), jnp.asarray(mask), sinks)
    return o.reshape(B, S, ATT_W)


def retention_chunk(state, q, k, v, log_gamma):
    L = q.shape[1]
    idx = jnp.arange(L, dtype=jnp.float32)
    diff = idx[:, None] - idx[None, :]
    decay = jnp.where(diff >= 0, jnp.exp(jnp.maximum(diff, 0.0)[None] * log_gamma[:, None, None]), 0.0)
    s = jnp.einsum('bqhd,bkhd->bhqk', q, k) * decay[None]
    inner = jnp.einsum('bhqk,bkhe->bqhe', s, v)
    q_dec = jnp.exp((idx + 1.0)[:, None] * log_gamma[None, :])
    cross = jnp.einsum('bqhd,bhde->bqhe', q, state) * q_dec[None, :, :, None]
    k_dec = jnp.exp((L - 1.0 - idx)[:, None] * log_gamma[None, :])
    new_state = (jnp.exp(L * log_gamma)[None, :, None, None] * state
                 + jnp.einsum('bkhd,bkhe->bhde', k * k_dec[None, :, :, None], v))
    return inner + cross, new_state


def prompt_retention(rq_m, rk_m, rv_m, rq, rk, rv, log_gamma):
    B, S = rq.shape[:2]
    nC = S // CHUNK
    st0 = jnp.zeros((B, RET_HEADS, RET_DK, RET_DV), jnp.float32)
    o_m, st = retention_chunk(st0, rq_m, rk_m, rv_m, log_gamma)

    def to_chunks(t):
        return t.reshape(B, nC, CHUNK, RET_HEADS, t.shape[-1]).swapaxes(0, 1)

    def step(s, qkv):
        o, s = retention_chunk(s, qkv[0], qkv[1], qkv[2], log_gamma)
        return s, o

    st, o = lax.scan(step, st, (to_chunks(rq), to_chunks(rk), to_chunks(rv)))
    o = o.swapaxes(0, 1).reshape(B, S, RET_HEADS, RET_DV)
    return o_m, o, st


def mix_out(o_att, o_ret, rg, gn_g, w_out):
    mu = o_ret.mean(-1, keepdims=True)
    var = jnp.square(o_ret - mu).mean(-1, keepdims=True)
    y = ((o_ret - mu) * lax.rsqrt(var + LN_EPS)).reshape(o_ret.shape[0], o_ret.shape[1], RET_W)
    y = y * gn_g.astype(jnp.float32) * jax.nn.silu(rg.astype(jnp.float32))
    mixed = jnp.concatenate([o_att, y], axis=-1).astype(rg.dtype)
    return jnp.einsum('bse,ed->bsd', mixed, w_out)


def peer_ffn(x, wq, sub_keys, u_tab, v_tab):
    lead = x.shape[:-1]
    xt = x.reshape(-1, D_MODEL)
    T = xt.shape[0]
    pad = (-T) % PEER_BLOCK
    xt = jnp.pad(xt, ((0, pad), (0, 0))).reshape(-1, PEER_BLOCK, D_MODEL)

    def block(xb):
        q = jnp.einsum('td,de->te', xb, wq).reshape(PEER_BLOCK, PEER_HEADS, 2, PEER_DK_HALF)
        s = jnp.einsum('tpcd,pcnd->tpcn', q, sub_keys, preferred_element_type=jnp.float32)
        s1, i1 = lax.top_k(s[:, :, 0], PEER_TOPK)
        s2, i2 = lax.top_k(s[:, :, 1], PEER_TOPK)
        cand_s = (s1[..., :, None] + s2[..., None, :]).reshape(PEER_BLOCK, PEER_HEADS, PEER_TOPK * PEER_TOPK)
        cand_i = (i1[..., :, None] * N_KEYS + i2[..., None, :]).reshape(PEER_BLOCK, PEER_HEADS, PEER_TOPK * PEER_TOPK)
        top_s, sel = lax.top_k(cand_s, PEER_TOPK)
        eidx = jnp.take_along_axis(cand_i, sel, axis=-1)
        g = jax.nn.softmax(top_s, axis=-1)
        act = jax.nn.gelu(jnp.einsum('tpkd,td->tpk', u_tab[eidx], xb, preferred_element_type=jnp.float32))
        w = (g * act).astype(xb.dtype)
        return jnp.einsum('tpk,tpkd->td', w, v_tab[eidx])

    out = lax.map(block, xt).reshape(-1, D_MODEL)[:T]
    return out.reshape(*lead, D_MODEL)


def post_layer(h, mix, ln1_g, ln1_b, wq, sub_keys, u_tab, v_tab, ln2_g, ln2_b):
    h = layer_norm(ALPHA * h + mix, ln1_g, ln1_b)
    return layer_norm(ALPHA * h + peer_ffn(h, wq, sub_keys, u_tab, v_tab), ln2_g, ln2_b)


def setup_inputs(seed: int = 0) -> dict:
    key = jax.random.key(seed)
    ks = jax.random.split(key, 32)
    f32 = jnp.float32
    nrm = lambda k, shape, scale=1.0: scale * jax.random.normal(k, shape, f32)
    swa_cache = min(WINDOW, PAST_LEN)
    return {
        'x_prompt': nrm(ks[0], (BATCH, SEQ, D_MODEL)),
        'x_sample': nrm(ks[1], (DEC_BATCH, DEC_SEQ, D_MODEL)),
        'cache_meta_k': nrm(ks[2], (DEPTH, DEC_BATCH, N_META, KV_HEADS, HEAD_DIM)),
        'cache_meta_v': nrm(ks[3], (DEPTH, DEC_BATCH, N_META, KV_HEADS, HEAD_DIM)),
        'cache_swa_k': nrm(ks[4], (DEPTH, DEC_BATCH, swa_cache, KV_HEADS, HEAD_DIM)),
        'cache_swa_v': nrm(ks[5], (DEPTH, DEC_BATCH, swa_cache, KV_HEADS, HEAD_DIM)),
        'state_ret': nrm(ks[6], (DEPTH, DEC_BATCH, RET_HEADS, RET_DK, RET_DV), 0.1),
        'meta_tokens': nrm(ks[7], (N_META, D_MODEL)),
        'ln_in_g': 1.0 + nrm(ks[8], (D_MODEL,), 0.02),
        'ln_in_b': nrm(ks[9], (D_MODEL,), 0.02),
        'rel_bias': nrm(ks[10], (N_BUCKETS, N_HEADS), 0.5),
        'w_in': nrm(ks[11], (DEPTH, D_MODEL, PROJ_W), D_MODEL ** -0.5),
        'w_out': nrm(ks[12], (DEPTH, MIX_W, D_MODEL), BETA * MIX_W ** -0.5),
        'attn_sinks': nrm(ks[13], (DEPTH, N_HEADS)),
        'ret_gn_g': 1.0 + nrm(ks[14], (DEPTH, RET_W), 0.02),
        'ln1_g': 1.0 + nrm(ks[15], (DEPTH, D_MODEL), 0.02),
        'ln1_b': nrm(ks[16], (DEPTH, D_MODEL), 0.02),
        'peer_wq': nrm(ks[17], (DEPTH, D_MODEL, PEER_HEADS * PEER_DK), D_MODEL ** -0.5),
        'peer_subkeys': nrm(ks[18], (DEPTH, PEER_HEADS, 2, N_KEYS, PEER_DK_HALF), PEER_DK_HALF ** -0.5),
        'peer_u': nrm(ks[19], (DEPTH, N_EXPERTS, D_MODEL), D_MODEL ** -0.5),
        'peer_v': nrm(ks[20], (DEPTH, N_EXPERTS, D_MODEL), BETA * PEER_HEADS ** -0.5),
        'ln2_g': 1.0 + nrm(ks[21], (DEPTH, D_MODEL), 0.02),
        'ln2_b': nrm(ks[22], (DEPTH, D_MODEL), 0.02),
    }


def reference(x_prompt, x_sample, cache_meta_k, cache_meta_v, cache_swa_k, cache_swa_v, state_ret,
              meta_tokens, ln_in_g, ln_in_b, rel_bias, w_in, w_out, attn_sinks, ret_gn_g, ln1_g, ln1_b,
              peer_wq, peer_subkeys, peer_u, peer_v, ln2_g, ln2_b):
    log_gamma = jnp.log(1.0 - 2.0 ** (-5.0 - jnp.arange(RET_HEADS, dtype=jnp.float32)))
    B, S, _ = x_prompt.shape
    DB, DS, _ = x_sample.shape
    pos_meta = np.arange(N_META)
    pos_p = N_META + np.arange(S)
    pos_s = N_META + PAST_LEN + np.arange(DS)

    h_meta = layer_norm(jnp.broadcast_to(meta_tokens.astype(x_prompt.dtype), (B, N_META, D_MODEL)), ln_in_g, ln_in_b)
    h = layer_norm(x_prompt, ln_in_g, ln_in_b)
    meta_k_l, meta_v_l, swa_k_l, swa_v_l, ret_l = [], [], [], [], []
    for l in range(DEPTH):
        ffn_p = (ln1_g[l], ln1_b[l], peer_wq[l], peer_subkeys[l], peer_u[l], peer_v[l], ln2_g[l], ln2_b[l])
        qm, km, vm, rqm, rkm, rvm, rgm = project(h_meta, w_in[l], pos_meta)
        q, k, v, rq, rk, rv, rg = project(h, w_in[l], pos_p)
        o_att = prompt_window_attention(q, k, v, km, vm, rel_bias, attn_sinks[l])
        o_ret_m, o_ret, st = prompt_retention(rqm, rkm, rvm, rq, rk, rv, log_gamma)
        h_next = post_layer(h, mix_out(o_att, o_ret, rg, ret_gn_g[l], w_out[l]), *ffn_p)
        if l < DEPTH - 1:
            bias_m = rel_bias_lookup(rel_bias, (pos_meta[None, :] - pos_meta[:, None])[None])
            o_att_m = sink_attention(qm[:, None], km[:, None], vm[:, None], bias_m,
                                     jnp.ones((1, N_META, N_META), dtype=bool), attn_sinks[l]).reshape(B, N_META, ATT_W)
            h_meta = post_layer(h_meta, mix_out(o_att_m, o_ret_m, rgm, ret_gn_g[l], w_out[l]), *ffn_p)
        meta_k_l.append(km)
        meta_v_l.append(vm)
        swa_k_l.append(k[:, S - WINDOW:])
        swa_v_l.append(v[:, S - WINDOW:])
        ret_l.append(st)
        h = h_next
    y_prompt = h

    hs = layer_norm(x_sample, ln_in_g, ln_in_b)
    ks_l, vs_l, rs_l = [], [], []
    W = cache_swa_k.shape[2]
    i = np.arange(DS)
    rel_s = np.concatenate([pos_meta[None, :] - pos_s[:, None],
                            np.arange(W)[None, :] - W - i[:, None],
                            i[None, :] - i[:, None]], axis=-1)[None]
    bias_s = rel_bias_lookup(rel_bias, rel_s)
    mask_s = jnp.ones(rel_s.shape, dtype=bool)
    for l in range(DEPTH):
        ffn_p = (ln1_g[l], ln1_b[l], peer_wq[l], peer_subkeys[l], peer_u[l], peer_v[l], ln2_g[l], ln2_b[l])
        q, k, v, rq, rk, rv, rg = project(hs, w_in[l], pos_s)
        kc = jnp.concatenate([cache_meta_k[l].astype(k.dtype), cache_swa_k[l].astype(k.dtype), k], axis=1)[:, None]
        vc = jnp.concatenate([cache_meta_v[l].astype(v.dtype), cache_swa_v[l].astype(v.dtype), v], axis=1)[:, None]
        o_att = sink_attention(q[:, None], kc, vc, bias_s, mask_s, attn_sinks[l]).reshape(DB, DS, ATT_W)
        o_ret, st_new = retention_chunk(state_ret[l].astype(jnp.float32), rq, rk, rv, log_gamma)
        hs = post_layer(hs, mix_out(o_att, o_ret, rg, ret_gn_g[l], w_out[l]), *ffn_p)
        ks_l.append(k)
        vs_l.append(v)
        rs_l.append(st_new)
    y_sample = hs

    return (y_prompt, y_sample,
            jnp.stack(meta_k_l), jnp.stack(meta_v_l), jnp.stack(swa_k_l), jnp.stack(swa_v_l), jnp.stack(ret_l),
            jnp.stack(ks_l), jnp.stack(vs_l), jnp.stack(rs_l))
```

```cpp
#include <hip/hip_runtime.h>
#include <stdint.h>

namespace {

constexpr int D = 1024;
constexpr int NB = 8, SEQ = 2048, DSEQ = 64;
constexpr int NPROMPT = NB * SEQ;
constexpr int NSAMPLE = NB * DSEQ;
constexpr int NTOK = NPROMPT + NSAMPLE;
constexpr int NMETA = 16;
constexpr int NROWS = NTOK + NMETA;
constexpr int PW = 2816;
constexpr float LN_EPS = 1e-5f;
constexpr float ALPHA = 1.18920711500272f;

constexpr size_t O_Y = 0;
constexpr size_t O_METAK = 17301504;
constexpr size_t O_METAV = O_METAK + 16384;
constexpr size_t O_SWAKP = O_METAV + 16384;
constexpr size_t O_SWAVP = O_SWAKP + 131072;
constexpr size_t O_RETP = O_SWAVP + 131072;
constexpr size_t O_SWAKS = O_RETP + 524288;
constexpr size_t O_SWAVS = O_SWAKS + 65536;
constexpr size_t O_RETS = O_SWAVS + 65536;

constexpr size_t W_HBF = 0;
constexpr size_t W_P = W_HBF + (size_t)NROWS * D * 2;
constexpr size_t W_MIXED = W_P + (size_t)NROWS * PW * 2;
constexpr size_t W_QP = W_MIXED + (size_t)NTOK * D * 2;
constexpr size_t W_LIDX = W_QP + (size_t)NTOK * D * 4;
constexpr size_t W_LGATE = W_LIDX + (size_t)NTOK * 128 * 4;
constexpr size_t W_END = W_LGATE + (size_t)NTOK * 128 * 4;

typedef uint16_t bf16_t;

__device__ __forceinline__ bf16_t f2bf(float f) {
  uint32_t u = __float_as_uint(f);
  u += 0x7FFFu + ((u >> 16) & 1u);
  return (bf16_t)(u >> 16);
}
__device__ __forceinline__ float bf2f(bf16_t h) { return __uint_as_float(((uint32_t)h) << 16); }

__device__ __forceinline__ int row_pos(int r) {
  if (r < NPROMPT) return 16 + (r & 2047);
  if (r < NTOK) return 16 + 2048 + ((r - NPROMPT) & 63);
  return r - NTOK;
}

__device__ __forceinline__ float wave_sum(float v) {
#pragma unroll
  for (int o = 32; o > 0; o >>= 1) v += __shfl_xor(v, o);
  return v;
}

__device__ __forceinline__ float block_sum256(float v, float* red) {
  v = wave_sum(v);
  __syncthreads();
  if ((threadIdx.x & 63) == 0) red[threadIdx.x >> 6] = v;
  __syncthreads();
  return red[0] + red[1] + red[2] + red[3];
}

__device__ __forceinline__ int t5_bucket(int rel) {
  int n = rel < 0 ? -rel : rel;
  int b;
  if (n < 8) b = n;
  else {
    int l = 2 + 31 - __clz(n * n);
    b = l > 15 ? 15 : l;
  }
  return (rel > 0 ? 16 : 0) + b;
}

__device__ __forceinline__ float gelu_tanh(float x) {
  float u = 0.7978845608028654f * (x + 0.044715f * x * x * x);
  return 0.5f * x * (1.0f + tanhf(u));
}

__global__ void __launch_bounds__(256) ln_in_kernel(const float* __restrict__ xp, const float* __restrict__ xs,
                                                    const float* __restrict__ meta, const float* __restrict__ g,
                                                    const float* __restrict__ b, bf16_t* __restrict__ hbf) {
  __shared__ float red[4];
  const int r = blockIdx.x, t = threadIdx.x;
  const float* src = r < NPROMPT ? xp + (size_t)r * D : (r < NTOK ? xs + (size_t)(r - NPROMPT) * D : meta + (size_t)(r - NTOK) * D);
  float4 v = ((const float4*)src)[t];
  float s = block_sum256(v.x + v.y + v.z + v.w, red);
  float mean = s * (1.0f / D);
  float dx = v.x - mean, dy = v.y - mean, dz = v.z - mean, dw = v.w - mean;
  float q = block_sum256(dx * dx + dy * dy + dz * dz + dw * dw, red);
  float rstd = rsqrtf(q * (1.0f / D) + LN_EPS);
  float4 gg = ((const float4*)g)[t], bb = ((const float4*)b)[t];
  ushort4 o;
  o.x = f2bf(dx * rstd * gg.x + bb.x);
  o.y = f2bf(dy * rstd * gg.y + bb.y);
  o.z = f2bf(dz * rstd * gg.z + bb.z);
  o.w = f2bf(dw * rstd * gg.w + bb.w);
  ((ushort4*)(hbf + (size_t)r * D))[t] = o;
}

struct ALoadBf16 {
  const bf16_t* A; int lda; int pad;
  __device__ __forceinline__ float operator()(int r, int k) const { return bf2f(A[(size_t)r * lda + k]); }
};
struct ALoadF32 {
  const float* A; int lda; int pad;
  __device__ __forceinline__ float operator()(int r, int k) const { return A[(size_t)r * lda + k]; }
};

template <class AL, class EPI>
__global__ void __launch_bounds__(256) gemm_naive(AL al, const float* __restrict__ W, int M, int N, int K, int pad0, EPI epi) {
  __shared__ float As[16][68];
  __shared__ float Bs[16][128];
  const int t = threadIdx.x, tx = t & 15, ty = t >> 4;
  const int m0 = blockIdx.y * 64, n0 = blockIdx.x * 128;
  float acc[4][8];
#pragma unroll
  for (int i = 0; i < 4; ++i)
#pragma unroll
    for (int j = 0; j < 8; ++j) acc[i][j] = 0.f;
  for (int k0 = 0; k0 < K; k0 += 16) {
#pragma unroll
    for (int e = 0; e < 4; ++e) {
      int idx = t + e * 256;
      int r = idx >> 4, kk = idx & 15;
      int gr = m0 + r;
      As[kk][r] = gr < M ? al(gr, k0 + kk) : 0.f;
    }
#pragma unroll
    for (int e = 0; e < 8; ++e) {
      int idx = t + e * 256;
      int kk = idx >> 7, n = idx & 127;
      Bs[kk][n] = W[(size_t)(k0 + kk) * N + n0 + n];
    }
    __syncthreads();
#pragma unroll
    for (int kk = 0; kk < 16; ++kk) {
      float a[4], b[8];
#pragma unroll
      for (int i = 0; i < 4; ++i) a[i] = As[kk][ty * 4 + i];
#pragma unroll
      for (int j = 0; j < 4; ++j) { b[j] = Bs[kk][tx * 4 + j]; b[4 + j] = Bs[kk][64 + tx * 4 + j]; }
#pragma unroll
      for (int i = 0; i < 4; ++i)
#pragma unroll
        for (int j = 0; j < 8; ++j) acc[i][j] += a[i] * b[j];
    }
    __syncthreads();
  }
#pragma unroll
  for (int i = 0; i < 4; ++i) {
    int r = m0 + ty * 4 + i;
    if (r < M) epi(r, blockIdx.x, tx * 4, acc[i]);
  }
}

struct EpiInProj {
  bf16_t* P; float* out;
  __device__ __forceinline__ void operator()(int r, int nt, int c, const float (&v)[8]) const {
    bf16_t* prow = P + (size_t)r * PW + nt * 128;
    float o[8];
#pragma unroll
    for (int j = 0; j < 8; ++j) o[j] = v[j];
    if (nt >= 6 && nt < 14) {
      const float pos = (float)row_pos(r);
      const float sc = nt >= 10 ? 0.08838834764831845f : 1.0f;
#pragma unroll
      for (int j = 0; j < 4; ++j) {
        const int d = c + j;
        const float inv = powf(10000.0f, -(float)d / 64.0f);
        const float ang = pos * inv;
        float sn, cs;
        sincosf(ang, &sn, &cs);
        o[j] = (v[j] * cs - v[4 + j] * sn) * sc;
        o[4 + j] = (v[j] * sn + v[4 + j] * cs) * sc;
      }
    }
#pragma unroll
    for (int j = 0; j < 4; ++j) { prow[c + j] = f2bf(o[j]); prow[64 + c + j] = f2bf(o[4 + j]); }
    if (nt == 4 || nt == 5) {
      const bool isv = nt == 5;
#pragma unroll
      for (int jj = 0; jj < 8; ++jj) {
        const int col = (jj < 4) ? c + jj : 64 + c + (jj - 4);
        const float val = v[jj];
        if (r < NPROMPT) {
          const int b = r >> 11, s = r & 2047;
          if (s >= SEQ - 128) out[(isv ? O_SWAVP : O_SWAKP) + (size_t)(b * 128 + (s - (SEQ - 128))) * 128 + col] = val;
        } else if (r < NTOK) {
          out[(isv ? O_SWAVS : O_SWAKS) + (size_t)(r - NPROMPT) * 128 + col] = val;
        } else {
          const int m = r - NTOK;
          for (int b = 0; b < NB; ++b) out[(isv ? O_METAV : O_METAK) + (size_t)(b * 16 + m) * 128 + col] = val;
        }
      }
    }
  }
};

struct EpiOutProj {
  const bf16_t* hbf; float* z;
  __device__ __forceinline__ void operator()(int r, int nt, int c, const float (&v)[8]) const {
    const size_t base = (size_t)r * D + nt * 128;
#pragma unroll
    for (int j = 0; j < 4; ++j) {
      z[base + c + j] = ALPHA * bf2f(hbf[base + c + j]) + v[j];
      z[base + 64 + c + j] = ALPHA * bf2f(hbf[base + 64 + c + j]) + v[4 + j];
    }
  }
};

struct EpiPlainF32 {
  float* C;
  __device__ __forceinline__ void operator()(int r, int nt, int c, const float (&v)[8]) const {
    const size_t base = (size_t)r * D + nt * 128;
#pragma unroll
    for (int j = 0; j < 4; ++j) { C[base + c + j] = v[j]; C[base + 64 + c + j] = v[4 + j]; }
  }
};

__global__ void __launch_bounds__(256) attn_naive(const bf16_t* __restrict__ P, const float* __restrict__ cmk,
                                                  const float* __restrict__ cmv, const float* __restrict__ csk,
                                                  const float* __restrict__ csv, const float* __restrict__ rel_bias,
                                                  const float* __restrict__ sinks, bf16_t* __restrict__ mixed) {
  __shared__ bf16_t Ks[208 * 64];
  __shared__ bf16_t Vs[208 * 64];
  const int u = blockIdx.x, kvh = blockIdx.y, t = threadIdx.x;
  const bool samp = u >= 256;
  const int b = samp ? u - 256 : u >> 5, c = samp ? 32 : (u & 31);
  for (int idx = t; idx < 208 * 64; idx += 256) {
    const int key = idx >> 6, d = idx & 63;
    float kf = 0.f, vf = 0.f;
    if (key < 16) {
      if (samp) {
        kf = cmk[((size_t)(b * 16 + key) * 2 + kvh) * 64 + d];
        vf = cmv[((size_t)(b * 16 + key) * 2 + kvh) * 64 + d];
      } else {
        const bf16_t* pr = P + (size_t)(NTOK + key) * PW;
        kf = bf2f(pr[512 + kvh * 64 + d]);
        vf = bf2f(pr[640 + kvh * 64 + d]);
      }
    } else {
      const int jb = key - 16;
      if (samp) {
        if (jb < 128) {
          kf = csk[((size_t)(b * 128 + jb) * 2 + kvh) * 64 + d];
          vf = csv[((size_t)(b * 128 + jb) * 2 + kvh) * 64 + d];
        } else {
          const bf16_t* pr = P + (size_t)(NPROMPT + b * 64 + (jb - 128)) * PW;
          kf = bf2f(pr[512 + kvh * 64 + d]);
          vf = bf2f(pr[640 + kvh * 64 + d]);
        }
      } else {
        const int f = (c - 2) * 64 + jb;
        if (f >= 0) {
          const bf16_t* pr = P + (size_t)(b * SEQ + f) * PW;
          kf = bf2f(pr[512 + kvh * 64 + d]);
          vf = bf2f(pr[640 + kvh * 64 + d]);
        }
      }
    }
    Ks[idx] = f2bf(kf);
    Vs[idx] = f2bf(vf);
  }
  __syncthreads();
  const int g = t >> 6, i = t & 63, H = kvh * 4 + g;
  const int row = samp ? NPROMPT + b * 64 + i : b * SEQ + c * 64 + i;
  const int posq = 16 + c * 64 + i;
  float q[64], acc[64];
  {
    const bf16_t* qp = P + (size_t)row * PW + H * 64;
#pragma unroll
    for (int d = 0; d < 64; ++d) { q[d] = bf2f(qp[d]); acc[d] = 0.f; }
  }
  float m = sinks[H], l = 1.0f;
  for (int key = 0; key < 208; ++key) {
    int rel;
    bool ok = true;
    if (key < 16) rel = key - posq;
    else {
      const int jb = key - 16;
      rel = jb - 128 - i;
      if (!samp && (c - 2) * 64 + jb < 0) ok = false;
    }
    if (!ok) continue;
    float s = 0.f;
#pragma unroll
    for (int d = 0; d < 64; ++d) s += q[d] * bf2f(Ks[key * 64 + d]);
    s = s * 0.125f + rel_bias[t5_bucket(rel) * 8 + H];
    if (s > m) {
      const float f = __expf(m - s);
      l *= f;
#pragma unroll
      for (int d = 0; d < 64; ++d) acc[d] *= f;
      m = s;
    }
    const float p = __expf(s - m);
    l += p;
#pragma unroll
    for (int d = 0; d < 64; ++d) acc[d] += p * bf2f(Vs[key * 64 + d]);
  }
  const float invl = 1.0f / l;
  bf16_t* op = mixed + (size_t)row * D + H * 64;
#pragma unroll
  for (int d = 0; d < 64; ++d) op[d] = f2bf(acc[d] * invl);
}

__global__ void __launch_bounds__(256) ret_naive(const bf16_t* __restrict__ P, const float* __restrict__ state_in,
                                                 float* __restrict__ oret, float* __restrict__ out) {
  const int t = threadIdx.x, e = t >> 1, half = t & 1;
  const bool samp = blockIdx.x >= 32;
  const int bh = blockIdx.x & 31, b = bh >> 2, h = bh & 3;
  const float gamma = 1.0f - exp2f(-5.0f - (float)h);
  float S[64];
  if (samp) {
#pragma unroll
    for (int dd = 0; dd < 64; ++dd) S[dd] = state_in[((size_t)(b * 4 + h) * 128 + half * 64 + dd) * 128 + e];
  } else {
#pragma unroll
    for (int dd = 0; dd < 64; ++dd) S[dd] = 0.f;
  }
  const int ntok = samp ? 64 : 16 + SEQ;
  for (int it = 0; it < ntok; ++it) {
    int row;
    bool emit = true;
    if (samp) row = NPROMPT + b * 64 + it;
    else if (it < 16) { row = NTOK + it; emit = false; }
    else row = b * SEQ + (it - 16);
    const bf16_t* pr = P + (size_t)row * PW;
    const float v = bf2f(pr[1792 + h * 128 + e]);
    const bf16_t* qp = pr + 768 + h * 128 + half * 64;
    const bf16_t* kp = pr + 1280 + h * 128 + half * 64;
    float o = 0.f;
#pragma unroll
    for (int dd = 0; dd < 64; ++dd) {
      S[dd] = gamma * S[dd] + bf2f(kp[dd]) * v;
      o += bf2f(qp[dd]) * S[dd];
    }
    o += __shfl_xor(o, 1);
    if (emit && half == 0) oret[(size_t)row * 512 + h * 128 + e] = o;
  }
  float* so = out + (samp ? O_RETS : O_RETP) + (size_t)(b * 4 + h) * 128 * 128;
#pragma unroll
  for (int dd = 0; dd < 64; ++dd) so[(size_t)(half * 64 + dd) * 128 + e] = S[dd];
}

__global__ void __launch_bounds__(256) ret_gate(const float* __restrict__ oret, const bf16_t* __restrict__ P,
                                                const float* __restrict__ gn_g, bf16_t* __restrict__ mixed) {
  const int row = blockIdx.x, t = threadIdx.x, h = t >> 6, l = t & 63;
  const float a = oret[(size_t)row * 512 + h * 128 + l], bq = oret[(size_t)row * 512 + h * 128 + 64 + l];
  const float mu = wave_sum(a + bq) * (1.0f / 128.0f);
  const float da = a - mu, db = bq - mu;
  const float var = wave_sum(da * da + db * db) * (1.0f / 128.0f);
  const float rstd = rsqrtf(var + LN_EPS);
  const bf16_t* rg = P + (size_t)row * PW + 2304 + h * 128;
  const float g0 = bf2f(rg[l]), g1 = bf2f(rg[64 + l]);
  const float y0 = da * rstd * gn_g[h * 128 + l] * (g0 / (1.0f + __expf(-g0)));
  const float y1 = db * rstd * gn_g[h * 128 + 64 + l] * (g1 / (1.0f + __expf(-g1)));
  mixed[(size_t)row * D + 512 + h * 128 + l] = f2bf(y0);
  mixed[(size_t)row * D + 512 + h * 128 + 64 + l] = f2bf(y1);
}

__global__ void __launch_bounds__(256) ln1_kernel(float* __restrict__ z, const float* __restrict__ g, const float* __restrict__ b) {
  __shared__ float red[4];
  const int r = blockIdx.x, t = threadIdx.x;
  float4 v = ((float4*)(z + (size_t)r * D))[t];
  float mean = block_sum256(v.x + v.y + v.z + v.w, red) * (1.0f / D);
  float dx = v.x - mean, dy = v.y - mean, dz = v.z - mean, dw = v.w - mean;
  float rstd = rsqrtf(block_sum256(dx * dx + dy * dy + dz * dz + dw * dw, red) * (1.0f / D) + LN_EPS);
  float4 gg = ((const float4*)g)[t], bb = ((const float4*)b)[t];
  float4 o;
  o.x = dx * rstd * gg.x + bb.x; o.y = dy * rstd * gg.y + bb.y; o.z = dz * rstd * gg.z + bb.z; o.w = dw * rstd * gg.w + bb.w;
  ((float4*)(z + (size_t)r * D))[t] = o;
}

__global__ void __launch_bounds__(256) topk_naive(const float* __restrict__ qp, const float* __restrict__ subk,
                                                  int* __restrict__ lidx, float* __restrict__ lgate) {
  __shared__ float qs[1024];
  __shared__ float sc[2048];
  __shared__ float tops[16][16];
  __shared__ int topi[16][16];
  __shared__ float cand[8][256];
  const int tok = blockIdx.x, t = threadIdx.x;
  for (int i = t; i < 1024; i += 256) qs[i] = qp[(size_t)tok * D + i];
  __syncthreads();
  for (int j = 0; j < 8; ++j) {
    const int idx = t + 256 * j, pc = idx >> 7;
    const float* kp = subk + (size_t)idx * 64;
    float s = 0.f;
    for (int d = 0; d < 64; ++d) s += qs[pc * 64 + d] * kp[d];
    sc[idx] = s;
  }
  __syncthreads();
  if (t < 16) {
    for (int k = 0; k < 16; ++k) {
      float best = -3.0e38f; int bi = 0;
      for (int n = 0; n < 128; ++n) { const float v = sc[t * 128 + n]; if (v > best) { best = v; bi = n; } }
      tops[t][k] = best; topi[t][k] = bi; sc[t * 128 + bi] = -3.0e38f;
    }
  }
  __syncthreads();
  {
    const int p = t >> 5;
    for (int j = 0; j < 8; ++j) {
      const int ci = (t & 31) * 8 + j, a = ci >> 4, bb = ci & 15;
      cand[p][ci] = tops[2 * p][a] + tops[2 * p + 1][bb];
    }
  }
  __syncthreads();
  if (t < 8) {
    float ts[16]; int ti[16];
#pragma unroll
    for (int k = 0; k < 16; ++k) {
      float best = -3.0e38f; int bi = 0;
      for (int n = 0; n < 256; ++n) { const float v = cand[t][n]; if (v > best) { best = v; bi = n; } }
      ts[k] = best; ti[k] = bi; cand[t][bi] = -3.0e38f;
    }
    float den = 0.f;
    const float smax = ts[0];
#pragma unroll
    for (int k = 0; k < 16; ++k) { ts[k] = __expf(ts[k] - smax); den += ts[k]; }
    const float inv = 1.0f / den;
#pragma unroll
    for (int k = 0; k < 16; ++k) {
      const int a = ti[k] >> 4, bb = ti[k] & 15;
      lidx[(size_t)tok * 128 + t * 16 + k] = topi[2 * t][a] * 128 + topi[2 * t + 1][bb];
      lgate[(size_t)tok * 128 + t * 16 + k] = ts[k] * inv;
    }
  }
}

__global__ void __launch_bounds__(256) peer_gather_naive(const float* __restrict__ h1, const int* __restrict__ lidx,
                                                         const float* __restrict__ lgate, const float* __restrict__ U,
                                                         const float* __restrict__ V, const float* __restrict__ g2,
                                                         const float* __restrict__ b2, float* __restrict__ y) {
  __shared__ float red[4];
  __shared__ float part[2][4];
  const int tok = blockIdx.x, t = threadIdx.x;
  const float4 x = ((const float4*)(h1 + (size_t)tok * D))[t];
  float4 acc = make_float4(0.f, 0.f, 0.f, 0.f);
  for (int j = 0; j < 128; ++j) {
    const int e = lidx[(size_t)tok * 128 + j];
    const float gt = lgate[(size_t)tok * 128 + j];
    const float4 u = ((const float4*)(U + (size_t)e * D))[t];
    float pd = wave_sum(u.x * x.x + u.y * x.y + u.z * x.z + u.w * x.w);
    if ((t & 63) == 0) part[j & 1][t >> 6] = pd;
    __syncthreads();
    const float dot = part[j & 1][0] + part[j & 1][1] + part[j & 1][2] + part[j & 1][3];
    const float w = gt * gelu_tanh(dot);
    const float4 v = ((const float4*)(V + (size_t)e * D))[t];
    acc.x += w * v.x; acc.y += w * v.y; acc.z += w * v.z; acc.w += w * v.w;
  }
  float4 r;
  r.x = ALPHA * x.x + acc.x; r.y = ALPHA * x.y + acc.y; r.z = ALPHA * x.z + acc.z; r.w = ALPHA * x.w + acc.w;
  float mean = block_sum256(r.x + r.y + r.z + r.w, red) * (1.0f / D);
  float dx = r.x - mean, dy = r.y - mean, dz = r.z - mean, dw = r.w - mean;
  float rstd = rsqrtf(block_sum256(dx * dx + dy * dy + dz * dz + dw * dw, red) * (1.0f / D) + LN_EPS);
  float4 gg = ((const float4*)g2)[t], bb = ((const float4*)b2)[t];
  float4 o;
  o.x = dx * rstd * gg.x + bb.x; o.y = dy * rstd * gg.y + bb.y; o.z = dz * rstd * gg.z + bb.z; o.w = dw * rstd * gg.w + bb.w;
  ((float4*)(y + (size_t)tok * D))[t] = o;
}

}

extern "C" void kernel_launch(void* const* d_in, const int* in_sizes, int n_in, void* d_out, int out_size, void* d_ws,
                              size_t ws_size, hipStream_t stream) {
  const float* x_prompt = (const float*)d_in[0];
  const float* x_sample = (const float*)d_in[1];
  const float* cmk = (const float*)d_in[2];
  const float* cmv = (const float*)d_in[3];
  const float* csk = (const float*)d_in[4];
  const float* csv = (const float*)d_in[5];
  const float* state_ret = (const float*)d_in[6];
  const float* meta_tokens = (const float*)d_in[7];
  const float* ln_in_g = (const float*)d_in[8];
  const float* ln_in_b = (const float*)d_in[9];
  const float* rel_bias = (const float*)d_in[10];
  const float* w_in = (const float*)d_in[11];
  const float* w_out = (const float*)d_in[12];
  const float* sinks = (const float*)d_in[13];
  const float* gn_g = (const float*)d_in[14];
  const float* ln1_g = (const float*)d_in[15];
  const float* ln1_b = (const float*)d_in[16];
  const float* peer_wq = (const float*)d_in[17];
  const float* subk = (const float*)d_in[18];
  const float* peer_u = (const float*)d_in[19];
  const float* peer_v = (const float*)d_in[20];
  const float* ln2_g = (const float*)d_in[21];
  const float* ln2_b = (const float*)d_in[22];
  float* out = (float*)d_out;
  char* ws = (char*)d_ws;
  bf16_t* hbf = (bf16_t*)(ws + W_HBF);
  bf16_t* P = (bf16_t*)(ws + W_P);
  float* z = (float*)(ws + W_P);
  bf16_t* mixed = (bf16_t*)(ws + W_MIXED);
  float* qp = (float*)(ws + W_QP);
  int* lidx = (int*)(ws + W_LIDX);
  float* lgate = (float*)(ws + W_LGATE);
  float* oret = out;

  ln_in_kernel<<<NROWS, 256, 0, stream>>>(x_prompt, x_sample, meta_tokens, ln_in_g, ln_in_b, hbf);
  {
    dim3 grid(PW / 128, (NROWS + 63) / 64);
    gemm_naive<<<grid, 256, 0, stream>>>(ALoadBf16{hbf, D, 0}, w_in, NROWS, PW, D, 0, EpiInProj{P, out});
  }
  attn_naive<<<dim3(264, 2), 256, 0, stream>>>(P, cmk, cmv, csk, csv, rel_bias, sinks, mixed);
  ret_naive<<<64, 256, 0, stream>>>(P, state_ret, oret, out);
  ret_gate<<<NTOK, 256, 0, stream>>>(oret, P, gn_g, mixed);
  {
    dim3 grid(D / 128, NTOK / 64);
    gemm_naive<<<grid, 256, 0, stream>>>(ALoadBf16{mixed, D, 0}, w_out, NTOK, D, D, 0, EpiOutProj{hbf, z});
  }
  ln1_kernel<<<NTOK, 256, 0, stream>>>(z, ln1_g, ln1_b);
  {
    dim3 grid(D / 128, NTOK / 64);
    gemm_naive<<<grid, 256, 0, stream>>>(ALoadF32{z, D, 0}, peer_wq, NTOK, D, D, 0, EpiPlainF32{qp});
  }
  topk_naive<<<NTOK, 256, 0, stream>>>(qp, subk, lidx, lgate);
  peer_gather_naive<<<NTOK, 256, 0, stream>>>(z, lidx, lgate, peer_u, peer_v, ln2_g, ln2_b, out);
}
```

```cpp
#include <hip/hip_runtime.h>
#include <hip/hip_cooperative_groups.h>
#include <stdint.h>
#include <cstdio>
namespace cg = cooperative_groups;

namespace {

constexpr int D = 1024;
constexpr int NB = 8, SEQ = 2048, DSEQ = 64;
constexpr int NPROMPT = NB * SEQ;
constexpr int NSAMPLE = NB * DSEQ;
constexpr int NTOK = NPROMPT + NSAMPLE;
constexpr int NMETA = 16;
constexpr int NROWS = NTOK + NMETA;
constexpr int PW = 2816;
constexpr float LN_EPS = 1e-5f;
constexpr float ALPHA = 1.18920711500272f;

constexpr size_t O_Y = 0;
constexpr size_t O_METAK = 17301504;
constexpr size_t O_METAV = O_METAK + 16384;
constexpr size_t O_SWAKP = O_METAV + 16384;
constexpr size_t O_SWAVP = O_SWAKP + 131072;
constexpr size_t O_RETP = O_SWAVP + 131072;
constexpr size_t O_SWAKS = O_RETP + 524288;
constexpr size_t O_SWAVS = O_SWAKS + 65536;
constexpr size_t O_RETS = O_SWAVS + 65536;

constexpr size_t W_HBF = 0;
constexpr size_t W_P = W_HBF + (size_t)NROWS * D * 2;
constexpr size_t W_MIXED = W_P + (size_t)NROWS * PW * 2;
constexpr size_t W_QP = W_MIXED + (size_t)NTOK * D * 2;
constexpr size_t W_LIDX = W_QP + (size_t)NTOK * D * 4;
constexpr size_t W_LGATE = W_LIDX + (size_t)NTOK * 128 * 4;
constexpr size_t W_END = W_LGATE + (size_t)NTOK * 128 * 4;

typedef uint16_t bf16_t;

__device__ __forceinline__ bf16_t f2bf(float f) {
  uint32_t u = __float_as_uint(f);
  u += 0x7FFFu + ((u >> 16) & 1u);
  return (bf16_t)(u >> 16);
}
__device__ __forceinline__ float bf2f(bf16_t h) { return __uint_as_float(((uint32_t)h) << 16); }

__device__ __forceinline__ int row_pos(int r) {
  if (r < NPROMPT) return 16 + (r & 2047);
  if (r < NTOK) return 16 + 2048 + ((r - NPROMPT) & 63);
  return r - NTOK;
}

__device__ __forceinline__ float wave_sum(float v) {
#pragma unroll
  for (int o = 32; o > 0; o >>= 1) v += __shfl_xor(v, o);
  return v;
}

__device__ __forceinline__ float block_sum256(float v, float* red) {
  v = wave_sum(v);
  __syncthreads();
  if ((threadIdx.x & 63) == 0) red[threadIdx.x >> 6] = v;
  __syncthreads();
  return red[0] + red[1] + red[2] + red[3];
}

__device__ __forceinline__ int t5_bucket(int rel) {
  int n = rel < 0 ? -rel : rel;
  int b;
  if (n < 8) b = n;
  else {
    int l = 2 + 31 - __clz(n * n);
    b = l > 15 ? 15 : l;
  }
  return (rel > 0 ? 16 : 0) + b;
}

__device__ __forceinline__ float gelu_tanh(float x) {
  float u = 0.7978845608028654f * (x + 0.044715f * x * x * x);
  return 0.5f * x * (1.0f + tanhf(u));
}

__device__ __forceinline__ void ln_in_body(int r, float* red, const float* __restrict__ xp, const float* __restrict__ xs,
                                                    const float* __restrict__ meta, const float* __restrict__ g,
                                                    const float* __restrict__ b, bf16_t* __restrict__ hbf) {
  const int t = threadIdx.x;
  const float* src = r < NPROMPT ? xp + (size_t)r * D : (r < NTOK ? xs + (size_t)(r - NPROMPT) * D : meta + (size_t)(r - NTOK) * D);
  float4 v = ((const float4*)src)[t];
  float s = block_sum256(v.x + v.y + v.z + v.w, red);
  float mean = s * (1.0f / D);
  float dx = v.x - mean, dy = v.y - mean, dz = v.z - mean, dw = v.w - mean;
  float q = block_sum256(dx * dx + dy * dy + dz * dz + dw * dw, red);
  float rstd = rsqrtf(q * (1.0f / D) + LN_EPS);
  float4 gg = ((const float4*)g)[t], bb = ((const float4*)b)[t];
  ushort4 o;
  o.x = f2bf(dx * rstd * gg.x + bb.x);
  o.y = f2bf(dy * rstd * gg.y + bb.y);
  o.z = f2bf(dz * rstd * gg.z + bb.z);
  o.w = f2bf(dw * rstd * gg.w + bb.w);
  ((ushort4*)(hbf + (size_t)r * D))[t] = o;
}

struct ALoadBf16 {
  const bf16_t* A; int lda; int pad;
  __device__ __forceinline__ float operator()(int r, int k) const { return bf2f(A[(size_t)r * lda + k]); }
};
struct ALoadF32 {
  const float* A; int lda; int pad;
  __device__ __forceinline__ float operator()(int r, int k) const { return A[(size_t)r * lda + k]; }
};

template <class AL, class EPI>
__device__ __forceinline__ void gemm_naive_body(int bx, int by, char* smem, AL al, const float* __restrict__ W, int M, int N, int K, EPI epi) {
  float (*As)[68] = (float (*)[68])smem;
  float (*Bs)[128] = (float (*)[128])(smem + 16 * 68 * 4);
  const int t = threadIdx.x, tx = t & 15, ty = t >> 4;
  const int m0 = by * 64, n0 = bx * 128;
  float acc[4][8];
#pragma unroll
  for (int i = 0; i < 4; ++i)
#pragma unroll
    for (int j = 0; j < 8; ++j) acc[i][j] = 0.f;
  for (int k0 = 0; k0 < K; k0 += 16) {
#pragma unroll
    for (int e = 0; e < 4; ++e) {
      int idx = t + e * 256;
      int r = idx >> 4, kk = idx & 15;
      int gr = m0 + r;
      As[kk][r] = gr < M ? al(gr, k0 + kk) : 0.f;
    }
#pragma unroll
    for (int e = 0; e < 8; ++e) {
      int idx = t + e * 256;
      int kk = idx >> 7, n = idx & 127;
      Bs[kk][n] = W[(size_t)(k0 + kk) * N + n0 + n];
    }
    __syncthreads();
#pragma unroll
    for (int kk = 0; kk < 16; ++kk) {
      float a[4], b[8];
#pragma unroll
      for (int i = 0; i < 4; ++i) a[i] = As[kk][ty * 4 + i];
#pragma unroll
      for (int j = 0; j < 4; ++j) { b[j] = Bs[kk][tx * 4 + j]; b[4 + j] = Bs[kk][64 + tx * 4 + j]; }
#pragma unroll
      for (int i = 0; i < 4; ++i)
#pragma unroll
        for (int j = 0; j < 8; ++j) acc[i][j] += a[i] * b[j];
    }
    __syncthreads();
  }
#pragma unroll
  for (int i = 0; i < 4; ++i) {
    int r = m0 + ty * 4 + i;
    if (r < M) epi(r, bx, tx * 4, acc[i]);
  }
}

struct EpiInProj {
  bf16_t* P; float* out;
  __device__ __forceinline__ void operator()(int r, int nt, int c, const float (&v)[8]) const {
    bf16_t* prow = P + (size_t)r * PW + nt * 128;
    float o[8];
#pragma unroll
    for (int j = 0; j < 8; ++j) o[j] = v[j];
    if (nt >= 6 && nt < 14) {
      const float pos = (float)row_pos(r);
      const float sc = nt >= 10 ? 0.08838834764831845f : 1.0f;
#pragma unroll
      for (int j = 0; j < 4; ++j) {
        const int d = c + j;
        const float inv = powf(10000.0f, -(float)d / 64.0f);
        const float ang = pos * inv;
        float sn, cs;
        sincosf(ang, &sn, &cs);
        o[j] = (v[j] * cs - v[4 + j] * sn) * sc;
        o[4 + j] = (v[j] * sn + v[4 + j] * cs) * sc;
      }
    }
#pragma unroll
    for (int j = 0; j < 4; ++j) { prow[c + j] = f2bf(o[j]); prow[64 + c + j] = f2bf(o[4 + j]); }
    if (nt == 4 || nt == 5) {
      const bool isv = nt == 5;
#pragma unroll
      for (int jj = 0; jj < 8; ++jj) {
        const int col = (jj < 4) ? c + jj : 64 + c + (jj - 4);
        const float val = v[jj];
        if (r < NPROMPT) {
          const int b = r >> 11, s = r & 2047;
          if (s >= SEQ - 128) out[(isv ? O_SWAVP : O_SWAKP) + (size_t)(b * 128 + (s - (SEQ - 128))) * 128 + col] = val;
        } else if (r < NTOK) {
          out[(isv ? O_SWAVS : O_SWAKS) + (size_t)(r - NPROMPT) * 128 + col] = val;
        } else {
          const int m = r - NTOK;
          for (int b = 0; b < NB; ++b) out[(isv ? O_METAV : O_METAK) + (size_t)(b * 16 + m) * 128 + col] = val;
        }
      }
    }
  }
};

struct EpiOutProj {
  const bf16_t* hbf; float* z;
  __device__ __forceinline__ void operator()(int r, int nt, int c, const float (&v)[8]) const {
    const size_t base = (size_t)r * D + nt * 128;
#pragma unroll
    for (int j = 0; j < 4; ++j) {
      z[base + c + j] = ALPHA * bf2f(hbf[base + c + j]) + v[j];
      z[base + 64 + c + j] = ALPHA * bf2f(hbf[base + 64 + c + j]) + v[4 + j];
    }
  }
};

struct EpiPlainF32 {
  float* C;
  __device__ __forceinline__ void operator()(int r, int nt, int c, const float (&v)[8]) const {
    const size_t base = (size_t)r * D + nt * 128;
#pragma unroll
    for (int j = 0; j < 4; ++j) { C[base + c + j] = v[j]; C[base + 64 + c + j] = v[4 + j]; }
  }
};

__device__ __forceinline__ void attn_naive_body(int u, int kvh, char* smem, const bf16_t* __restrict__ P, const float* __restrict__ cmk,
                                                  const float* __restrict__ cmv, const float* __restrict__ csk,
                                                  const float* __restrict__ csv, const float* __restrict__ rel_bias,
                                                  const float* __restrict__ sinks, bf16_t* __restrict__ mixed) {
  bf16_t* Ks = (bf16_t*)smem;
  bf16_t* Vs = Ks + 208 * 64;
  const int t = threadIdx.x;
  __syncthreads();
  const bool samp = u >= 256;
  const int b = samp ? u - 256 : u >> 5, c = samp ? 32 : (u & 31);
  for (int idx = t; idx < 208 * 64; idx += 256) {
    const int key = idx >> 6, d = idx & 63;
    float kf = 0.f, vf = 0.f;
    if (key < 16) {
      if (samp) {
        kf = cmk[((size_t)(b * 16 + key) * 2 + kvh) * 64 + d];
        vf = cmv[((size_t)(b * 16 + key) * 2 + kvh) * 64 + d];
      } else {
        const bf16_t* pr = P + (size_t)(NTOK + key) * PW;
        kf = bf2f(pr[512 + kvh * 64 + d]);
        vf = bf2f(pr[640 + kvh * 64 + d]);
      }
    } else {
      const int jb = key - 16;
      if (samp) {
        if (jb < 128) {
          kf = csk[((size_t)(b * 128 + jb) * 2 + kvh) * 64 + d];
          vf = csv[((size_t)(b * 128 + jb) * 2 + kvh) * 64 + d];
        } else {
          const bf16_t* pr = P + (size_t)(NPROMPT + b * 64 + (jb - 128)) * PW;
          kf = bf2f(pr[512 + kvh * 64 + d]);
          vf = bf2f(pr[640 + kvh * 64 + d]);
        }
      } else {
        const int f = (c - 2) * 64 + jb;
        if (f >= 0) {
          const bf16_t* pr = P + (size_t)(b * SEQ + f) * PW;
          kf = bf2f(pr[512 + kvh * 64 + d]);
          vf = bf2f(pr[640 + kvh * 64 + d]);
        }
      }
    }
    Ks[idx] = f2bf(kf);
    Vs[idx] = f2bf(vf);
  }
  __syncthreads();
  const int g = t >> 6, i = t & 63, H = kvh * 4 + g;
  const int row = samp ? NPROMPT + b * 64 + i : b * SEQ + c * 64 + i;
  const int posq = 16 + c * 64 + i;
  float q[64], acc[64];
  {
    const bf16_t* qp = P + (size_t)row * PW + H * 64;
#pragma unroll
    for (int d = 0; d < 64; ++d) { q[d] = bf2f(qp[d]); acc[d] = 0.f; }
  }
  float m = sinks[H], l = 1.0f;
  for (int key = 0; key < 208; ++key) {
    int rel;
    bool ok = true;
    if (key < 16) rel = key - posq;
    else {
      const int jb = key - 16;
      rel = jb - 128 - i;
      if (!samp && (c - 2) * 64 + jb < 0) ok = false;
    }
    if (!ok) continue;
    float s = 0.f;
#pragma unroll
    for (int d = 0; d < 64; ++d) s += q[d] * bf2f(Ks[key * 64 + d]);
    s = s * 0.125f + rel_bias[t5_bucket(rel) * 8 + H];
    if (s > m) {
      const float f = __expf(m - s);
      l *= f;
#pragma unroll
      for (int d = 0; d < 64; ++d) acc[d] *= f;
      m = s;
    }
    const float p = __expf(s - m);
    l += p;
#pragma unroll
    for (int d = 0; d < 64; ++d) acc[d] += p * bf2f(Vs[key * 64 + d]);
  }
  const float invl = 1.0f / l;
  bf16_t* op = mixed + (size_t)row * D + H * 64;
#pragma unroll
  for (int d = 0; d < 64; ++d) op[d] = f2bf(acc[d] * invl);
}

__device__ __forceinline__ void ret_naive_body(int unit, const bf16_t* __restrict__ P, const float* __restrict__ state_in,
                                                 float* __restrict__ oret, float* __restrict__ out) {
  const int t = threadIdx.x, e = t >> 1, half = t & 1;
  const bool samp = unit >= 32;
  const int bh = unit & 31, b = bh >> 2, h = bh & 3;
  const float gamma = 1.0f - exp2f(-5.0f - (float)h);
  float S[64];
  if (samp) {
#pragma unroll
    for (int dd = 0; dd < 64; ++dd) S[dd] = state_in[((size_t)(b * 4 + h) * 128 + half * 64 + dd) * 128 + e];
  } else {
#pragma unroll
    for (int dd = 0; dd < 64; ++dd) S[dd] = 0.f;
  }
  const int ntok = samp ? 64 : 16 + SEQ;
  for (int it = 0; it < ntok; ++it) {
    int row;
    bool emit = true;
    if (samp) row = NPROMPT + b * 64 + it;
    else if (it < 16) { row = NTOK + it; emit = false; }
    else row = b * SEQ + (it - 16);
    const bf16_t* pr = P + (size_t)row * PW;
    const float v = bf2f(pr[1792 + h * 128 + e]);
    const bf16_t* qp = pr + 768 + h * 128 + half * 64;
    const bf16_t* kp = pr + 1280 + h * 128 + half * 64;
    float o = 0.f;
#pragma unroll
    for (int dd = 0; dd < 64; ++dd) {
      S[dd] = gamma * S[dd] + bf2f(kp[dd]) * v;
      o += bf2f(qp[dd]) * S[dd];
    }
    o += __shfl_xor(o, 1);
    if (emit && half == 0) oret[(size_t)row * 512 + h * 128 + e] = o;
  }
  float* so = out + (samp ? O_RETS : O_RETP) + (size_t)(b * 4 + h) * 128 * 128;
#pragma unroll
  for (int dd = 0; dd < 64; ++dd) so[(size_t)(half * 64 + dd) * 128 + e] = S[dd];
}

__device__ __forceinline__ void ret_gate_body(int row, const float* __restrict__ oret, const bf16_t* __restrict__ P,
                                                const float* __restrict__ gn_g, bf16_t* __restrict__ mixed) {
  const int t = threadIdx.x, h = t >> 6, l = t & 63;
  const float a = oret[(size_t)row * 512 + h * 128 + l], bq = oret[(size_t)row * 512 + h * 128 + 64 + l];
  const float mu = wave_sum(a + bq) * (1.0f / 128.0f);
  const float da = a - mu, db = bq - mu;
  const float var = wave_sum(da * da + db * db) * (1.0f / 128.0f);
  const float rstd = rsqrtf(var + LN_EPS);
  const bf16_t* rg = P + (size_t)row * PW + 2304 + h * 128;
  const float g0 = bf2f(rg[l]), g1 = bf2f(rg[64 + l]);
  const float y0 = da * rstd * gn_g[h * 128 + l] * (g0 / (1.0f + __expf(-g0)));
  const float y1 = db * rstd * gn_g[h * 128 + 64 + l] * (g1 / (1.0f + __expf(-g1)));
  mixed[(size_t)row * D + 512 + h * 128 + l] = f2bf(y0);
  mixed[(size_t)row * D + 512 + h * 128 + 64 + l] = f2bf(y1);
}

__device__ __forceinline__ void ln1_body(int r, float* red, float* __restrict__ z, const float* __restrict__ g, const float* __restrict__ b) {
  const int t = threadIdx.x;
  float4 v = ((float4*)(z + (size_t)r * D))[t];
  float mean = block_sum256(v.x + v.y + v.z + v.w, red) * (1.0f / D);
  float dx = v.x - mean, dy = v.y - mean, dz = v.z - mean, dw = v.w - mean;
  float rstd = rsqrtf(block_sum256(dx * dx + dy * dy + dz * dz + dw * dw, red) * (1.0f / D) + LN_EPS);
  float4 gg = ((const float4*)g)[t], bb = ((const float4*)b)[t];
  float4 o;
  o.x = dx * rstd * gg.x + bb.x; o.y = dy * rstd * gg.y + bb.y; o.z = dz * rstd * gg.z + bb.z; o.w = dw * rstd * gg.w + bb.w;
  ((float4*)(z + (size_t)r * D))[t] = o;
}

__device__ __forceinline__ void topk_naive_body(int tok, char* smem, const float* __restrict__ qp, const float* __restrict__ subk,
                                                  int* __restrict__ lidx, float* __restrict__ lgate) {
  float* qs = (float*)smem;
  float* sc = qs + 1024;
  float (*tops)[16] = (float (*)[16])(sc + 2048);
  int (*topi)[16] = (int (*)[16])(sc + 2048 + 256);
  float (*cand)[256] = (float (*)[256])(sc + 2048 + 512);
  const int t = threadIdx.x;
  __syncthreads();
  for (int i = t; i < 1024; i += 256) qs[i] = qp[(size_t)tok * D + i];
  __syncthreads();
  for (int j = 0; j < 8; ++j) {
    const int idx = t + 256 * j, pc = idx >> 7;
    const float* kp = subk + (size_t)idx * 64;
    float s = 0.f;
    for (int d = 0; d < 64; ++d) s += qs[pc * 64 + d] * kp[d];
    sc[idx] = s;
  }
  __syncthreads();
  if (t < 16) {
    for (int k = 0; k < 16; ++k) {
      float best = -3.0e38f; int bi = 0;
      for (int n = 0; n < 128; ++n) { const float v = sc[t * 128 + n]; if (v > best) { best = v; bi = n; } }
      tops[t][k] = best; topi[t][k] = bi; sc[t * 128 + bi] = -3.0e38f;
    }
  }
  __syncthreads();
  {
    const int p = t >> 5;
    for (int j = 0; j < 8; ++j) {
      const int ci = (t & 31) * 8 + j, a = ci >> 4, bb = ci & 15;
      cand[p][ci] = tops[2 * p][a] + tops[2 * p + 1][bb];
    }
  }
  __syncthreads();
  if (t < 8) {
    float ts[16]; int ti[16];
#pragma unroll
    for (int k = 0; k < 16; ++k) {
      float best = -3.0e38f; int bi = 0;
      for (int n = 0; n < 256; ++n) { const float v = cand[t][n]; if (v > best) { best = v; bi = n; } }
      ts[k] = best; ti[k] = bi; cand[t][bi] = -3.0e38f;
    }
    float den = 0.f;
    const float smax = ts[0];
#pragma unroll
    for (int k = 0; k < 16; ++k) { ts[k] = __expf(ts[k] - smax); den += ts[k]; }
    const float inv = 1.0f / den;
#pragma unroll
    for (int k = 0; k < 16; ++k) {
      const int a = ti[k] >> 4, bb = ti[k] & 15;
      lidx[(size_t)tok * 128 + t * 16 + k] = topi[2 * t][a] * 128 + topi[2 * t + 1][bb];
      lgate[(size_t)tok * 128 + t * 16 + k] = ts[k] * inv;
    }
  }
}

__device__ __forceinline__ void peer_gather_naive_body(int tok, char* smem, const float* __restrict__ h1, const int* __restrict__ lidx,
                                                         const float* __restrict__ lgate, const float* __restrict__ U,
                                                         const float* __restrict__ V, const float* __restrict__ g2,
                                                         const float* __restrict__ b2, float* __restrict__ y) {
  float* red = (float*)smem;
  float (*part)[4] = (float (*)[4])(smem + 64);
  const int t = threadIdx.x;
  __syncthreads();
  const float4 x = ((const float4*)(h1 + (size_t)tok * D))[t];
  float4 acc = make_float4(0.f, 0.f, 0.f, 0.f);
  for (int j = 0; j < 128; ++j) {
    const int e = lidx[(size_t)tok * 128 + j];
    const float gt = lgate[(size_t)tok * 128 + j];
    const float4 u = ((const float4*)(U + (size_t)e * D))[t];
    float pd = wave_sum(u.x * x.x + u.y * x.y + u.z * x.z + u.w * x.w);
    if ((t & 63) == 0) part[j & 1][t >> 6] = pd;
    __syncthreads();
    const float dot = part[j & 1][0] + part[j & 1][1] + part[j & 1][2] + part[j & 1][3];
    const float w = gt * gelu_tanh(dot);
    const float4 v = ((const float4*)(V + (size_t)e * D))[t];
    acc.x += w * v.x; acc.y += w * v.y; acc.z += w * v.z; acc.w += w * v.w;
  }
  float4 r;
  r.x = ALPHA * x.x + acc.x; r.y = ALPHA * x.y + acc.y; r.z = ALPHA * x.z + acc.z; r.w = ALPHA * x.w + acc.w;
  float mean = block_sum256(r.x + r.y + r.z + r.w, red) * (1.0f / D);
  float dx = r.x - mean, dy = r.y - mean, dz = r.z - mean, dw = r.w - mean;
  float rstd = rsqrtf(block_sum256(dx * dx + dy * dy + dz * dz + dw * dw, red) * (1.0f / D) + LN_EPS);
  float4 gg = ((const float4*)g2)[t], bb = ((const float4*)b2)[t];
  float4 o;
  o.x = dx * rstd * gg.x + bb.x; o.y = dy * rstd * gg.y + bb.y; o.z = dz * rstd * gg.z + bb.z; o.w = dw * rstd * gg.w + bb.w;
  ((float4*)(y + (size_t)tok * D))[t] = o;
}


struct Params {
  const float *x_prompt, *x_sample, *cmk, *cmv, *csk, *csv, *state_ret, *meta_tokens, *ln_in_g, *ln_in_b, *rel_bias, *w_in,
      *w_out, *sinks, *gn_g, *ln1_g, *ln1_b, *peer_wq, *subk, *peer_u, *peer_v, *ln2_g, *ln2_b;
  float* out;
  char* ws;
};

__global__ void __launch_bounds__(256) mega_kernel(Params p) {
  __shared__ __attribute__((aligned(16))) char smem[53248];
  cg::grid_group grid = cg::this_grid();
  const int G = gridDim.x, bid = blockIdx.x;
  bf16_t* hbf = (bf16_t*)(p.ws + W_HBF);
  bf16_t* P = (bf16_t*)(p.ws + W_P);
  float* z = (float*)(p.ws + W_P);
  bf16_t* mixed = (bf16_t*)(p.ws + W_MIXED);
  float* qp = (float*)(p.ws + W_QP);
  int* lidx = (int*)(p.ws + W_LIDX);
  float* lgate = (float*)(p.ws + W_LGATE);
  float* oret = p.out;

  for (int r = bid; r < NROWS; r += G) ln_in_body(r, (float*)smem, p.x_prompt, p.x_sample, p.meta_tokens, p.ln_in_g, p.ln_in_b, hbf);
  grid.sync();
  for (int u = bid; u < 22 * 265; u += G) {
    __syncthreads();
    gemm_naive_body(u % 22, u / 22, smem, ALoadBf16{hbf, D, 0}, p.w_in, NROWS, PW, D, EpiInProj{P, p.out});
  }
  grid.sync();
  for (int u = bid; u < 64 + 528; u += G) {
    if (u < 64) ret_naive_body(u, P, p.state_ret, oret, p.out);
    else attn_naive_body((u - 64) >> 1, (u - 64) & 1, smem, P, p.cmk, p.cmv, p.csk, p.csv, p.rel_bias, p.sinks, mixed);
  }
  grid.sync();
  for (int r = bid; r < NTOK; r += G) ret_gate_body(r, oret, P, p.gn_g, mixed);
  grid.sync();
  for (int u = bid; u < 8 * 264; u += G) {
    __syncthreads();
    gemm_naive_body(u % 8, u / 8, smem, ALoadBf16{mixed, D, 0}, p.w_out, NTOK, D, D, EpiOutProj{hbf, z});
  }
  grid.sync();
  for (int r = bid; r < NTOK; r += G) ln1_body(r, (float*)smem, z, p.ln1_g, p.ln1_b);
  grid.sync();
  for (int u = bid; u < 8 * 264; u += G) {
    __syncthreads();
    gemm_naive_body(u % 8, u / 8, smem, ALoadF32{z, D, 0}, p.peer_wq, NTOK, D, D, EpiPlainF32{qp});
  }
  grid.sync();
  for (int r = bid; r < NTOK; r += G) topk_naive_body(r, smem, qp, p.subk, lidx, lgate);
  grid.sync();
  for (int r = bid; r < NTOK; r += G) peer_gather_naive_body(r, smem, z, lidx, lgate, p.peer_u, p.peer_v, p.ln2_g, p.ln2_b, p.out);
}

}

extern "C" void kernel_launch(void* const* d_in, const int* in_sizes, int n_in, void* d_out, int out_size, void* d_ws,
                              size_t ws_size, hipStream_t stream) {
  static int grid_blocks = 0;
  if (!grid_blocks) {
    int dev = 0, cus = 0, per_cu = 0;
    (void)hipGetDevice(&dev);
    (void)hipDeviceGetAttribute(&cus, hipDeviceAttributeMultiprocessorCount, dev);
    (void)hipOccupancyMaxActiveBlocksPerMultiprocessor(&per_cu, mega_kernel, 256, 0);
    if (per_cu > 2) per_cu = 2;
    if (per_cu < 1) per_cu = 1;
    grid_blocks = cus * per_cu;
  }
  Params p{};
  const float** pp = (const float**)&p;
  for (int i = 0; i < 23; ++i) pp[i] = (const float*)d_in[i];
  p.out = (float*)d_out;
  p.ws = (char*)d_ws;
  void* args[] = {&p};
  hipError_t e = hipLaunchCooperativeKernel((void*)mega_kernel, dim3(grid_blocks), dim3(256), args, 0, stream);
  if (e != hipSuccess) fprintf(stderr, "cooperative launch failed: %s (grid %d)\n", hipGetErrorString(e), grid_blocks);
}
```

```cpp
#include <hip/hip_runtime.h>
#include <hip/hip_cooperative_groups.h>
#include <stdint.h>
#include <cstdio>
namespace cg = cooperative_groups;

namespace {

constexpr int D = 1024;
constexpr int NB = 8, SEQ = 2048, DSEQ = 64;
constexpr int NPROMPT = NB * SEQ;
constexpr int NSAMPLE = NB * DSEQ;
constexpr int NTOK = NPROMPT + NSAMPLE;
constexpr int NMETA = 16;
constexpr int NROWS = NTOK + NMETA;
constexpr int PW = 2816;
constexpr float LN_EPS = 1e-5f;
constexpr float ALPHA = 1.18920711500272f;

constexpr size_t O_Y = 0;
constexpr size_t O_METAK = 17301504;
constexpr size_t O_METAV = O_METAK + 16384;
constexpr size_t O_SWAKP = O_METAV + 16384;
constexpr size_t O_SWAVP = O_SWAKP + 131072;
constexpr size_t O_RETP = O_SWAVP + 131072;
constexpr size_t O_SWAKS = O_RETP + 524288;
constexpr size_t O_SWAVS = O_SWAKS + 65536;
constexpr size_t O_RETS = O_SWAVS + 65536;

constexpr size_t W_HBF = 0;
constexpr size_t W_P = W_HBF + (size_t)NROWS * D * 2;
constexpr size_t W_MIXED = W_P + (size_t)NROWS * PW * 2;
constexpr size_t W_LIDX = W_MIXED + (size_t)NTOK * D * 2;
constexpr size_t W_LGATE = W_LIDX + (size_t)NTOK * 128 * 4;
constexpr size_t W_WTIN = W_LGATE + (size_t)NTOK * 128 * 4;
constexpr size_t W_WTOUT = W_WTIN + (size_t)PW * D * 2;
constexpr size_t W_WTQ = W_WTOUT + (size_t)D * D * 2;
constexpr size_t W_ROPE = W_WTQ + (size_t)D * D * 2;
constexpr size_t W_U8 = W_ROPE + (size_t)2128 * 64 * 8;
constexpr size_t W_V8 = W_U8 + (size_t)16384 * 1024;
constexpr size_t W_SU = W_V8 + (size_t)16384 * 1024;
constexpr size_t W_SV = W_SU + 65536;
constexpr size_t W_XQ = W_SV + 65536;
constexpr size_t W_XS = W_XQ + (size_t)NTOK * 1024;
constexpr size_t W_SUBK = W_XS + (size_t)NTOK * 4 + 256;
constexpr size_t W_END = W_SUBK + 131072 * 2;
static_assert(W_END <= (size_t)256 * 1024 * 1024, "workspace overflow");

typedef uint16_t bf16_t;

__device__ __forceinline__ bf16_t f2bf(float f) {
  uint32_t u = __float_as_uint(f);
  u += 0x7FFFu + ((u >> 16) & 1u);
  return (bf16_t)(u >> 16);
}
__device__ __forceinline__ float bf2f(bf16_t h) { return __uint_as_float(((uint32_t)h) << 16); }

__device__ __forceinline__ int row_pos(int r) {
  if (r < NPROMPT) return 16 + (r & 2047);
  if (r < NTOK) return 16 + 2048 + ((r - NPROMPT) & 63);
  return r - NTOK;
}

__device__ __forceinline__ float wave_sum(float v) {
#pragma unroll
  for (int o = 32; o > 0; o >>= 1) v += __shfl_xor(v, o);
  return v;
}

__device__ __forceinline__ float block_sum256(float v, float* red) {
  v = wave_sum(v);
  __syncthreads();
  if ((threadIdx.x & 63) == 0) red[threadIdx.x >> 6] = v;
  __syncthreads();
  return red[0] + red[1] + red[2] + red[3];
}

__device__ __forceinline__ int t5_bucket(int rel) {
  int n = rel < 0 ? -rel : rel;
  int b;
  if (n < 8) b = n;
  else {
    int l = 2 + 31 - __clz(n * n);
    b = l > 15 ? 15 : l;
  }
  return (rel > 0 ? 16 : 0) + b;
}

__device__ __forceinline__ float gelu_tanh(float x) {
  float u = 0.7978845608028654f * (x + 0.044715f * x * x * x);
  return 0.5f * x * (1.0f + tanhf(u));
}

__device__ __forceinline__ void ln_in_body(int r, float* red, const float* __restrict__ xp, const float* __restrict__ xs,
                                                    const float* __restrict__ meta, const float* __restrict__ g,
                                                    const float* __restrict__ b, bf16_t* __restrict__ hbf) {
  const int t = threadIdx.x;
  const float* src = r < NPROMPT ? xp + (size_t)r * D : (r < NTOK ? xs + (size_t)(r - NPROMPT) * D : meta + (size_t)(r - NTOK) * D);
  float4 v = ((const float4*)src)[t];
  float s = block_sum256(v.x + v.y + v.z + v.w, red);
  float mean = s * (1.0f / D);
  float dx = v.x - mean, dy = v.y - mean, dz = v.z - mean, dw = v.w - mean;
  float q = block_sum256(dx * dx + dy * dy + dz * dz + dw * dw, red);
  float rstd = rsqrtf(q * (1.0f / D) + LN_EPS);
  float4 gg = ((const float4*)g)[t], bb = ((const float4*)b)[t];
  ushort4 o;
  o.x = f2bf(dx * rstd * gg.x + bb.x);
  o.y = f2bf(dy * rstd * gg.y + bb.y);
  o.z = f2bf(dz * rstd * gg.z + bb.z);
  o.w = f2bf(dw * rstd * gg.w + bb.w);
  ((ushort4*)(hbf + (size_t)r * D))[t] = o;
}

struct ALoadBf16 {
  const bf16_t* A; int lda; int pad;
  __device__ __forceinline__ float operator()(int r, int k) const { return bf2f(A[(size_t)r * lda + k]); }
};
struct ALoadF32 {
  const float* A; int lda; int pad;
  __device__ __forceinline__ float operator()(int r, int k) const { return A[(size_t)r * lda + k]; }
};

template <class AL, class EPI>
__device__ __forceinline__ void gemm_naive_body(int bx, int by, char* smem, AL al, const float* __restrict__ W, int M, int N, int K, EPI epi) {
  float (*As)[68] = (float (*)[68])smem;
  float (*Bs)[128] = (float (*)[128])(smem + 16 * 68 * 4);
  const int t = threadIdx.x, tx = t & 15, ty = t >> 4;
  const int m0 = by * 64, n0 = bx * 128;
  float acc[4][8];
#pragma unroll
  for (int i = 0; i < 4; ++i)
#pragma unroll
    for (int j = 0; j < 8; ++j) acc[i][j] = 0.f;
  for (int k0 = 0; k0 < K; k0 += 16) {
#pragma unroll
    for (int e = 0; e < 4; ++e) {
      int idx = t + e * 256;
      int r = idx >> 4, kk = idx & 15;
      int gr = m0 + r;
      As[kk][r] = gr < M ? al(gr, k0 + kk) : 0.f;
    }
#pragma unroll
    for (int e = 0; e < 8; ++e) {
      int idx = t + e * 256;
      int kk = idx >> 7, n = idx & 127;
      Bs[kk][n] = W[(size_t)(k0 + kk) * N + n0 + n];
    }
    __syncthreads();
#pragma unroll
    for (int kk = 0; kk < 16; ++kk) {
      float a[4], b[8];
#pragma unroll
      for (int i = 0; i < 4; ++i) a[i] = As[kk][ty * 4 + i];
#pragma unroll
      for (int j = 0; j < 4; ++j) { b[j] = Bs[kk][tx * 4 + j]; b[4 + j] = Bs[kk][64 + tx * 4 + j]; }
#pragma unroll
      for (int i = 0; i < 4; ++i)
#pragma unroll
        for (int j = 0; j < 8; ++j) acc[i][j] += a[i] * b[j];
    }
    __syncthreads();
  }
#pragma unroll
  for (int i = 0; i < 4; ++i) {
    int r = m0 + ty * 4 + i;
    if (r < M) epi(r, bx, tx * 4, acc[i]);
  }
}

struct EpiInProj {
  bf16_t* P; float* out;
  __device__ __forceinline__ void operator()(int r, int nt, int c, const float (&v)[8]) const {
    bf16_t* prow = P + (size_t)r * PW + nt * 128;
    float o[8];
#pragma unroll
    for (int j = 0; j < 8; ++j) o[j] = v[j];
    if (nt >= 6 && nt < 14) {
      const float pos = (float)row_pos(r);
      const float sc = nt >= 10 ? 0.08838834764831845f : 1.0f;
#pragma unroll
      for (int j = 0; j < 4; ++j) {
        const int d = c + j;
        const float inv = powf(10000.0f, -(float)d / 64.0f);
        const float ang = pos * inv;
        float sn, cs;
        sincosf(ang, &sn, &cs);
        o[j] = (v[j] * cs - v[4 + j] * sn) * sc;
        o[4 + j] = (v[j] * sn + v[4 + j] * cs) * sc;
      }
    }
#pragma unroll
    for (int j = 0; j < 4; ++j) { prow[c + j] = f2bf(o[j]); prow[64 + c + j] = f2bf(o[4 + j]); }
    if (nt == 4 || nt == 5) {
      const bool isv = nt == 5;
#pragma unroll
      for (int jj = 0; jj < 8; ++jj) {
        const int col = (jj < 4) ? c + jj : 64 + c + (jj - 4);
        const float val = v[jj];
        if (r < NPROMPT) {
          const int b = r >> 11, s = r & 2047;
          if (s >= SEQ - 128) out[(isv ? O_SWAVP : O_SWAKP) + (size_t)(b * 128 + (s - (SEQ - 128))) * 128 + col] = val;
        } else if (r < NTOK) {
          out[(isv ? O_SWAVS : O_SWAKS) + (size_t)(r - NPROMPT) * 128 + col] = val;
        } else {
          const int m = r - NTOK;
          for (int b = 0; b < NB; ++b) out[(isv ? O_METAV : O_METAK) + (size_t)(b * 16 + m) * 128 + col] = val;
        }
      }
    }
  }
};

struct EpiOutProj {
  const bf16_t* hbf; float* z;
  __device__ __forceinline__ void operator()(int r, int nt, int c, const float (&v)[8]) const {
    const size_t base = (size_t)r * D + nt * 128;
#pragma unroll
    for (int j = 0; j < 4; ++j) {
      z[base + c + j] = ALPHA * bf2f(hbf[base + c + j]) + v[j];
      z[base + 64 + c + j] = ALPHA * bf2f(hbf[base + 64 + c + j]) + v[4 + j];
    }
  }
};

struct EpiPlainF32 {
  float* C;
  __device__ __forceinline__ void operator()(int r, int nt, int c, const float (&v)[8]) const {
    const size_t base = (size_t)r * D + nt * 128;
#pragma unroll
    for (int j = 0; j < 4; ++j) { C[base + c + j] = v[j]; C[base + 64 + c + j] = v[4 + j]; }
  }
};

__device__ __forceinline__ void attn_naive_body(int u, int kvh, char* smem, const bf16_t* __restrict__ P, const float* __restrict__ cmk,
                                                  const float* __restrict__ cmv, const float* __restrict__ csk,
                                                  const float* __restrict__ csv, const float* __restrict__ rel_bias,
                                                  const float* __restrict__ sinks, bf16_t* __restrict__ mixed) {
  bf16_t* Ks = (bf16_t*)smem;
  bf16_t* Vs = Ks + 208 * 64;
  const int t = threadIdx.x;
  __syncthreads();
  const bool samp = u >= 256;
  const int b = samp ? u - 256 : u >> 5, c = samp ? 32 : (u & 31);
  for (int idx = t; idx < 208 * 64; idx += 256) {
    const int key = idx >> 6, d = idx & 63;
    float kf = 0.f, vf = 0.f;
    if (key < 16) {
      if (samp) {
        kf = cmk[((size_t)(b * 16 + key) * 2 + kvh) * 64 + d];
        vf = cmv[((size_t)(b * 16 + key) * 2 + kvh) * 64 + d];
      } else {
        const bf16_t* pr = P + (size_t)(NTOK + key) * PW;
        kf = bf2f(pr[512 + kvh * 64 + d]);
        vf = bf2f(pr[640 + kvh * 64 + d]);
      }
    } else {
      const int jb = key - 16;
      if (samp) {
        if (jb < 128) {
          kf = csk[((size_t)(b * 128 + jb) * 2 + kvh) * 64 + d];
          vf = csv[((size_t)(b * 128 + jb) * 2 + kvh) * 64 + d];
        } else {
          const bf16_t* pr = P + (size_t)(NPROMPT + b * 64 + (jb - 128)) * PW;
          kf = bf2f(pr[512 + kvh * 64 + d]);
          vf = bf2f(pr[640 + kvh * 64 + d]);
        }
      } else {
        const int f = (c - 2) * 64 + jb;
        if (f >= 0) {
          const bf16_t* pr = P + (size_t)(b * SEQ + f) * PW;
          kf = bf2f(pr[512 + kvh * 64 + d]);
          vf = bf2f(pr[640 + kvh * 64 + d]);
        }
      }
    }
    Ks[idx] = f2bf(kf);
    Vs[idx] = f2bf(vf);
  }
  __syncthreads();
  const int g = t >> 6, i = t & 63, H = kvh * 4 + g;
  const int row = samp ? NPROMPT + b * 64 + i : b * SEQ + c * 64 + i;
  const int posq = 16 + c * 64 + i;
  float q[64], acc[64];
  {
    const bf16_t* qp = P + (size_t)row * PW + H * 64;
#pragma unroll
    for (int d = 0; d < 64; ++d) { q[d] = bf2f(qp[d]); acc[d] = 0.f; }
  }
  float m = sinks[H], l = 1.0f;
  for (int key = 0; key < 208; ++key) {
    int rel;
    bool ok = true;
    if (key < 16) rel = key - posq;
    else {
      const int jb = key - 16;
      rel = jb - 128 - i;
      if (!samp && (c - 2) * 64 + jb < 0) ok = false;
    }
    if (!ok) continue;
    float s = 0.f;
#pragma unroll
    for (int d = 0; d < 64; ++d) s += q[d] * bf2f(Ks[key * 64 + d]);
    s = s * 0.125f + rel_bias[t5_bucket(rel) * 8 + H];
    if (s > m) {
      const float f = __expf(m - s);
      l *= f;
#pragma unroll
      for (int d = 0; d < 64; ++d) acc[d] *= f;
      m = s;
    }
    const float p = __expf(s - m);
    l += p;
#pragma unroll
    for (int d = 0; d < 64; ++d) acc[d] += p * bf2f(Vs[key * 64 + d]);
  }
  const float invl = 1.0f / l;
  bf16_t* op = mixed + (size_t)row * D + H * 64;
#pragma unroll
  for (int d = 0; d < 64; ++d) op[d] = f2bf(acc[d] * invl);
}

__device__ __forceinline__ void ret_naive_body(int unit, const bf16_t* __restrict__ P, const float* __restrict__ state_in,
                                                 float* __restrict__ oret, float* __restrict__ out) {
  const int t = threadIdx.x, e = t >> 1, half = t & 1;
  const bool samp = unit >= 32;
  const int bh = unit & 31, b = bh >> 2, h = bh & 3;
  const float gamma = 1.0f - exp2f(-5.0f - (float)h);
  float S[64];
  if (samp) {
#pragma unroll
    for (int dd = 0; dd < 64; ++dd) S[dd] = state_in[((size_t)(b * 4 + h) * 128 + half * 64 + dd) * 128 + e];
  } else {
#pragma unroll
    for (int dd = 0; dd < 64; ++dd) S[dd] = 0.f;
  }
  const int ntok = samp ? 64 : 16 + SEQ;
  for (int it = 0; it < ntok; ++it) {
    int row;
    bool emit = true;
    if (samp) row = NPROMPT + b * 64 + it;
    else if (it < 16) { row = NTOK + it; emit = false; }
    else row = b * SEQ + (it - 16);
    const bf16_t* pr = P + (size_t)row * PW;
    const float v = bf2f(pr[1792 + h * 128 + e]);
    const bf16_t* qp = pr + 768 + h * 128 + half * 64;
    const bf16_t* kp = pr + 1280 + h * 128 + half * 64;
    float o = 0.f;
#pragma unroll
    for (int dd = 0; dd < 64; ++dd) {
      S[dd] = gamma * S[dd] + bf2f(kp[dd]) * v;
      o += bf2f(qp[dd]) * S[dd];
    }
    o += __shfl_xor(o, 1);
    if (emit && half == 0) oret[(size_t)row * 512 + h * 128 + e] = o;
  }
  float* so = out + (samp ? O_RETS : O_RETP) + (size_t)(b * 4 + h) * 128 * 128;
#pragma unroll
  for (int dd = 0; dd < 64; ++dd) so[(size_t)(half * 64 + dd) * 128 + e] = S[dd];
}

__device__ __forceinline__ void ret_gate_body(int row, const float* __restrict__ oret, const bf16_t* __restrict__ P,
                                                const float* __restrict__ gn_g, bf16_t* __restrict__ mixed) {
  const int t = threadIdx.x, h = t >> 6, l = t & 63;
  const float a = oret[(size_t)row * 512 + h * 128 + l], bq = oret[(size_t)row * 512 + h * 128 + 64 + l];
  const float mu = wave_sum(a + bq) * (1.0f / 128.0f);
  const float da = a - mu, db = bq - mu;
  const float var = wave_sum(da * da + db * db) * (1.0f / 128.0f);
  const float rstd = rsqrtf(var + LN_EPS);
  const bf16_t* rg = P + (size_t)row * PW + 2304 + h * 128;
  const float g0 = bf2f(rg[l]), g1 = bf2f(rg[64 + l]);
  const float y0 = da * rstd * gn_g[h * 128 + l] * (g0 / (1.0f + __expf(-g0)));
  const float y1 = db * rstd * gn_g[h * 128 + 64 + l] * (g1 / (1.0f + __expf(-g1)));
  mixed[(size_t)row * D + 512 + h * 128 + l] = f2bf(y0);
  mixed[(size_t)row * D + 512 + h * 128 + 64 + l] = f2bf(y1);
}

__device__ __forceinline__ void ln1_body(int r, float* red, float* __restrict__ z, const float* __restrict__ g, const float* __restrict__ b) {
  const int t = threadIdx.x;
  float4 v = ((float4*)(z + (size_t)r * D))[t];
  float mean = block_sum256(v.x + v.y + v.z + v.w, red) * (1.0f / D);
  float dx = v.x - mean, dy = v.y - mean, dz = v.z - mean, dw = v.w - mean;
  float rstd = rsqrtf(block_sum256(dx * dx + dy * dy + dz * dz + dw * dw, red) * (1.0f / D) + LN_EPS);
  float4 gg = ((const float4*)g)[t], bb = ((const float4*)b)[t];
  float4 o;
  o.x = dx * rstd * gg.x + bb.x; o.y = dy * rstd * gg.y + bb.y; o.z = dz * rstd * gg.z + bb.z; o.w = dw * rstd * gg.w + bb.w;
  ((float4*)(z + (size_t)r * D))[t] = o;
}

__device__ __forceinline__ void topk_naive_body(int tok, char* smem, const float* __restrict__ qp, const float* __restrict__ subk,
                                                  int* __restrict__ lidx, float* __restrict__ lgate) {
  float* qs = (float*)smem;
  float* sc = qs + 1024;
  float (*tops)[16] = (float (*)[16])(sc + 2048);
  int (*topi)[16] = (int (*)[16])(sc + 2048 + 256);
  float (*cand)[256] = (float (*)[256])(sc + 2048 + 512);
  const int t = threadIdx.x;
  __syncthreads();
  for (int i = t; i < 1024; i += 256) qs[i] = qp[(size_t)tok * D + i];
  __syncthreads();
  for (int j = 0; j < 8; ++j) {
    const int idx = t + 256 * j, pc = idx >> 7;
    const float* kp = subk + (size_t)idx * 64;
    float s = 0.f;
    for (int d = 0; d < 64; ++d) s += qs[pc * 64 + d] * kp[d];
    sc[idx] = s;
  }
  __syncthreads();
  if (t < 16) {
    for (int k = 0; k < 16; ++k) {
      float best = -3.0e38f; int bi = 0;
      for (int n = 0; n < 128; ++n) { const float v = sc[t * 128 + n]; if (v > best) { best = v; bi = n; } }
      tops[t][k] = best; topi[t][k] = bi; sc[t * 128 + bi] = -3.0e38f;
    }
  }
  __syncthreads();
  {
    const int p = t >> 5;
    for (int j = 0; j < 8; ++j) {
      const int ci = (t & 31) * 8 + j, a = ci >> 4, bb = ci & 15;
      cand[p][ci] = tops[2 * p][a] + tops[2 * p + 1][bb];
    }
  }
  __syncthreads();
  if (t < 8) {
    float ts[16]; int ti[16];
#pragma unroll
    for (int k = 0; k < 16; ++k) {
      float best = -3.0e38f; int bi = 0;
      for (int n = 0; n < 256; ++n) { const float v = cand[t][n]; if (v > best) { best = v; bi = n; } }
      ts[k] = best; ti[k] = bi; cand[t][bi] = -3.0e38f;
    }
    float den = 0.f;
    const float smax = ts[0];
#pragma unroll
    for (int k = 0; k < 16; ++k) { ts[k] = __expf(ts[k] - smax); den += ts[k]; }
    const float inv = 1.0f / den;
#pragma unroll
    for (int k = 0; k < 16; ++k) {
      const int a = ti[k] >> 4, bb = ti[k] & 15;
      lidx[(size_t)tok * 128 + t * 16 + k] = topi[2 * t][a] * 128 + topi[2 * t + 1][bb];
      lgate[(size_t)tok * 128 + t * 16 + k] = ts[k] * inv;
    }
  }
}

__device__ __forceinline__ void peer_gather_naive_body(int tok, char* smem, const float* __restrict__ h1, const int* __restrict__ lidx,
                                                         const float* __restrict__ lgate, const float* __restrict__ U,
                                                         const float* __restrict__ V, const float* __restrict__ g2,
                                                         const float* __restrict__ b2, float* __restrict__ y) {
  float* red = (float*)smem;
  float (*part)[4] = (float (*)[4])(smem + 64);
  const int t = threadIdx.x;
  __syncthreads();
  const float4 x = ((const float4*)(h1 + (size_t)tok * D))[t];
  float4 acc = make_float4(0.f, 0.f, 0.f, 0.f);
  for (int j = 0; j < 128; ++j) {
    const int e = lidx[(size_t)tok * 128 + j];
    const float gt = lgate[(size_t)tok * 128 + j];
    const float4 u = ((const float4*)(U + (size_t)e * D))[t];
    float pd = wave_sum(u.x * x.x + u.y * x.y + u.z * x.z + u.w * x.w);
    if ((t & 63) == 0) part[j & 1][t >> 6] = pd;
    __syncthreads();
    const float dot = part[j & 1][0] + part[j & 1][1] + part[j & 1][2] + part[j & 1][3];
    const float w = gt * gelu_tanh(dot);
    const float4 v = ((const float4*)(V + (size_t)e * D))[t];
    acc.x += w * v.x; acc.y += w * v.y; acc.z += w * v.z; acc.w += w * v.w;
  }
  float4 r;
  r.x = ALPHA * x.x + acc.x; r.y = ALPHA * x.y + acc.y; r.z = ALPHA * x.z + acc.z; r.w = ALPHA * x.w + acc.w;
  float mean = block_sum256(r.x + r.y + r.z + r.w, red) * (1.0f / D);
  float dx = r.x - mean, dy = r.y - mean, dz = r.z - mean, dw = r.w - mean;
  float rstd = rsqrtf(block_sum256(dx * dx + dy * dy + dz * dz + dw * dw, red) * (1.0f / D) + LN_EPS);
  float4 gg = ((const float4*)g2)[t], bb = ((const float4*)b2)[t];
  float4 o;
  o.x = dx * rstd * gg.x + bb.x; o.y = dy * rstd * gg.y + bb.y; o.z = dz * rstd * gg.z + bb.z; o.w = dw * rstd * gg.w + bb.w;
  ((float4*)(y + (size_t)tok * D))[t] = o;
}


typedef short bf16x8 __attribute__((ext_vector_type(8)));
typedef float f32x16 __attribute__((ext_vector_type(16)));
typedef uint32_t u32x4 __attribute__((ext_vector_type(4)));
__device__ __forceinline__ u32x4 make_u32x4_zero() { u32x4 r; r[0] = 0; r[1] = 0; r[2] = 0; r[3] = 0; return r; }

__device__ __forceinline__ uint32_t pack_bf16(float lo, float hi) { return (uint32_t)f2bf(lo) | ((uint32_t)f2bf(hi) << 16); }

__device__ __forceinline__ int tile_off(int row, int c) {
  const int s = row >> 1;
  const int sc = ((row & 1) << 3) | c;
  return s * 256 + ((sc ^ (s & 15)) << 4);
}

template <class EPI>
__device__ __forceinline__ void gemm_mfma_tile(int mt, int nt, char* smem, const bf16_t* __restrict__ A, int M,
                                               const bf16_t* __restrict__ Bt, int K, const EPI& epi) {
  const int t = threadIdx.x, lane = t & 63, wave = t >> 6, r = lane & 31, h = lane >> 5;
  const int m0 = mt * 128, n0 = nt * 128;
  const bf16_t* ag[4];
  const bf16_t* bg[4];
  int woff[4];
#pragma unroll
  for (int i = 0; i < 4; ++i) {
    const int q = t + 256 * i, row = q >> 3, c = q & 7;
    int ar = m0 + row;
    ar = ar < M ? ar : M - 1;
    ag[i] = A + (size_t)ar * K + c * 8;
    bg[i] = Bt + (size_t)(n0 + row) * K + c * 8;
    woff[i] = tile_off(row, c);
  }
  int roff[4];
#pragma unroll
  for (int ks = 0; ks < 4; ++ks) roff[ks] = tile_off(r, ks * 2 + h);
  f32x16 acc[4];
#pragma unroll
  for (int j = 0; j < 4; ++j)
#pragma unroll
    for (int e = 0; e < 16; ++e) acc[j][e] = 0.f;
  u32x4 ra[4], rb[4];
#pragma unroll
  for (int i = 0; i < 4; ++i) { ra[i] = *(const u32x4*)(ag[i]); rb[i] = *(const u32x4*)(bg[i]); }
  __syncthreads();
#pragma unroll
  for (int i = 0; i < 4; ++i) { *(u32x4*)(smem + woff[i]) = ra[i]; *(u32x4*)(smem + 16384 + woff[i]) = rb[i]; }
  __syncthreads();
  const int nk = K >> 6;
  for (int kt = 0; kt < nk; ++kt) {
    char* cur = smem + (kt & 1) * 32768;
    char* nxt = smem + ((kt + 1) & 1) * 32768;
    if (kt + 1 < nk) {
#pragma unroll
      for (int i = 0; i < 4; ++i) { ra[i] = *(const u32x4*)(ag[i] + (kt + 1) * 64); rb[i] = *(const u32x4*)(bg[i] + (kt + 1) * 64); }
    }
    const char* sa = cur + wave * 4096;
    const char* sb = cur + 16384;
#pragma unroll
    for (int ks = 0; ks < 4; ++ks) {
      const bf16x8 af = *(const bf16x8*)(sa + roff[ks]);
#pragma unroll
      for (int j = 0; j < 4; ++j) {
        const bf16x8 bfr = *(const bf16x8*)(sb + j * 4096 + roff[ks]);
        acc[j] = __builtin_amdgcn_mfma_f32_32x32x16_bf16(bfr, af, acc[j], 0, 0, 0);
      }
    }
    if (kt + 1 < nk) {
#pragma unroll
      for (int i = 0; i < 4; ++i) { *(u32x4*)(nxt + woff[i]) = ra[i]; *(u32x4*)(nxt + 16384 + woff[i]) = rb[i]; }
    }
    __syncthreads();
  }
  const int row = m0 + wave * 32 + r;
  if (row < M) epi(row, nt, h, acc, smem);
}

struct EpiInProjM {
  bf16_t* P; float* out; const float2* rope;
  __device__ __forceinline__ void operator()(int row, int nt, int h, f32x16 (&acc)[4], char* smem) const {
    if (nt >= 6 && nt < 14) {
      const float sc = nt >= 10 ? 0.08838834764831845f : 1.0f;
      const float2* rp = rope + (size_t)row_pos(row) * 64;
#pragma unroll
      for (int j = 0; j < 2; ++j)
#pragma unroll
        for (int g = 0; g < 4; ++g)
#pragma unroll
          for (int i = 0; i < 4; ++i) {
            const float2 cs = rp[j * 32 + 8 * g + 4 * h + i];
            const float x1 = acc[j][4 * g + i], x2 = acc[j + 2][4 * g + i];
            acc[j][4 * g + i] = (x1 * cs.x - x2 * cs.y) * sc;
            acc[j + 2][4 * g + i] = (x1 * cs.y + x2 * cs.x) * sc;
          }
    }
    bf16_t* prow = P + (size_t)row * PW + nt * 128 + 4 * h;
#pragma unroll
    for (int j = 0; j < 4; ++j)
#pragma unroll
      for (int g = 0; g < 4; ++g) {
        uint2 w;
        w.x = pack_bf16(acc[j][4 * g], acc[j][4 * g + 1]);
        w.y = pack_bf16(acc[j][4 * g + 2], acc[j][4 * g + 3]);
        *(uint2*)(prow + j * 32 + 8 * g) = w;
      }
    if (nt == 4 || nt == 5) {
      const bool isv = nt == 5;
#pragma unroll
      for (int j = 0; j < 4; ++j)
#pragma unroll
        for (int g = 0; g < 4; ++g) {
          const int col = j * 32 + 8 * g + 4 * h;
          const float4 val = make_float4(acc[j][4 * g], acc[j][4 * g + 1], acc[j][4 * g + 2], acc[j][4 * g + 3]);
          if (row < NPROMPT) {
            const int b = row >> 11, sidx = row & 2047;
            if (sidx >= SEQ - 128) *(float4*)(out + (isv ? O_SWAVP : O_SWAKP) + (size_t)(b * 128 + (sidx - (SEQ - 128))) * 128 + col) = val;
          } else if (row < NTOK) {
            *(float4*)(out + (isv ? O_SWAVS : O_SWAKS) + (size_t)(row - NPROMPT) * 128 + col) = val;
          } else {
            const int m = row - NTOK;
            for (int b = 0; b < NB; ++b) *(float4*)(out + (isv ? O_METAV : O_METAK) + (size_t)(b * 16 + m) * 128 + col) = val;
          }
        }
    }
  }
};

struct EpiOutProjM {
  const bf16_t* hbf; float* z;
  __device__ __forceinline__ void operator()(int row, int nt, int h, f32x16 (&acc)[4], char* smem) const {
    const size_t base = (size_t)row * D + nt * 128 + 4 * h;
#pragma unroll
    for (int j = 0; j < 4; ++j)
#pragma unroll
      for (int g = 0; g < 4; ++g) {
        const uint2 hv = *(const uint2*)(hbf + base + j * 32 + 8 * g);
        float4 o;
        o.x = ALPHA * __uint_as_float(hv.x << 16) + acc[j][4 * g];
        o.y = ALPHA * __uint_as_float(hv.x & 0xffff0000u) + acc[j][4 * g + 1];
        o.z = ALPHA * __uint_as_float(hv.y << 16) + acc[j][4 * g + 2];
        o.w = ALPHA * __uint_as_float(hv.y & 0xffff0000u) + acc[j][4 * g + 3];
        *(float4*)(z + base + j * 32 + 8 * g) = o;
      }
  }
};

struct EpiPlainF32M {
  float* C;
  __device__ __forceinline__ void operator()(int row, int nt, int h, f32x16 (&acc)[4], char* smem) const {
    const size_t base = (size_t)row * D + nt * 128 + 4 * h;
#pragma unroll
    for (int j = 0; j < 4; ++j)
#pragma unroll
      for (int g = 0; g < 4; ++g)
        *(float4*)(C + base + j * 32 + 8 * g) = make_float4(acc[j][4 * g], acc[j][4 * g + 1], acc[j][4 * g + 2], acc[j][4 * g + 3]);
  }
};


constexpr int NET16[63][2] = {{0,1}, {2,3}, {0,2}, {1,3}, {1,2}, {4,5}, {6,7}, {4,6}, {5,7}, {5,6}, {0,4}, {2,6}, {2,4}, {1,5}, {3,7}, {3,5}, {1,2}, {3,4}, {5,6}, {8,9}, {10,11}, {8,10}, {9,11}, {9,10}, {12,13}, {14,15}, {12,14}, {13,15}, {13,14}, {8,12}, {10,14}, {10,12}, {9,13}, {11,15}, {11,13}, {9,10}, {11,12}, {13,14}, {0,8}, {4,12}, {4,8}, {2,10}, {6,14}, {6,10}, {2,4}, {6,8}, {10,12}, {1,9}, {5,13}, {5,9}, {3,11}, {7,15}, {7,11}, {3,5}, {7,9}, {11,13}, {1,2}, {3,4}, {5,6}, {7,8}, {9,10}, {11,12}, {13,14}};
constexpr int CLEAN16[32][2] = {{0,8}, {1,9}, {2,10}, {3,11}, {4,12}, {5,13}, {6,14}, {7,15}, {0,4}, {1,5}, {2,6}, {3,7}, {8,12}, {9,13}, {10,14}, {11,15}, {0,2}, {1,3}, {4,6}, {5,7}, {8,10}, {9,11}, {12,14}, {13,15}, {0,1}, {2,3}, {4,5}, {6,7}, {8,9}, {10,11}, {12,13}, {14,15}};
constexpr int CAND_REST[34][2] = {{1,0}, {1,1}, {1,2}, {1,3}, {1,4}, {1,5}, {1,6}, {1,7}, {2,0}, {2,1}, {2,2}, {2,3}, {2,4}, {3,0}, {3,1}, {3,2}, {3,3}, {4,0}, {4,1}, {4,2}, {5,0}, {5,1}, {6,0}, {6,1}, {7,0}, {7,1}, {8,0}, {9,0}, {10,0}, {11,0}, {12,0}, {13,0}, {14,0}, {15,0}};
#define CE_DESC(a, b) { const int hi_ = max(a, b), lo_ = min(a, b); a = hi_; b = lo_; }
__device__ __forceinline__ void sort16_desc(int (&x)[16]) {
#pragma unroll
  for (int t = 0; t < 63; ++t) CE_DESC(x[NET16[t][0]], x[NET16[t][1]])
}
__device__ __forceinline__ void merge_top16(int (&a)[16], const int (&b)[16]) {
#pragma unroll
  for (int i = 0; i < 16; ++i) a[i] = max(a[i], b[15 - i]);
#pragma unroll
  for (int t = 0; t < 32; ++t) CE_DESC(a[CLEAN16[t][0]], a[CLEAN16[t][1]])
}
__device__ __forceinline__ int f2ord(float f) { const int b = __float_as_int(f); return b ^ ((b >> 31) & 0x7FFFFFFF); }
__device__ __forceinline__ float ord2f(int k) { return __int_as_float(k ^ ((k >> 31) & 0x7FFFFFFF)); }

struct EpiTopK {
  const bf16_t* subk;
  int* lidx; float* lgate;
  __device__ __forceinline__ void operator()(int row, int p, int h, f32x16 (&acc)[4], char* smem) const {
    const int lane = threadIdx.x & 63, wave = threadIdx.x >> 6, r = lane & 31;
    char* qw = smem + wave * 16384;
    int* sl = (int*)(smem + wave * 16384 + 8192);
#pragma unroll
    for (int j = 0; j < 4; ++j)
#pragma unroll
      for (int g = 0; g < 4; ++g) {
        uint2 w;
        w.x = pack_bf16(acc[j][4 * g], acc[j][4 * g + 1]);
        w.y = pack_bf16(acc[j][4 * g + 2], acc[j][4 * g + 3]);
        *(uint2*)(qw + r * 256 + (((4 * j + g) ^ (r & 15)) << 4) + 8 * h) = w;
      }
    int S[2][16];
#pragma unroll
    for (int c = 0; c < 2; ++c) {
      f32x16 sc[4];
#pragma unroll
      for (int mi = 0; mi < 4; ++mi)
#pragma unroll
        for (int e = 0; e < 16; ++e) sc[mi][e] = 0.f;
      const bf16_t* kb = subk + (size_t)((p * 2 + c) * 128 + r) * 64 + 8 * h;
#pragma unroll
      for (int ks = 0; ks < 4; ++ks) {
        const bf16x8 qf = *(const bf16x8*)(qw + r * 256 + (((8 * c + 2 * ks + h) ^ (r & 15)) << 4));
#pragma unroll
        for (int mi = 0; mi < 4; ++mi) {
          const bf16x8 kf = *(const bf16x8*)(kb + mi * 32 * 64 + ks * 16);
          sc[mi] = __builtin_amdgcn_mfma_f32_32x32x16_bf16(kf, qf, sc[mi], 0, 0, 0);
        }
      }
      int L[16];
#pragma unroll
      for (int mi = 0; mi < 4; ++mi) {
        int x[16];
#pragma unroll
        for (int e = 0; e < 16; ++e) x[e] = (f2ord(sc[mi][e]) & ~127) | (32 * mi + (e & 3) + 8 * (e >> 2) + 4 * h);
        sort16_desc(x);
        if (mi == 0) {
#pragma unroll
          for (int e = 0; e < 16; ++e) L[e] = x[e];
        } else merge_top16(L, x);
      }
      int Pn[16];
#pragma unroll
      for (int e = 0; e < 16; ++e) Pn[e] = __shfl_xor(L[e], 32);
      merge_top16(L, Pn);
#pragma unroll
      for (int e = 0; e < 16; ++e) { S[c][e] = L[e]; sl[(c * 16 + e) * 64 + lane] = L[e]; }
    }
    float f0[16], f1[16];
#pragma unroll
    for (int e = 0; e < 16; ++e) { f0[e] = ord2f(S[0][e]); f1[e] = ord2f(S[1][e]); }
    int T[16];
#pragma unroll
    for (int b = 0; b < 16; ++b) T[b] = (f2ord(f0[0] + f1[b]) & ~255) | (15 - b);
#pragma unroll
    for (int gi = 0; gi < 3; ++gi) {
      int x[16];
#pragma unroll
      for (int e = 0; e < 16; ++e) {
        const int ci = gi * 16 + e;
        if (ci < 34) x[e] = (f2ord(f0[CAND_REST[ci][0]] + f1[CAND_REST[ci][1]]) & ~255) | (CAND_REST[ci][0] << 4) | (15 - CAND_REST[ci][1]);
        else x[e] = (int)0x80000000;
      }
      sort16_desc(x);
      merge_top16(T, x);
    }
    float ev[16], den = 0.f;
    const float vmax = ord2f(T[0]);
#pragma unroll
    for (int k = 0; k < 16; ++k) { ev[k] = __expf(ord2f(T[k]) - vmax); den += ev[k]; }
    const float inv = 1.0f / den;
    int eo[16];
#pragma unroll
    for (int k = 0; k < 16; ++k) {
      const int ab = T[k] & 255;
      const int i1 = sl[(ab >> 4) * 64 + lane] & 127, i2 = sl[(16 + 15 - (ab & 15)) * 64 + lane] & 127;
      eo[k] = i1 * 128 + i2;
    }
    if (h == 0) {
      int* lp = lidx + (size_t)row * 128 + p * 16;
      float* gp = lgate + (size_t)row * 128 + p * 16;
#pragma unroll
      for (int q = 0; q < 4; ++q) {
        *(int4*)(lp + 4 * q) = make_int4(eo[4 * q], eo[4 * q + 1], eo[4 * q + 2], eo[4 * q + 3]);
        *(float4*)(gp + 4 * q) = make_float4(ev[4 * q] * inv, ev[4 * q + 1] * inv, ev[4 * q + 2] * inv, ev[4 * q + 3] * inv);
      }
    }
  }
};

__device__ __forceinline__ void transpose_tile(int kt, int ntile, char* smem, const float* __restrict__ W, int N, int K, bf16_t* __restrict__ Wt) {
  float (*T)[65] = (float (*)[65])smem;
  const int t = threadIdx.x;
  __syncthreads();
#pragma unroll
  for (int pss = 0; pss < 4; ++pss) {
    const int kk = pss * 16 + (t >> 4), nn = (t & 15) * 4;
    const float4 v = *(const float4*)(W + (size_t)(kt * 64 + kk) * N + ntile * 64 + nn);
    T[kk][nn] = v.x; T[kk][nn + 1] = v.y; T[kk][nn + 2] = v.z; T[kk][nn + 3] = v.w;
  }
  __syncthreads();
#pragma unroll
  for (int pss = 0; pss < 4; ++pss) {
    const int nn = pss * 16 + (t >> 4), kk = (t & 15) * 4;
    uint2 w;
    w.x = pack_bf16(T[kk][nn], T[kk + 1][nn]);
    w.y = pack_bf16(T[kk + 2][nn], T[kk + 3][nn]);
    *(uint2*)(Wt + (size_t)(ntile * 64 + nn) * K + kt * 64 + kk) = w;
  }
}

__device__ __forceinline__ void ln1_body2(int r, float* red, float* __restrict__ z, const float* __restrict__ g, const float* __restrict__ b, bf16_t* __restrict__ h1bf) {
  const int t = threadIdx.x;
  float4 v = ((float4*)(z + (size_t)r * D))[t];
  float mean = block_sum256(v.x + v.y + v.z + v.w, red) * (1.0f / D);
  float dx = v.x - mean, dy = v.y - mean, dz = v.z - mean, dw = v.w - mean;
  float rstd = rsqrtf(block_sum256(dx * dx + dy * dy + dz * dz + dw * dw, red) * (1.0f / D) + LN_EPS);
  float4 gg = ((const float4*)g)[t], bb = ((const float4*)b)[t];
  float4 o;
  o.x = dx * rstd * gg.x + bb.x; o.y = dy * rstd * gg.y + bb.y; o.z = dz * rstd * gg.z + bb.z; o.w = dw * rstd * gg.w + bb.w;
  ((float4*)(z + (size_t)r * D))[t] = o;
  uint2 w;
  w.x = pack_bf16(o.x, o.y); w.y = pack_bf16(o.z, o.w);
  ((uint2*)(h1bf + (size_t)r * D))[t] = w;
}


__device__ __forceinline__ float wave_max(float v) {
#pragma unroll
  for (int o = 32; o > 0; o >>= 1) v = fmaxf(v, __shfl_xor(v, o));
  return v;
}

__device__ __forceinline__ float quant_row_regs(const float4 (&v)[4], int lane, uint8_t* __restrict__ dst, bool biased) {
  float m = 0.f;
#pragma unroll
  for (int i = 0; i < 4; ++i) m = fmaxf(m, fmaxf(fmaxf(fabsf(v[i].x), fabsf(v[i].y)), fmaxf(fabsf(v[i].z), fabsf(v[i].w))));
  m = wave_max(m);
  const float scale = m * (1.0f / 127.0f);
  const float inv = m > 0.f ? 127.0f / m : 0.f;
  u32x4 w;
#pragma unroll
  for (int i = 0; i < 4; ++i) {
    int a = (int)rintf(v[i].x * inv), b = (int)rintf(v[i].y * inv), c = (int)rintf(v[i].z * inv), d = (int)rintf(v[i].w * inv);
    if (biased) { a += 128; b += 128; c += 128; d += 128; }
    w[i] = (uint32_t)(a & 255) | ((uint32_t)(b & 255) << 8) | ((uint32_t)(c & 255) << 16) | ((uint32_t)(d & 255) << 24);
  }
  *(u32x4*)(dst + lane * 16) = w;
  return scale;
}

__device__ __forceinline__ void quant_table_row(const float* __restrict__ src, int lane, uint8_t* __restrict__ dst, float* __restrict__ sc, bool biased) {
  float4 v[4];
#pragma unroll
  for (int i = 0; i < 4; ++i) v[i] = *(const float4*)(src + 256 * i + 4 * lane);
  const float scale = quant_row_regs(v, lane, dst, biased);
  if (lane == 0) *sc = scale;
}

__device__ __forceinline__ void ln1_row_wave(int r, int lane, float* __restrict__ z, const float* __restrict__ g, const float* __restrict__ b,
                                             bf16_t* __restrict__ h1bf, uint8_t* __restrict__ xq, float* __restrict__ xs) {
  float4 v[4];
  float sum = 0.f;
#pragma unroll
  for (int i = 0; i < 4; ++i) { v[i] = *(const float4*)(z + (size_t)r * D + 256 * i + 4 * lane); sum += (v[i].x + v[i].y) + (v[i].z + v[i].w); }
  const float mean = wave_sum(sum) * (1.0f / D);
  float sq = 0.f;
#pragma unroll
  for (int i = 0; i < 4; ++i) { v[i].x -= mean; v[i].y -= mean; v[i].z -= mean; v[i].w -= mean; sq += (v[i].x * v[i].x + v[i].y * v[i].y) + (v[i].z * v[i].z + v[i].w * v[i].w); }
  const float rstd = rsqrtf(wave_sum(sq) * (1.0f / D) + LN_EPS);
#pragma unroll
  for (int i = 0; i < 4; ++i) {
    const float4 gg = *(const float4*)(g + 256 * i + 4 * lane), bb = *(const float4*)(b + 256 * i + 4 * lane);
    v[i].x = v[i].x * rstd * gg.x + bb.x; v[i].y = v[i].y * rstd * gg.y + bb.y; v[i].z = v[i].z * rstd * gg.z + bb.z; v[i].w = v[i].w * rstd * gg.w + bb.w;
    *(float4*)(z + (size_t)r * D + 256 * i + 4 * lane) = v[i];
    uint2 w;
    w.x = pack_bf16(v[i].x, v[i].y); w.y = pack_bf16(v[i].z, v[i].w);
    *(uint2*)(h1bf + (size_t)r * D + 256 * i + 4 * lane) = w;
  }
  const float scale = quant_row_regs(v, lane, xq + (size_t)r * 1024, false);
  if (lane == 0) xs[r] = scale;
}

struct SweepArgs {
  const int* lidx; const float* lgate; const uint8_t* U8; const uint8_t* V8; const float* su; const float* sv;
  const uint8_t* xq; const float* xs; const float* h1; const float* g2; const float* b2; float* y;
};

#define SW_LDS_PER_WAVE 15872

__device__ __forceinline__ float cvt_ub0(uint32_t d) { return (float)(d & 0xffu); }
__device__ __forceinline__ float cvt_ub1(uint32_t d) { return (float)((d >> 8) & 0xffu); }
__device__ __forceinline__ float cvt_ub2(uint32_t d) { return (float)((d >> 16) & 0xffu); }
__device__ __forceinline__ float cvt_ub3(uint32_t d) { return (float)(d >> 24); }

__device__ __forceinline__ void sw_axpy(f32x16& acc, float& corr, float w, const u32x4& vv) {
#pragma unroll
  for (int q = 0; q < 4; ++q) {
    const uint32_t d = vv[q];
    acc[4 * q + 0] = fmaf(w, cvt_ub0(d), acc[4 * q + 0]);
    acc[4 * q + 1] = fmaf(w, cvt_ub1(d), acc[4 * q + 1]);
    acc[4 * q + 2] = fmaf(w, cvt_ub2(d), acc[4 * q + 2]);
    acc[4 * q + 3] = fmaf(w, cvt_ub3(d), acc[4 * q + 3]);
  }
  corr += w;
}

__device__ __forceinline__ void sw_finish(int tok, int lane, const f32x16& acc, float corr, const SweepArgs& a) {
  float4 v[4];
  float sum = 0.f;
  const float c128 = 128.0f * corr;
#pragma unroll
  for (int i = 0; i < 4; ++i) {
    const float4 hh = *(const float4*)(a.h1 + (size_t)tok * D + 256 * i + 4 * lane);
    v[i].x = ALPHA * hh.x + (acc[4 * i + 0] - c128);
    v[i].y = ALPHA * hh.y + (acc[4 * i + 1] - c128);
    v[i].z = ALPHA * hh.z + (acc[4 * i + 2] - c128);
    v[i].w = ALPHA * hh.w + (acc[4 * i + 3] - c128);
    sum += (v[i].x + v[i].y) + (v[i].z + v[i].w);
  }
  const float mean = wave_sum(sum) * (1.0f / D);
  float sq = 0.f;
#pragma unroll
  for (int i = 0; i < 4; ++i) { v[i].x -= mean; v[i].y -= mean; v[i].z -= mean; v[i].w -= mean; sq += (v[i].x * v[i].x + v[i].y * v[i].y) + (v[i].z * v[i].z + v[i].w * v[i].w); }
  const float rstd = rsqrtf(wave_sum(sq) * (1.0f / D) + LN_EPS);
#pragma unroll
  for (int i = 0; i < 4; ++i) {
    const float4 gg = *(const float4*)(a.g2 + 256 * i + 4 * lane), bb = *(const float4*)(a.b2 + 256 * i + 4 * lane);
    float4 o;
    o.x = v[i].x * rstd * gg.x + bb.x; o.y = v[i].y * rstd * gg.y + bb.y; o.z = v[i].z * rstd * gg.z + bb.z; o.w = v[i].w * rstd * gg.w + bb.w;
    *(float4*)(a.y + (size_t)tok * D + 256 * i + 4 * lane) = o;
  }
}

__device__ __forceinline__ void sw_issue(uint32_t keyv, int lane, const SweepArgs& a, u32x4 (&ub)[8], u32x4 (&vb)[8]) {
#pragma unroll
  for (int r = 0; r < 8; ++r) {
    const uint32_t key = (uint32_t)__builtin_amdgcn_readlane((int)keyv, r);
    const size_t off = (size_t)(key >> 3) * 1024 + lane * 16;
    ub[r] = *(const u32x4*)(a.U8 + off);
    vb[r] = *(const u32x4*)(a.V8 + off);
  }
}

__device__ __forceinline__ void sweep_wave(int tok0, int ntok, int lane, char* lds, const SweepArgs& a) {
  u32x4* list = (u32x4*)lds;
  uint8_t* xl = (uint8_t*)(lds + 10240);
  float* xscl = (float*)(lds + 10240 + 5120);
  const int npairs = ntok * 128;
  __syncthreads();
  for (int sidx = 0; sidx < ntok; ++sidx) *(u32x4*)(xl + sidx * 1024 + lane * 16) = *(const u32x4*)(a.xq + (size_t)(tok0 + sidx) * 1024 + lane * 16);
  if (lane < ntok) xscl[lane] = a.xs[tok0 + lane];
  int K[16];
  {
    const int* lp = a.lidx + (size_t)tok0 * 128;
#pragma unroll
    for (int q = 0; q < 4; ++q) {
      const int i0 = lane * 16 + q * 4;
      int4 e4 = make_int4(0, 0, 0, 0);
      if (i0 < npairs) e4 = *(const int4*)(lp + i0);
      K[4 * q + 0] = i0 < npairs ? ((e4.x << 10) | (i0 + 0)) : 0x7FFFFFFF;
      K[4 * q + 1] = i0 < npairs ? ((e4.y << 10) | (i0 + 1)) : 0x7FFFFFFF;
      K[4 * q + 2] = i0 < npairs ? ((e4.z << 10) | (i0 + 2)) : 0x7FFFFFFF;
      K[4 * q + 3] = i0 < npairs ? ((e4.w << 10) | (i0 + 3)) : 0x7FFFFFFF;
    }
  }
#pragma unroll
  for (int k = 2; k <= 1024; k <<= 1) {
#pragma unroll
    for (int j = k >> 1; j > 0; j >>= 1) {
      if (j >= 16) {
        const int lj = j >> 4;
        const bool upper = (lane & lj) != 0;
        const bool desc = (k < 1024) && ((lane & (k >> 4)) != 0);
        const bool keepmax = upper != desc;
#pragma unroll
        for (int r = 0; r < 16; ++r) {
          const int o = __shfl_xor(K[r], lj);
          const int mn = min(K[r], o), mx = max(K[r], o);
          K[r] = keepmax ? mx : mn;
        }
      } else {
#pragma unroll
        for (int r = 0; r < 16; ++r) {
          if ((r & j) == 0) {
            const int p = r | j;
            const int mn = min(K[r], K[p]), mx = max(K[r], K[p]);
            if (k >= 16) {
              const bool desc = (k < 1024) && ((lane & (k >> 4)) != 0);
              K[r] = desc ? mx : mn; K[p] = desc ? mn : mx;
            } else {
              const bool desc = (r & k) != 0;
              K[r] = desc ? mx : mn; K[p] = desc ? mn : mx;
            }
          }
        }
      }
    }
  }
  __syncthreads();
#pragma unroll
  for (int r = 0; r < 16; ++r) {
    const int i = lane * 16 + r;
    if (i < npairs) {
      const int key = K[r];
      const int e = key >> 10, pid = key & 1023, slot = pid >> 7;
      const float gate = a.lgate[(size_t)tok0 * 128 + pid];
      u32x4 ent;
      ent[0] = ((uint32_t)e << 3) | (uint32_t)slot;
      ent[1] = __float_as_uint(a.su[e] * xscl[slot]);
      ent[2] = __float_as_uint(gate * a.sv[e]);
      ent[3] = 0;
      list[i] = ent;
    }
  }
  __syncthreads();
  f32x16 acc0, acc1, acc2, acc3, acc4;
#pragma unroll
  for (int e = 0; e < 16; ++e) { acc0[e] = 0.f; acc1[e] = 0.f; acc2[e] = 0.f; acc3[e] = 0.f; acc4[e] = 0.f; }
  float corr0 = 0.f, corr1 = 0.f, corr2 = 0.f, corr3 = 0.f, corr4 = 0.f;
  const int nb = npairs >> 3;
  u32x4 uA[8], vA[8], uB[8], vB[8];
  u32x4 entA = make_u32x4_zero(), entB = make_u32x4_zero();
  if (nb > 0) { entA = list[lane & 7]; sw_issue(entA[0], lane, a, uA, vA); }

#define SW_COMPUTE(ENT, UB, VB)                                                                              \
  {                                                                                                          \
    int dsum[8];                                                                                             \
    _Pragma("unroll") for (int r = 0; r < 8; ++r) {                                                          \
      const uint32_t key = (uint32_t)__builtin_amdgcn_readlane((int)ENT[0], r);                              \
      const u32x4 xx = *(const u32x4*)(xl + (key & 7) * 1024 + lane * 16);                                   \
      int dd = __builtin_amdgcn_sdot4((int)UB[r][0], (int)xx[0], 0, false);                                  \
      dd = __builtin_amdgcn_sdot4((int)UB[r][1], (int)xx[1], dd, false);                                     \
      dd = __builtin_amdgcn_sdot4((int)UB[r][2], (int)xx[2], dd, false);                                     \
      dd = __builtin_amdgcn_sdot4((int)UB[r][3], (int)xx[3], dd, false);                                     \
      dsum[r] = dd;                                                                                          \
    }                                                                                                        \
                                              \
    int t4[4], t2[2], t1;                                                                                    \
    _Pragma("unroll") for (int q = 0; q < 4; ++q) {                                                          \
      const bool hi = (lane & 1) != 0;                                                                       \
      const int keep = hi ? dsum[2 * q + 1] : dsum[2 * q], send = hi ? dsum[2 * q] : dsum[2 * q + 1];        \
      t4[q] = keep + __shfl_xor(send, 1);                                                                    \
    }                                                                                                        \
    _Pragma("unroll") for (int q = 0; q < 2; ++q) {                                                          \
      const bool hi = (lane & 2) != 0;                                                                       \
      const int keep = hi ? t4[2 * q + 1] : t4[2 * q], send = hi ? t4[2 * q] : t4[2 * q + 1];                \
      t2[q] = keep + __shfl_xor(send, 2);                                                                    \
    }                                                                                                        \
    {                                                                                                        \
      const bool hi = (lane & 4) != 0;                                                                       \
      const int keep = hi ? t2[1] : t2[0], send = hi ? t2[0] : t2[1];                                        \
      t1 = keep + __shfl_xor(send, 4);                                                                       \
    }                                                                                                        \
    t1 += __shfl_xor(t1, 8); t1 += __shfl_xor(t1, 16); t1 += __shfl_xor(t1, 32);                             \
                               \
    const float pre = (float)t1 * __uint_as_float(ENT[1]);                                                   \
    const float uu = 1.5957691216057308f * (pre + 0.044715f * pre * pre * pre);                              \
    const float act = pre / (1.0f + __expf(-uu));                                                            \
    const float wv = act * __uint_as_float(ENT[2]);                                                          \
    _Pragma("unroll") for (int r = 0; r < 8; ++r) {                                                          \
      const uint32_t key = (uint32_t)__builtin_amdgcn_readlane((int)ENT[0], r);                              \
      const float w = __uint_as_float((uint32_t)__builtin_amdgcn_readlane((int)__float_as_uint(wv), r));     \
      switch (key & 7) {                                                                                     \
        case 0: sw_axpy(acc0, corr0, w, VB[r]); break;                                                       \
        case 1: sw_axpy(acc1, corr1, w, VB[r]); break;                                                       \
        case 2: sw_axpy(acc2, corr2, w, VB[r]); break;                                                       \
        case 3: sw_axpy(acc3, corr3, w, VB[r]); break;                                                       \
        default: sw_axpy(acc4, corr4, w, VB[r]); break;                                                      \
      }                                                                                                      \
    }                                                                                                        \
  }

  for (int bt = 0; bt < nb; bt += 2) {
    if (bt + 1 < nb) { entB = list[(bt + 1) * 8 + (lane & 7)]; sw_issue(entB[0], lane, a, uB, vB); }
    SW_COMPUTE(entA, uA, vA)
    if (bt + 1 < nb) {
      if (bt + 2 < nb) { entA = list[(bt + 2) * 8 + (lane & 7)]; sw_issue(entA[0], lane, a, uA, vA); }
      SW_COMPUTE(entB, uB, vB)
    }
  }
#undef SW_COMPUTE
  if (ntok > 0) sw_finish(tok0 + 0, lane, acc0, corr0, a);
  if (ntok > 1) sw_finish(tok0 + 1, lane, acc1, corr1, a);
  if (ntok > 2) sw_finish(tok0 + 2, lane, acc2, corr2, a);
  if (ntok > 3) sw_finish(tok0 + 3, lane, acc3, corr3, a);
  if (ntok > 4) sw_finish(tok0 + 4, lane, acc4, corr4, a);
}


__device__ __forceinline__ int unit_row0(int u) { return u < 256 ? (u >> 5) * SEQ + (u & 31) * 64 : NPROMPT + (u - 256) * 64; }

__device__ __forceinline__ void stage_T(char* dst, const bf16_t* __restrict__ src, const float* dec) {
  const int t = threadIdx.x, lane = t & 63, wave = t >> 6, tp = lane & 31;
#pragma unroll
  for (int item = 0; item < 2; ++item) {
    const int fc = (lane >> 5) + 2 * wave + 8 * item;
    const u32x4 a = *(const u32x4*)(src + (size_t)(2 * tp) * PW + fc * 8);
    const u32x4 b = *(const u32x4*)(src + (size_t)(2 * tp + 1) * PW + fc * 8);
    float d0 = 1.f, d1 = 1.f;
    if (dec) { d0 = dec[2 * tp]; d1 = dec[2 * tp + 1]; }
#pragma unroll
    for (int q = 0; q < 4; ++q) {
      uint32_t lo, hi;
      if (dec) {
        lo = pack_bf16(__uint_as_float(a[q] << 16) * d0, __uint_as_float(b[q] << 16) * d1);
        hi = pack_bf16(__uint_as_float(a[q] & 0xffff0000u) * d0, __uint_as_float(b[q] & 0xffff0000u) * d1);
      } else {
        lo = (a[q] & 0xffffu) | (b[q] << 16);
        hi = (a[q] >> 16) | (b[q] & 0xffff0000u);
      }
      const int f = fc * 8 + 2 * q;
      *(uint32_t*)(dst + tile_off(f, tp >> 2) + (tp & 3) * 4) = lo;
      *(uint32_t*)(dst + tile_off(f + 1, tp >> 2) + (tp & 3) * 4) = hi;
    }
  }
}

__device__ __forceinline__ void stage_R(char* dst, const bf16_t* __restrict__ src) {
  const int t = threadIdx.x;
#pragma unroll
  for (int i = 0; i < 4; ++i) {
    const int q = t + 256 * i, row = q >> 4, c = q & 15;
    *(u32x4*)(dst + row * 256 + ((c ^ (row & 15)) << 4)) = *(const u32x4*)(src + (size_t)row * PW + c * 8);
  }
}

__device__ __forceinline__ void ret_state_unit(int u, int h, char* smem, const bf16_t* __restrict__ P, float* __restrict__ ST) {
  const int t = threadIdx.x, lane = t & 63, wave = t >> 6, r = lane & 31, hh = lane >> 5;
  char* RKT = smem;
  char* RVT = smem + 16384;
  float* dec = (float*)(smem + 32768);
  const int row0 = unit_row0(u);
  const float lg2 = log2f(1.0f - exp2f(-5.0f - (float)h));
  __syncthreads();
  if (t < 64) dec[t] = exp2f((float)(63 - t) * lg2);
  __syncthreads();
  stage_T(RKT, P + (size_t)row0 * PW + 1280 + h * 128, dec);
  stage_T(RVT, P + (size_t)row0 * PW + 1792 + h * 128, nullptr);
  __syncthreads();
  f32x16 acc[4];
#pragma unroll
  for (int j = 0; j < 4; ++j)
#pragma unroll
    for (int e = 0; e < 16; ++e) acc[j][e] = 0.f;
#pragma unroll
  for (int ks = 0; ks < 4; ++ks) {
    const bf16x8 af = *(const bf16x8*)(RVT + tile_off(32 * wave + r, 2 * ks + hh));
#pragma unroll
    for (int dj = 0; dj < 4; ++dj) {
      const bf16x8 bfr = *(const bf16x8*)(RKT + tile_off(32 * dj + r, 2 * ks + hh));
      acc[dj] = __builtin_amdgcn_mfma_f32_32x32x16_bf16(af, bfr, acc[dj], 0, 0, 0);
    }
  }
  float* o = ST + (size_t)(u * 4 + h) * 16384;
#pragma unroll
  for (int dj = 0; dj < 4; ++dj)
#pragma unroll
    for (int e = 0; e < 16; ++e) {
      const int er = 32 * wave + (e & 3) + 8 * (e >> 2) + 4 * hh;
      o[er * 128 + 32 * dj + r] = acc[dj][e];
    }
}

__device__ __forceinline__ void ret_scan_chain(int ci, const bf16_t* __restrict__ P, const float* __restrict__ state_in, float* __restrict__ ST, float* __restrict__ out) {
  const int d4 = ci & 31, e = (ci >> 5) & 127, h = (ci >> 12) & 3, b = (ci >> 14) & 7, samp = ci >> 17;
  const float gamma = 1.0f - exp2f(-5.0f - (float)h);
  const float g64 = exp2f(64.0f * log2f(gamma));
  float s[4];
  if (samp) {
    float* ptr = ST + ((size_t)((256 + b) * 4 + h) * 128 + e) * 128 + d4 * 4;
    const float4 a = *(const float4*)ptr;
    float sv4[4];
#pragma unroll
    for (int j = 0; j < 4; ++j) sv4[j] = state_in[((size_t)(b * 4 + h) * 128 + d4 * 4 + j) * 128 + e];
    *(float4*)ptr = make_float4(sv4[0], sv4[1], sv4[2], sv4[3]);
    const float av[4] = {a.x, a.y, a.z, a.w};
#pragma unroll
    for (int j = 0; j < 4; ++j) out[O_RETS + ((size_t)(b * 4 + h) * 128 + d4 * 4 + j) * 128 + e] = g64 * sv4[j] + av[j];
    return;
  }
#pragma unroll
  for (int j = 0; j < 4; ++j) s[j] = 0.f;
  for (int k = 0; k < 16; ++k) {
    const bf16_t* pr = P + (size_t)(NTOK + k) * PW;
    const float v = bf2f(pr[1792 + h * 128 + e]);
#pragma unroll
    for (int j = 0; j < 4; ++j) s[j] = gamma * s[j] + bf2f(pr[1280 + h * 128 + d4 * 4 + j]) * v;
  }
  for (int c = 0; c < 32; ++c) {
    float* ptr = ST + ((size_t)((b * 32 + c) * 4 + h) * 128 + e) * 128 + d4 * 4;
    const float4 a = *(const float4*)ptr;
    *(float4*)ptr = make_float4(s[0], s[1], s[2], s[3]);
    s[0] = g64 * s[0] + a.x; s[1] = g64 * s[1] + a.y; s[2] = g64 * s[2] + a.z; s[3] = g64 * s[3] + a.w;
  }
#pragma unroll
  for (int j = 0; j < 4; ++j) out[O_RETP + ((size_t)(b * 4 + h) * 128 + d4 * 4 + j) * 128 + e] = s[j];
}

__device__ __forceinline__ void ret_out_unit(int u, int h, char* smem, const bf16_t* __restrict__ P, const float* __restrict__ ST,
                                             const float* __restrict__ gn_g, bf16_t* __restrict__ mixed) {
  const int t = threadIdx.x, lane = t & 63, wave = t >> 6, r = lane & 31, hh = lane >> 5;
  char* RQ = smem;
  char* RK = smem + 16384;
  char* RVT = smem + 32768;
  char* YL = smem + 49152;
  float* red = (float*)smem;
  const int row0 = unit_row0(u);
  const float lg2 = log2f(1.0f - exp2f(-5.0f - (float)h));
  __syncthreads();
  stage_R(RQ, P + (size_t)row0 * PW + 768 + h * 128);
  stage_R(RK, P + (size_t)row0 * PW + 1280 + h * 128);
  stage_T(RVT, P + (size_t)row0 * PW + 1792 + h * 128, nullptr);
  __syncthreads();
  const int qt = wave & 1, ep = wave >> 1;
  const int q = 32 * qt + r;
  f32x16 X[2];
#pragma unroll
  for (int kt = 0; kt < 2; ++kt) {
#pragma unroll
    for (int e = 0; e < 16; ++e) X[kt][e] = 0.f;
    if (kt <= qt) {
#pragma unroll
      for (int ks = 0; ks < 8; ++ks) {
        const int krow = 32 * kt + r, qrow = 32 * qt + r;
        const bf16x8 kf = *(const bf16x8*)(RK + krow * 256 + (((2 * ks + hh) ^ (krow & 15)) << 4));
        const bf16x8 qf = *(const bf16x8*)(RQ + qrow * 256 + (((2 * ks + hh) ^ (qrow & 15)) << 4));
        X[kt] = __builtin_amdgcn_mfma_f32_32x32x16_bf16(kf, qf, X[kt], 0, 0, 0);
      }
#pragma unroll
      for (int e = 0; e < 16; ++e) {
        const int k = 32 * kt + (e & 3) + 8 * (e >> 2) + 4 * hh;
        X[kt][e] = (q >= k) ? X[kt][e] * exp2f((float)(q - k) * lg2) : 0.f;
      }
    }
  }
  f32x16 O[2];
  const float* Su = ST + (size_t)(u * 4 + h) * 16384;
#pragma unroll
  for (int ei = 0; ei < 2; ++ei) {
#pragma unroll
    for (int e = 0; e < 16; ++e) O[ei][e] = 0.f;
    const int erow = 32 * (2 * ep + ei) + r;
#pragma unroll
    for (int ks = 0; ks < 8; ++ks) {
      const float4 s0 = *(const float4*)(Su + erow * 128 + 16 * ks + 8 * hh);
      const float4 s1 = *(const float4*)(Su + erow * 128 + 16 * ks + 8 * hh + 4);
      u32x4 sp;
      sp[0] = pack_bf16(s0.x, s0.y); sp[1] = pack_bf16(s0.z, s0.w); sp[2] = pack_bf16(s1.x, s1.y); sp[3] = pack_bf16(s1.z, s1.w);
      bf16x8 sf;
      __builtin_memcpy(&sf, &sp, 16);
      const int qrow = 32 * qt + r;
      const bf16x8 qf = *(const bf16x8*)(RQ + qrow * 256 + (((2 * ks + hh) ^ (qrow & 15)) << 4));
      O[ei] = __builtin_amdgcn_mfma_f32_32x32x16_bf16(sf, qf, O[ei], 0, 0, 0);
    }
    const float qd = exp2f((float)(q + 1) * lg2);
#pragma unroll
    for (int e = 0; e < 16; ++e) O[ei][e] *= qd;
  }
#pragma unroll
  for (int kt = 0; kt < 2; ++kt) {
    if (kt <= qt) {
#pragma unroll
      for (int sidx = 0; sidx < 2; ++sidx) {
        u32x4 xp;
#pragma unroll
        for (int j = 0; j < 4; ++j) xp[j] = pack_bf16(X[kt][8 * sidx + 2 * j], X[kt][8 * sidx + 2 * j + 1]);
        bf16x8 xf;
        __builtin_memcpy(&xf, &xp, 16);
#pragma unroll
        for (int ei = 0; ei < 2; ++ei) {
          const int erow = 32 * (2 * ep + ei) + r;
          const uint2 a0 = *(const uint2*)(RVT + tile_off(erow, 4 * kt + 2 * sidx) + 8 * hh);
          const uint2 a1 = *(const uint2*)(RVT + tile_off(erow, 4 * kt + 2 * sidx + 1) + 8 * hh);
          u32x4 ap;
          ap[0] = a0.x; ap[1] = a0.y; ap[2] = a1.x; ap[3] = a1.y;
          bf16x8 af;
          __builtin_memcpy(&af, &ap, 16);
          O[ei] = __builtin_amdgcn_mfma_f32_32x32x16_bf16(af, xf, O[ei], 0, 0, 0);
        }
      }
    }
  }
  float s1 = 0.f, s2 = 0.f;
#pragma unroll
  for (int ei = 0; ei < 2; ++ei)
#pragma unroll
    for (int e = 0; e < 16; ++e) { s1 += O[ei][e]; s2 += O[ei][e] * O[ei][e]; }
  s1 += __shfl_xor(s1, 32);
  s2 += __shfl_xor(s2, 32);
  __syncthreads();
  if (hh == 0) { red[(wave * 32 + r) * 2] = s1; red[(wave * 32 + r) * 2 + 1] = s2; }
  __syncthreads();
  {
    const int pw = wave ^ 2;
    s1 += red[(pw * 32 + r) * 2];
    s2 += red[(pw * 32 + r) * 2 + 1];
  }
  const float mean = s1 * (1.0f / 128.0f);
  const float rstd = rsqrtf(fmaxf(s2 * (1.0f / 128.0f) - mean * mean, 0.f) + LN_EPS);
  const bf16_t* rgp = P + (size_t)(row0 + q) * PW + 2304 + h * 128;
#pragma unroll
  for (int ei = 0; ei < 2; ++ei)
#pragma unroll
    for (int g = 0; g < 4; ++g) {
      const int e0 = 32 * (2 * ep + ei) + 8 * g + 4 * hh;
      const uint2 rg = *(const uint2*)(rgp + e0);
      const float4 gg = *(const float4*)(gn_g + h * 128 + e0);
      const float g0 = __uint_as_float(rg.x << 16), g1 = __uint_as_float(rg.x & 0xffff0000u), g2 = __uint_as_float(rg.y << 16), g3 = __uint_as_float(rg.y & 0xffff0000u);
      const float y0 = (O[ei][4 * g + 0] - mean) * rstd * gg.x * (g0 / (1.0f + __expf(-g0)));
      const float y1 = (O[ei][4 * g + 1] - mean) * rstd * gg.y * (g1 / (1.0f + __expf(-g1)));
      const float y2 = (O[ei][4 * g + 2] - mean) * rstd * gg.z * (g2 / (1.0f + __expf(-g2)));
      const float y3 = (O[ei][4 * g + 3] - mean) * rstd * gg.w * (g3 / (1.0f + __expf(-g3)));
      uint2 w;
      w.x = pack_bf16(y0, y1); w.y = pack_bf16(y2, y3);
      const int c = e0 >> 3;
      *(uint2*)(YL + q * 256 + ((c ^ (q & 15)) << 4) + 8 * hh) = w;
    }
  __syncthreads();
#pragma unroll
  for (int i = 0; i < 4; ++i) {
    const int qq = t + 256 * i, row = qq >> 4, c = qq & 15;
    *(u32x4*)(mixed + (size_t)(row0 + row) * D + 512 + h * 128 + c * 8) = *(const u32x4*)(YL + row * 256 + ((c ^ (row & 15)) << 4));
  }
}


constexpr int VT_STRIDE = 456;

struct AttnSrc {
  const bf16_t* P; const float *cmk, *cmv, *csk, *csv;
  int samp, b, c, kvh;
  __device__ __forceinline__ u32x4 load(int kk, int ch, bool isv) const {
    u32x4 z = make_u32x4_zero();
    const bf16_t* src = nullptr;
    const float* fsrc = nullptr;
    const int col = (isv ? 640 : 512) + kvh * 64 + ch * 8;
    if (kk < 16) {
      if (samp) fsrc = (isv ? cmv : cmk) + ((size_t)(b * 16 + kk) * 2 + kvh) * 64 + ch * 8;
      else src = P + (size_t)(NTOK + kk) * PW + col;
    } else if (kk < 208) {
      const int jb = kk - 16;
      if (samp) {
        if (jb < 128) fsrc = (isv ? csv : csk) + ((size_t)(b * 128 + jb) * 2 + kvh) * 64 + ch * 8;
        else src = P + (size_t)(NPROMPT + b * 64 + (jb - 128)) * PW + col;
      } else {
        const int f = (c - 2) * 64 + jb;
        if (f >= 0) src = P + (size_t)(b * SEQ + f) * PW + col;
      }
    }
    if (src) z = *(const u32x4*)src;
    else if (fsrc) {
      const float4 a = *(const float4*)fsrc, bq = *(const float4*)(fsrc + 4);
      z[0] = pack_bf16(a.x, a.y); z[1] = pack_bf16(a.z, a.w); z[2] = pack_bf16(bq.x, bq.y); z[3] = pack_bf16(bq.z, bq.w);
    }
    return z;
  }
};

__device__ __forceinline__ void attn_unit(int u, int kvh, char* smem, const bf16_t* __restrict__ P, const float* __restrict__ cmk,
                                          const float* __restrict__ cmv, const float* __restrict__ csk, const float* __restrict__ csv,
                                          const float* __restrict__ rel_bias, const float* __restrict__ sinks, bf16_t* __restrict__ mixed) {
  const int t = threadIdx.x, lane = t & 63, g = t >> 6, r = lane & 31, hh = lane >> 5;
  char* KT = smem;
  char* VT = smem + 28672;
  float* TB = (float*)(smem + 28672 + 64 * VT_STRIDE) + g * 384;
  AttnSrc as;
  as.P = P; as.cmk = cmk; as.cmv = cmv; as.csk = csk; as.csv = csv;
  as.samp = u >= 256; as.b = as.samp ? u - 256 : u >> 5; as.c = as.samp ? 32 : (u & 31); as.kvh = kvh;
  const int H = kvh * 4 + g;
  const int row0 = unit_row0(u);
  __syncthreads();
#pragma unroll
  for (int i = 0; i < 7; ++i) {
    const int qidx = t + 256 * i, key = qidx >> 3, ch = qidx & 7;
    *(u32x4*)(KT + tile_off(key, ch)) = as.load(key, ch, false);
  }
  for (int item = t; item < 896; item += 256) {
    const int fc = item / 112, tp = item - fc * 112;
    const u32x4 a = as.load(2 * tp, fc, true), bq = as.load(2 * tp + 1, fc, true);
#pragma unroll
    for (int q = 0; q < 4; ++q) {
      *(uint32_t*)(VT + (fc * 8 + 2 * q) * VT_STRIDE + tp * 4) = (a[q] & 0xffffu) | (bq[q] << 16);
      *(uint32_t*)(VT + (fc * 8 + 2 * q + 1) * VT_STRIDE + tp * 4) = (a[q] >> 16) | (bq[q] & 0xffff0000u);
    }
  }
  for (int idx = lane; idx < 383; idx += 64) TB[idx] = rel_bias[t5_bucket(idx - 191) * 8 + H];
  __syncthreads();
  const float sink = sinks[H];
#pragma unroll 1
  for (int qt = 0; qt < 2; ++qt) {
    bf16x8 qf[4];
#pragma unroll
    for (int ks = 0; ks < 4; ++ks) qf[ks] = *(const bf16x8*)(P + (size_t)(row0 + 32 * qt + r) * PW + H * 64 + ks * 16 + 8 * hh);
    f32x16 S[7];
#pragma unroll
    for (int kt = 0; kt < 7; ++kt) {
#pragma unroll
      for (int e = 0; e < 16; ++e) S[kt][e] = 0.f;
#pragma unroll
      for (int ks = 0; ks < 4; ++ks) {
        const bf16x8 kf = *(const bf16x8*)(KT + tile_off(32 * kt + r, 2 * ks + hh));
        S[kt] = __builtin_amdgcn_mfma_f32_32x32x16_bf16(kf, qf[ks], S[kt], 0, 0, 0);
      }
    }
    const int i = 32 * qt + r, posq = 16 + as.c * 64 + i;
    float mx = -3.0e38f;
#pragma unroll
    for (int kt = 0; kt < 7; ++kt)
#pragma unroll
      for (int e = 0; e < 16; ++e) {
        const int kk = 32 * kt + (e & 3) + 8 * (e >> 2) + 4 * hh;
        const int rel = kk < 16 ? kk - posq : kk - 144 - i;
        const bool valid = kk < 16 || (kk < 208 && (as.samp || (as.c - 2) * 64 + (kk - 16) >= 0));
        const int ti = (rel < -191 ? -191 : rel) + 191;
        const float sv = valid ? S[kt][e] * 0.125f + TB[ti] : -1.0e30f;
        S[kt][e] = sv;
        mx = fmaxf(mx, sv);
        if (e == 15) __builtin_amdgcn_sched_barrier(0);
      }
    mx = fmaxf(mx, __shfl_xor(mx, 32));
    const float m = fmaxf(mx, sink);
    float ls = 0.f;
#pragma unroll
    for (int kt = 0; kt < 7; ++kt)
#pragma unroll
      for (int e = 0; e < 16; ++e) {
        const float pv = __expf(S[kt][e] - m);
        S[kt][e] = pv;
        ls += pv;
        if (e == 15) __builtin_amdgcn_sched_barrier(0);
      }
    ls += __shfl_xor(ls, 32);
    const float inv = 1.0f / (ls + __expf(sink - m));
    f32x16 O[2];
#pragma unroll
    for (int dt = 0; dt < 2; ++dt)
#pragma unroll
      for (int e = 0; e < 16; ++e) O[dt][e] = 0.f;
#pragma unroll
    for (int kt = 0; kt < 7; ++kt)
#pragma unroll
      for (int sidx = 0; sidx < 2; ++sidx) {
        u32x4 xp;
#pragma unroll
        for (int j = 0; j < 4; ++j) xp[j] = pack_bf16(S[kt][8 * sidx + 2 * j], S[kt][8 * sidx + 2 * j + 1]);
        bf16x8 xf;
        __builtin_memcpy(&xf, &xp, 16);
#pragma unroll
        for (int dt = 0; dt < 2; ++dt) {
          const char* vp = VT + (32 * dt + r) * VT_STRIDE + (32 * kt + 16 * sidx + 4 * hh) * 2;
          const uint2 a0 = *(const uint2*)vp, a1 = *(const uint2*)(vp + 16);
          u32x4 ap;
          ap[0] = a0.x; ap[1] = a0.y; ap[2] = a1.x; ap[3] = a1.y;
          bf16x8 af;
          __builtin_memcpy(&af, &ap, 16);
          O[dt] = __builtin_amdgcn_mfma_f32_32x32x16_bf16(af, xf, O[dt], 0, 0, 0);
        }
      }
    bf16_t* op = mixed + (size_t)(row0 + i) * D + H * 64 + 4 * hh;
#pragma unroll
    for (int dt = 0; dt < 2; ++dt)
#pragma unroll
      for (int g4 = 0; g4 < 4; ++g4) {
        uint2 w;
        w.x = pack_bf16(O[dt][4 * g4] * inv, O[dt][4 * g4 + 1] * inv);
        w.y = pack_bf16(O[dt][4 * g4 + 2] * inv, O[dt][4 * g4 + 3] * inv);
        *(uint2*)(op + 32 * dt + 8 * g4) = w;
      }
  }
}

struct Params {
  const float *x_prompt, *x_sample, *cmk, *cmv, *csk, *csv, *state_ret, *meta_tokens, *ln_in_g, *ln_in_b, *rel_bias, *w_in,
      *w_out, *sinks, *gn_g, *ln1_g, *ln1_b, *peer_wq, *subk, *peer_u, *peer_v, *ln2_g, *ln2_b;
  float* out;
  char* ws;
};

__global__ void __launch_bounds__(256) mega_kernel(Params p) {
  __shared__ __attribute__((aligned(16))) char smem[65536];
  cg::grid_group grid = cg::this_grid();
  const int G = gridDim.x, bid = blockIdx.x;
  bf16_t* hbf = (bf16_t*)(p.ws + W_HBF);
  bf16_t* P = (bf16_t*)(p.ws + W_P);
  float* z = (float*)(p.ws + W_P);
  bf16_t* mixed = (bf16_t*)(p.ws + W_MIXED);
  float* qp = p.out;
  int* lidx = (int*)(p.ws + W_LIDX);
  float* lgate = (float*)(p.ws + W_LGATE);
  float* oret = p.out;
  bf16_t* wt_in = (bf16_t*)(p.ws + W_WTIN);
  bf16_t* wt_out = (bf16_t*)(p.ws + W_WTOUT);
  bf16_t* wt_q = (bf16_t*)(p.ws + W_WTQ);
  float2* rope = (float2*)(p.ws + W_ROPE);
  bf16_t* h1bf = mixed;
  uint8_t* U8 = (uint8_t*)(p.ws + W_U8);
  uint8_t* V8 = (uint8_t*)(p.ws + W_V8);
  float* su = (float*)(p.ws + W_SU);
  float* sv = (float*)(p.ws + W_SV);
  uint8_t* xq = (uint8_t*)(p.ws + W_XQ);
  bf16_t* subk_bf = (bf16_t*)(p.ws + W_SUBK);
  float* xs = (float*)(p.ws + W_XS);
  const int lane = threadIdx.x & 63, wave = threadIdx.x >> 6, nw = blockDim.x >> 6;
  const int gw = bid * nw + wave, W = G * nw;

  for (int r = bid; r < NROWS; r += G) ln_in_body(r, (float*)smem, p.x_prompt, p.x_sample, p.meta_tokens, p.ln_in_g, p.ln_in_b, hbf);
  for (int u = bid; u < 704 + 256 + 256; u += G) {
    if (u < 704) transpose_tile(u % 16, u / 16, smem, p.w_in, PW, D, wt_in);
    else if (u < 960) transpose_tile((u - 704) % 16, (u - 704) / 16, smem, p.w_out, D, D, wt_out);
    else transpose_tile((u - 960) % 16, (u - 960) / 16, smem, p.peer_wq, D, D, wt_q);
  }
  for (int idx = bid * 256 + threadIdx.x; idx < 2128 * 64; idx += G * 256) {
    const int pos = idx >> 6, d = idx & 63;
    const float inv = powf(10000.0f, -(float)d / 64.0f);
    float sn, cs;
    sincosf((float)pos * inv, &sn, &cs);
    rope[idx] = make_float2(cs, sn);
  }
  for (int idx = bid * 256 + threadIdx.x; idx < 131072; idx += G * 256) subk_bf[idx] = f2bf(p.subk[idx]);
  for (int r = gw; r < 32768; r += W) {
    if (r < 16384) quant_table_row(p.peer_u + (size_t)r * D, lane, U8 + (size_t)r * 1024, su + r, false);
    else quant_table_row(p.peer_v + (size_t)(r - 16384) * D, lane, V8 + (size_t)(r - 16384) * 1024, sv + (r - 16384), true);
  }
  grid.sync();
  for (int u = bid; u < 22 * 133; u += G) gemm_mfma_tile(u / 22, u % 22, smem, hbf, NROWS, wt_in, D, EpiInProjM{P, p.out, rope});
  grid.sync();
  float* ST = p.out;
  for (int u = bid; u < 1056 + 528; u += G) {
    if (u < 1056) ret_state_unit(u >> 2, u & 3, smem, P, ST);
    else attn_unit((u - 1056) >> 1, (u - 1056) & 1, smem, P, p.cmk, p.cmv, p.csk, p.csv, p.rel_bias, p.sinks, mixed);
  }
  grid.sync();
  for (int ci = bid * 256 + threadIdx.x; ci < 262144; ci += G * 256) ret_scan_chain(ci, P, p.state_ret, ST, p.out);
  grid.sync();
  for (int u = bid; u < 1056; u += G) ret_out_unit(u >> 2, u & 3, smem, P, ST, p.gn_g, mixed);
  grid.sync();
  for (int u = bid; u < 8 * 132; u += G) gemm_mfma_tile(u / 8, u % 8, smem, mixed, NTOK, wt_out, D, EpiOutProjM{hbf, z});
  grid.sync();
  for (int r = gw; r < NTOK; r += W) ln1_row_wave(r, lane, z, p.ln1_g, p.ln1_b, h1bf, xq, xs);
  grid.sync();
  for (int u = bid; u < 8 * 132; u += G) gemm_mfma_tile(u / 8, u % 8, smem, h1bf, NTOK, wt_q, D, EpiTopK{subk_bf, lidx, lgate});
  grid.sync();
  {
    const SweepArgs sa{lidx, lgate, U8, V8, su, sv, xq, xs, z, p.ln2_g, p.ln2_b, p.out};
    const int NP = (NTOK * 8 + W * 33 - 1) / (W * 33);
    const int TP = (NTOK + NP - 1) / NP;
    for (int pass = 0; pass < NP; ++pass) {
      const int base = pass * TP;
      const int cnt = (NTOK - base) < TP ? (NTOK - base) : TP;
      const int t0 = base + (int)(((long)gw * cnt) / W), t1 = base + (int)(((long)(gw + 1) * cnt) / W);
      sweep_wave(t0, t1 - t0, lane, smem + wave * SW_LDS_PER_WAVE, sa);
    }
  }
}

}

extern "C" void kernel_launch(void* const* d_in, const int* in_sizes, int n_in, void* d_out, int out_size, void* d_ws,
                              size_t ws_size, hipStream_t stream) {
  static int grid_blocks = 0;
  if (!grid_blocks) {
    int dev = 0, cus = 0, per_cu = 0;
    (void)hipGetDevice(&dev);
    (void)hipDeviceGetAttribute(&cus, hipDeviceAttributeMultiprocessorCount, dev);
    (void)hipOccupancyMaxActiveBlocksPerMultiprocessor(&per_cu, mega_kernel, 256, 0);
    if (per_cu > 2) per_cu = 2;
    if (per_cu < 1) per_cu = 1;
    grid_blocks = cus * per_cu;
  }
  Params p{};
  const float** pp = (const float**)&p;
  for (int i = 0; i < 23; ++i) pp[i] = (const float*)d_in[i];
  p.out = (float*)d_out;
  p.ws = (char*)d_ws;
  void* args[] = {&p};
  hipError_t e = hipLaunchCooperativeKernel((void*)mega_kernel, dim3(grid_blocks), dim3(256), args, 0, stream);
  if (e != hipSuccess) fprintf(stderr, "cooperative launch failed: %s (grid %d)\n", hipGetErrorString(e), grid_blocks);
}
```

```cpp
#include <hip/hip_runtime.h>
#include <hip/hip_cooperative_groups.h>
#include <stdint.h>
#include <cstdio>
namespace cg = cooperative_groups;

namespace {

constexpr int D = 1024;
constexpr int NB = 8, SEQ = 2048, DSEQ = 64;
constexpr int NPROMPT = NB * SEQ;
constexpr int NSAMPLE = NB * DSEQ;
constexpr int NTOK = NPROMPT + NSAMPLE;
constexpr int NMETA = 16;
constexpr int NROWS = NTOK + NMETA;
constexpr int PW = 2816;
constexpr float LN_EPS = 1e-5f;
constexpr float ALPHA = 1.18920711500272f;

constexpr size_t O_Y = 0;
constexpr size_t O_METAK = 17301504;
constexpr size_t O_METAV = O_METAK + 16384;
constexpr size_t O_SWAKP = O_METAV + 16384;
constexpr size_t O_SWAVP = O_SWAKP + 131072;
constexpr size_t O_RETP = O_SWAVP + 131072;
constexpr size_t O_SWAKS = O_RETP + 524288;
constexpr size_t O_SWAVS = O_SWAKS + 65536;
constexpr size_t O_RETS = O_SWAVS + 65536;

constexpr size_t W_HBF = 0;
constexpr size_t W_P = W_HBF + (size_t)NROWS * D * 2;
constexpr size_t W_MIXED = W_P + (size_t)NROWS * PW * 2;
constexpr size_t W_LIDX = W_MIXED + (size_t)NTOK * D * 2;
constexpr size_t W_LGATE = W_LIDX + (size_t)NTOK * 128 * 4;
constexpr size_t W_WTIN = W_LGATE + (size_t)NTOK * 128 * 4;
constexpr size_t W_WTOUT = W_WTIN + (size_t)PW * D * 2;
constexpr size_t W_WTQ = W_WTOUT + (size_t)D * D * 2;
constexpr size_t W_ROPE = W_WTQ + (size_t)D * D * 2;
constexpr size_t W_U8 = W_ROPE + (size_t)2128 * 64 * 8;
constexpr size_t W_V8 = W_U8 + (size_t)16384 * 1024;
constexpr size_t W_SU = W_V8 + (size_t)16384 * 1024;
constexpr size_t W_SV = W_SU + 65536;
constexpr size_t W_XQ = W_SV + 65536;
constexpr size_t W_XS = W_XQ + (size_t)NTOK * 1024;
constexpr size_t W_SUBK = W_XS + (size_t)NTOK * 4 + 256;
constexpr size_t W_BAR = W_SUBK + 131072 * 2;
constexpr size_t W_END = W_BAR + 3456 * 4;
static_assert(W_END <= (size_t)256 * 1024 * 1024, "workspace overflow");

typedef uint16_t bf16_t;

__device__ __forceinline__ int opaque_tid() { int t = (int)threadIdx.x; asm volatile("" : "+v"(t)); return t; }

__device__ __forceinline__ bf16_t f2bf(float f) {
  uint32_t u = __float_as_uint(f);
  u += 0x7FFFu + ((u >> 16) & 1u);
  return (bf16_t)(u >> 16);
}
__device__ __forceinline__ float bf2f(bf16_t h) { return __uint_as_float(((uint32_t)h) << 16); }

__device__ __forceinline__ int row_pos(int r) {
  if (r < NPROMPT) return 16 + (r & 2047);
  if (r < NTOK) return 16 + 2048 + ((r - NPROMPT) & 63);
  return r - NTOK;
}


template <int M> __device__ __forceinline__ int lane_xor_i(int x) {
  if (M == 1) return __builtin_amdgcn_mov_dpp(x, 0xB1, 0xF, 0xF, true);
  else if (M == 2) return __builtin_amdgcn_mov_dpp(x, 0x4E, 0xF, 0xF, true);
  else if (M == 4) return __builtin_amdgcn_mov_dpp(__builtin_amdgcn_mov_dpp(x, 0x141, 0xF, 0xF, true), 0x1B, 0xF, 0xF, true);
  else if (M == 8) return __builtin_amdgcn_mov_dpp(__builtin_amdgcn_mov_dpp(x, 0x140, 0xF, 0xF, true), 0x141, 0xF, 0xF, true);
  else if (M == 16) return __builtin_amdgcn_ds_swizzle(x, 0x401F);
  else {
    const auto r = __builtin_amdgcn_permlane32_swap((unsigned)x, (unsigned)x, false, false);
    return (int)((__builtin_amdgcn_mbcnt_hi(~0u, __builtin_amdgcn_mbcnt_lo(~0u, 0u)) < 32u) ? r[1] : r[0]);
  }
}
template <int M> __device__ __forceinline__ float lane_xor_f(float x) { return __int_as_float(lane_xor_i<M>(__float_as_int(x))); }

__device__ __forceinline__ float wave_sum(float v) {
  v += lane_xor_f<1>(v); v += lane_xor_f<2>(v); v += lane_xor_f<4>(v); v += lane_xor_f<8>(v); v += lane_xor_f<16>(v); v += lane_xor_f<32>(v);
  return v;
}

__device__ __forceinline__ float block_sum256(float v, float* red) {
  v = wave_sum(v);
  __syncthreads();
  if ((opaque_tid() & 63) == 0) red[opaque_tid() >> 6] = v;
  __syncthreads();
  return red[0] + red[1] + red[2] + red[3];
}

__device__ __forceinline__ int t5_bucket(int rel) {
  int n = rel < 0 ? -rel : rel;
  int b;
  if (n < 8) b = n;
  else {
    int l = 2 + 31 - __clz(n * n);
    b = l > 15 ? 15 : l;
  }
  return (rel > 0 ? 16 : 0) + b;
}

__device__ __forceinline__ float gelu_tanh(float x) {
  float u = 0.7978845608028654f * (x + 0.044715f * x * x * x);
  return 0.5f * x * (1.0f + tanhf(u));
}

__device__ __forceinline__ void ln_in_body(int r, float* red, const float* __restrict__ xp, const float* __restrict__ xs,
                                                    const float* __restrict__ meta, const float* __restrict__ g,
                                                    const float* __restrict__ b, bf16_t* __restrict__ hbf) {
  const int t = opaque_tid();
  const float* src = r < NPROMPT ? xp + (size_t)r * D : (r < NTOK ? xs + (size_t)(r - NPROMPT) * D : meta + (size_t)(r - NTOK) * D);
  float4 v = ((const float4*)src)[t];
  float s = block_sum256(v.x + v.y + v.z + v.w, red);
  float mean = s * (1.0f / D);
  float dx = v.x - mean, dy = v.y - mean, dz = v.z - mean, dw = v.w - mean;
  float q = block_sum256(dx * dx + dy * dy + dz * dz + dw * dw, red);
  float rstd = rsqrtf(q * (1.0f / D) + LN_EPS);
  float4 gg = ((const float4*)g)[t], bb = ((const float4*)b)[t];
  ushort4 o;
  o.x = f2bf(dx * rstd * gg.x + bb.x);
  o.y = f2bf(dy * rstd * gg.y + bb.y);
  o.z = f2bf(dz * rstd * gg.z + bb.z);
  o.w = f2bf(dw * rstd * gg.w + bb.w);
  ((ushort4*)(hbf + (size_t)r * D))[t] = o;
}


typedef short bf16x8 __attribute__((ext_vector_type(8)));
typedef float f32x16 __attribute__((ext_vector_type(16)));
typedef uint32_t u32x4 __attribute__((ext_vector_type(4)));
__device__ __forceinline__ u32x4 make_u32x4_zero() { u32x4 r; r[0] = 0; r[1] = 0; r[2] = 0; r[3] = 0; return r; }

__device__ __forceinline__ uint32_t pack_bf16(float lo, float hi) { return (uint32_t)f2bf(lo) | ((uint32_t)f2bf(hi) << 16); }

__device__ __forceinline__ int tile_off(int row, int c) {
  const int s = row >> 1;
  const int sc = ((row & 1) << 3) | c;
  return s * 256 + ((sc ^ (s & 15)) << 4);
}

template <class EPI>
__device__ __forceinline__ void gemm_mfma_tile(int mt, int nt, char* smem, const bf16_t* __restrict__ A, int M,
                                               const bf16_t* __restrict__ Bt, int K, const EPI& epi) {
  const int t = opaque_tid(), lane = t & 63, wave = t >> 6, r = lane & 31, h = lane >> 5;
  const int m0 = mt * 128, n0 = nt * 128;
  const bf16_t* ag[4];
  const bf16_t* bg[4];
  int woff[4];
#pragma unroll
  for (int i = 0; i < 4; ++i) {
    const int q = t + 256 * i, row = q >> 3, c = q & 7;
    int ar = m0 + row;
    ar = ar < M ? ar : M - 1;
    ag[i] = A + (size_t)ar * K + c * 8;
    bg[i] = Bt + (size_t)(n0 + row) * K + c * 8;
    woff[i] = tile_off(row, c);
  }
  int roff[4];
#pragma unroll
  for (int ks = 0; ks < 4; ++ks) roff[ks] = tile_off(r, ks * 2 + h);
  f32x16 acc[4];
#pragma unroll
  for (int j = 0; j < 4; ++j)
#pragma unroll
    for (int e = 0; e < 16; ++e) acc[j][e] = 0.f;
  u32x4 ra[4], rb[4];
#pragma unroll
  for (int i = 0; i < 4; ++i) { ra[i] = *(const u32x4*)(ag[i]); rb[i] = *(const u32x4*)(bg[i]); }
  __syncthreads();
#pragma unroll
  for (int i = 0; i < 4; ++i) { *(u32x4*)(smem + woff[i]) = ra[i]; *(u32x4*)(smem + 16384 + woff[i]) = rb[i]; }
  __syncthreads();
  const int nk = K >> 6;
  for (int kt = 0; kt < nk; ++kt) {
    char* cur = smem + (kt & 1) * 32768;
    char* nxt = smem + ((kt + 1) & 1) * 32768;
    if (kt + 1 < nk) {
#pragma unroll
      for (int i = 0; i < 4; ++i) { ra[i] = *(const u32x4*)(ag[i] + (kt + 1) * 64); rb[i] = *(const u32x4*)(bg[i] + (kt + 1) * 64); }
    }
    const char* sa = cur + wave * 4096;
    const char* sb = cur + 16384;
#pragma unroll
    for (int ks = 0; ks < 4; ++ks) {
      const bf16x8 af = *(const bf16x8*)(sa + roff[ks]);
#pragma unroll
      for (int j = 0; j < 4; ++j) {
        const bf16x8 bfr = *(const bf16x8*)(sb + j * 4096 + roff[ks]);
        acc[j] = __builtin_amdgcn_mfma_f32_32x32x16_bf16(bfr, af, acc[j], 0, 0, 0);
      }
    }
    if (kt + 1 < nk) {
#pragma unroll
      for (int i = 0; i < 4; ++i) { *(u32x4*)(nxt + woff[i]) = ra[i]; *(u32x4*)(nxt + 16384 + woff[i]) = rb[i]; }
    }
    __syncthreads();
  }
  const int row = m0 + wave * 32 + r;
  if (row < M) epi(row, nt, h, acc, smem);
}

struct EpiInProjM {
  bf16_t* P; float* out; const float2* rope;
  __device__ __forceinline__ void operator()(int row, int nt, int h, f32x16 (&acc)[4], char* smem) const {
    if (nt >= 6 && nt < 14) {
      const float sc = nt >= 10 ? 0.08838834764831845f : 1.0f;
      const float2* rp = rope + (size_t)row_pos(row) * 64;
#pragma unroll
      for (int j = 0; j < 2; ++j)
#pragma unroll
        for (int g = 0; g < 4; ++g)
#pragma unroll
          for (int i = 0; i < 4; ++i) {
            const float2 cs = rp[j * 32 + 8 * g + 4 * h + i];
            const float x1 = acc[j][4 * g + i], x2 = acc[j + 2][4 * g + i];
            acc[j][4 * g + i] = (x1 * cs.x - x2 * cs.y) * sc;
            acc[j + 2][4 * g + i] = (x1 * cs.y + x2 * cs.x) * sc;
          }
    }
    bf16_t* prow = P + (size_t)row * PW + nt * 128 + 4 * h;
#pragma unroll
    for (int j = 0; j < 4; ++j)
#pragma unroll
      for (int g = 0; g < 4; ++g) {
        uint2 w;
        w.x = pack_bf16(acc[j][4 * g], acc[j][4 * g + 1]);
        w.y = pack_bf16(acc[j][4 * g + 2], acc[j][4 * g + 3]);
        *(uint2*)(prow + j * 32 + 8 * g) = w;
      }
    if (nt == 4 || nt == 5) {
      const bool isv = nt == 5;
#pragma unroll
      for (int j = 0; j < 4; ++j)
#pragma unroll
        for (int g = 0; g < 4; ++g) {
          const int col = j * 32 + 8 * g + 4 * h;
          const float4 val = make_float4(acc[j][4 * g], acc[j][4 * g + 1], acc[j][4 * g + 2], acc[j][4 * g + 3]);
          if (row < NPROMPT) {
            const int b = row >> 11, sidx = row & 2047;
            if (sidx >= SEQ - 128) *(float4*)(out + (isv ? O_SWAVP : O_SWAKP) + (size_t)(b * 128 + (sidx - (SEQ - 128))) * 128 + col) = val;
          } else if (row < NTOK) {
            *(float4*)(out + (isv ? O_SWAVS : O_SWAKS) + (size_t)(row - NPROMPT) * 128 + col) = val;
          } else {
            const int m = row - NTOK;
            for (int b = 0; b < NB; ++b) *(float4*)(out + (isv ? O_METAV : O_METAK) + (size_t)(b * 16 + m) * 128 + col) = val;
          }
        }
    }
  }
};

struct EpiOutProjM {
  const bf16_t* hbf; float* z;
  __device__ __forceinline__ void operator()(int row, int nt, int h, f32x16 (&acc)[4], char* smem) const {
    const size_t base = (size_t)row * D + nt * 128 + 4 * h;
#pragma unroll
    for (int j = 0; j < 4; ++j)
#pragma unroll
      for (int g = 0; g < 4; ++g) {
        const uint2 hv = *(const uint2*)(hbf + base + j * 32 + 8 * g);
        float4 o;
        o.x = ALPHA * __uint_as_float(hv.x << 16) + acc[j][4 * g];
        o.y = ALPHA * __uint_as_float(hv.x & 0xffff0000u) + acc[j][4 * g + 1];
        o.z = ALPHA * __uint_as_float(hv.y << 16) + acc[j][4 * g + 2];
        o.w = ALPHA * __uint_as_float(hv.y & 0xffff0000u) + acc[j][4 * g + 3];
        *(float4*)(z + base + j * 32 + 8 * g) = o;
      }
  }
};

struct EpiPlainF32M {
  float* C;
  __device__ __forceinline__ void operator()(int row, int nt, int h, f32x16 (&acc)[4], char* smem) const {
    const size_t base = (size_t)row * D + nt * 128 + 4 * h;
#pragma unroll
    for (int j = 0; j < 4; ++j)
#pragma unroll
      for (int g = 0; g < 4; ++g)
        *(float4*)(C + base + j * 32 + 8 * g) = make_float4(acc[j][4 * g], acc[j][4 * g + 1], acc[j][4 * g + 2], acc[j][4 * g + 3]);
  }
};


constexpr int NET16[63][2] = {{0,1}, {2,3}, {0,2}, {1,3}, {1,2}, {4,5}, {6,7}, {4,6}, {5,7}, {5,6}, {0,4}, {2,6}, {2,4}, {1,5}, {3,7}, {3,5}, {1,2}, {3,4}, {5,6}, {8,9}, {10,11}, {8,10}, {9,11}, {9,10}, {12,13}, {14,15}, {12,14}, {13,15}, {13,14}, {8,12}, {10,14}, {10,12}, {9,13}, {11,15}, {11,13}, {9,10}, {11,12}, {13,14}, {0,8}, {4,12}, {4,8}, {2,10}, {6,14}, {6,10}, {2,4}, {6,8}, {10,12}, {1,9}, {5,13}, {5,9}, {3,11}, {7,15}, {7,11}, {3,5}, {7,9}, {11,13}, {1,2}, {3,4}, {5,6}, {7,8}, {9,10}, {11,12}, {13,14}};
constexpr int CLEAN16[32][2] = {{0,8}, {1,9}, {2,10}, {3,11}, {4,12}, {5,13}, {6,14}, {7,15}, {0,4}, {1,5}, {2,6}, {3,7}, {8,12}, {9,13}, {10,14}, {11,15}, {0,2}, {1,3}, {4,6}, {5,7}, {8,10}, {9,11}, {12,14}, {13,15}, {0,1}, {2,3}, {4,5}, {6,7}, {8,9}, {10,11}, {12,13}, {14,15}};
constexpr int CAND_REST[34][2] = {{1,0}, {1,1}, {1,2}, {1,3}, {1,4}, {1,5}, {1,6}, {1,7}, {2,0}, {2,1}, {2,2}, {2,3}, {2,4}, {3,0}, {3,1}, {3,2}, {3,3}, {4,0}, {4,1}, {4,2}, {5,0}, {5,1}, {6,0}, {6,1}, {7,0}, {7,1}, {8,0}, {9,0}, {10,0}, {11,0}, {12,0}, {13,0}, {14,0}, {15,0}};
#define CE_DESC(a, b) { const int hi_ = max(a, b), lo_ = min(a, b); a = hi_; b = lo_; }
__device__ __forceinline__ void sort16_desc(int (&x)[16]) {
#pragma unroll
  for (int t = 0; t < 63; ++t) CE_DESC(x[NET16[t][0]], x[NET16[t][1]])
}
__device__ __forceinline__ void merge_top16(int (&a)[16], const int (&b)[16]) {
#pragma unroll
  for (int i = 0; i < 16; ++i) a[i] = max(a[i], b[15 - i]);
#pragma unroll
  for (int t = 0; t < 32; ++t) CE_DESC(a[CLEAN16[t][0]], a[CLEAN16[t][1]])
}
__device__ __forceinline__ int f2ord(float f) { const int b = __float_as_int(f); return b ^ ((b >> 31) & 0x7FFFFFFF); }
__device__ __forceinline__ float ord2f(int k) { return __int_as_float(k ^ ((k >> 31) & 0x7FFFFFFF)); }

struct EpiTopK {
  const bf16_t* subk;
  int* lidx; float* lgate;
  __device__ __forceinline__ void operator()(int row, int p, int h, f32x16 (&acc)[4], char* smem) const {
    const int lane = opaque_tid() & 63, wave = opaque_tid() >> 6, r = lane & 31;
    char* qw = smem + wave * 16384;
    int* sl = (int*)(smem + wave * 16384 + 8192);
#pragma unroll
    for (int j = 0; j < 4; ++j)
#pragma unroll
      for (int g = 0; g < 4; ++g) {
        uint2 w;
        w.x = pack_bf16(acc[j][4 * g], acc[j][4 * g + 1]);
        w.y = pack_bf16(acc[j][4 * g + 2], acc[j][4 * g + 3]);
        *(uint2*)(qw + r * 256 + (((4 * j + g) ^ (r & 15)) << 4) + 8 * h) = w;
      }
    int S[2][16];
#pragma unroll
    for (int c = 0; c < 2; ++c) {
      f32x16 sc[4];
#pragma unroll
      for (int mi = 0; mi < 4; ++mi)
#pragma unroll
        for (int e = 0; e < 16; ++e) sc[mi][e] = 0.f;
      const bf16_t* kb = subk + (size_t)((p * 2 + c) * 128 + r) * 64 + 8 * h;
#pragma unroll
      for (int ks = 0; ks < 4; ++ks) {
        const bf16x8 qf = *(const bf16x8*)(qw + r * 256 + (((8 * c + 2 * ks + h) ^ (r & 15)) << 4));
#pragma unroll
        for (int mi = 0; mi < 4; ++mi) {
          const bf16x8 kf = *(const bf16x8*)(kb + mi * 32 * 64 + ks * 16);
          sc[mi] = __builtin_amdgcn_mfma_f32_32x32x16_bf16(kf, qf, sc[mi], 0, 0, 0);
        }
      }
      int L[16];
#pragma unroll
      for (int mi = 0; mi < 4; ++mi) {
        int x[16];
#pragma unroll
        for (int e = 0; e < 16; ++e) x[e] = (f2ord(sc[mi][e]) & ~127) | (32 * mi + (e & 3) + 8 * (e >> 2) + 4 * h);
        sort16_desc(x);
        if (mi == 0) {
#pragma unroll
          for (int e = 0; e < 16; ++e) L[e] = x[e];
        } else merge_top16(L, x);
      }
      int Pn[16];
#pragma unroll
      for (int e = 0; e < 16; ++e) Pn[e] = __shfl_xor(L[e], 32);
      merge_top16(L, Pn);
#pragma unroll
      for (int e = 0; e < 16; ++e) { S[c][e] = L[e]; sl[(c * 16 + e) * 64 + lane] = L[e]; }
    }
    float f0[16], f1[16];
#pragma unroll
    for (int e = 0; e < 16; ++e) { f0[e] = ord2f(S[0][e]); f1[e] = ord2f(S[1][e]); }
    int T[16];
#pragma unroll
    for (int b = 0; b < 16; ++b) T[b] = (f2ord(f0[0] + f1[b]) & ~255) | (15 - b);
#pragma unroll
    for (int gi = 0; gi < 3; ++gi) {
      int x[16];
#pragma unroll
      for (int e = 0; e < 16; ++e) {
        const int ci = gi * 16 + e;
        if (ci < 34) x[e] = (f2ord(f0[CAND_REST[ci][0]] + f1[CAND_REST[ci][1]]) & ~255) | (CAND_REST[ci][0] << 4) | (15 - CAND_REST[ci][1]);
        else x[e] = (int)0x80000000;
      }
      sort16_desc(x);
      merge_top16(T, x);
    }
    float ev[16], den = 0.f;
    const float vmax = ord2f(T[0]);
#pragma unroll
    for (int k = 0; k < 16; ++k) { ev[k] = __expf(ord2f(T[k]) - vmax); den += ev[k]; }
    const float inv = 1.0f / den;
    int eo[16];
#pragma unroll
    for (int k = 0; k < 16; ++k) {
      const int ab = T[k] & 255;
      const int i1 = sl[(ab >> 4) * 64 + lane] & 127, i2 = sl[(16 + 15 - (ab & 15)) * 64 + lane] & 127;
      eo[k] = i1 * 128 + i2;
    }
    if (h == 0) {
      int* lp = lidx + (size_t)row * 128 + p * 16;
      float* gp = lgate + (size_t)row * 128 + p * 16;
#pragma unroll
      for (int q = 0; q < 4; ++q) {
        *(int4*)(lp + 4 * q) = make_int4(eo[4 * q], eo[4 * q + 1], eo[4 * q + 2], eo[4 * q + 3]);
        *(float4*)(gp + 4 * q) = make_float4(ev[4 * q] * inv, ev[4 * q + 1] * inv, ev[4 * q + 2] * inv, ev[4 * q + 3] * inv);
      }
    }
  }
};

__device__ __forceinline__ void transpose_tile(int kt, int ntile, char* smem, const float* __restrict__ W, int N, int K, bf16_t* __restrict__ Wt) {
  float (*T)[65] = (float (*)[65])smem;
  const int t = opaque_tid();
  __syncthreads();
#pragma unroll
  for (int pss = 0; pss < 4; ++pss) {
    const int kk = pss * 16 + (t >> 4), nn = (t & 15) * 4;
    const float4 v = *(const float4*)(W + (size_t)(kt * 64 + kk) * N + ntile * 64 + nn);
    T[kk][nn] = v.x; T[kk][nn + 1] = v.y; T[kk][nn + 2] = v.z; T[kk][nn + 3] = v.w;
  }
  __syncthreads();
#pragma unroll
  for (int pss = 0; pss < 4; ++pss) {
    const int nn = pss * 16 + (t >> 4), kk = (t & 15) * 4;
    uint2 w;
    w.x = pack_bf16(T[kk][nn], T[kk + 1][nn]);
    w.y = pack_bf16(T[kk + 2][nn], T[kk + 3][nn]);
    *(uint2*)(Wt + (size_t)(ntile * 64 + nn) * K + kt * 64 + kk) = w;
  }
}


__device__ __forceinline__ float wave_max(float v) {
  v = fmaxf(v, lane_xor_f<1>(v)); v = fmaxf(v, lane_xor_f<2>(v)); v = fmaxf(v, lane_xor_f<4>(v));
  v = fmaxf(v, lane_xor_f<8>(v)); v = fmaxf(v, lane_xor_f<16>(v)); v = fmaxf(v, lane_xor_f<32>(v));
  return v;
}

__device__ __forceinline__ float quant_row_regs(const float4 (&v)[4], int lane, uint8_t* __restrict__ dst, bool biased) {
  float m = 0.f;
#pragma unroll
  for (int i = 0; i < 4; ++i) m = fmaxf(m, fmaxf(fmaxf(fabsf(v[i].x), fabsf(v[i].y)), fmaxf(fabsf(v[i].z), fabsf(v[i].w))));
  m = wave_max(m);
  const float scale = m * (1.0f / 127.0f);
  const float inv = m > 0.f ? 127.0f / m : 0.f;
  u32x4 w;
#pragma unroll
  for (int i = 0; i < 4; ++i) {
    int a = (int)rintf(v[i].x * inv), b = (int)rintf(v[i].y * inv), c = (int)rintf(v[i].z * inv), d = (int)rintf(v[i].w * inv);
    if (biased) { a += 128; b += 128; c += 128; d += 128; }
    w[i] = (uint32_t)(a & 255) | ((uint32_t)(b & 255) << 8) | ((uint32_t)(c & 255) << 16) | ((uint32_t)(d & 255) << 24);
  }
  *(u32x4*)(dst + lane * 16) = w;
  return scale;
}

__device__ __forceinline__ void quant_table_row(const float* __restrict__ src, int lane, uint8_t* __restrict__ dst, float* __restrict__ sc, bool biased) {
  float4 v[4];
#pragma unroll
  for (int i = 0; i < 4; ++i) v[i] = *(const float4*)(src + 256 * i + 4 * lane);
  const float scale = quant_row_regs(v, lane, dst, biased);
  if (lane == 0) *sc = scale;
}

__device__ __forceinline__ void ln1_row_wave(int r, int lane, float* __restrict__ z, const float* __restrict__ g, const float* __restrict__ b,
                                             bf16_t* __restrict__ h1bf, uint8_t* __restrict__ xq, float* __restrict__ xs) {
  float4 v[4];
  float sum = 0.f;
#pragma unroll
  for (int i = 0; i < 4; ++i) { v[i] = *(const float4*)(z + (size_t)r * D + 256 * i + 4 * lane); sum += (v[i].x + v[i].y) + (v[i].z + v[i].w); }
  const float mean = wave_sum(sum) * (1.0f / D);
  float sq = 0.f;
#pragma unroll
  for (int i = 0; i < 4; ++i) { v[i].x -= mean; v[i].y -= mean; v[i].z -= mean; v[i].w -= mean; sq += (v[i].x * v[i].x + v[i].y * v[i].y) + (v[i].z * v[i].z + v[i].w * v[i].w); }
  const float rstd = rsqrtf(wave_sum(sq) * (1.0f / D) + LN_EPS);
#pragma unroll
  for (int i = 0; i < 4; ++i) {
    const float4 gg = *(const float4*)(g + 256 * i + 4 * lane), bb = *(const float4*)(b + 256 * i + 4 * lane);
    v[i].x = v[i].x * rstd * gg.x + bb.x; v[i].y = v[i].y * rstd * gg.y + bb.y; v[i].z = v[i].z * rstd * gg.z + bb.z; v[i].w = v[i].w * rstd * gg.w + bb.w;
    *(float4*)(z + (size_t)r * D + 256 * i + 4 * lane) = v[i];
    uint2 w;
    w.x = pack_bf16(v[i].x, v[i].y); w.y = pack_bf16(v[i].z, v[i].w);
    *(uint2*)(h1bf + (size_t)r * D + 256 * i + 4 * lane) = w;
  }
  const float scale = quant_row_regs(v, lane, xq + (size_t)r * 1024, false);
  if (lane == 0) xs[r] = scale;
}

struct SweepArgs {
  const int* lidx; const float* lgate; const uint8_t* U8; const uint8_t* V8; const float* su; const float* sv;
  const uint8_t* xq; const float* xs; const float* h1; const float* g2; const float* b2; float* y;
};

#define SW_LDS_PER_WAVE 12544

__device__ __forceinline__ float cvt_ub0(uint32_t d) { return (float)(d & 0xffu); }
__device__ __forceinline__ float cvt_ub1(uint32_t d) { return (float)((d >> 8) & 0xffu); }
__device__ __forceinline__ float cvt_ub2(uint32_t d) { return (float)((d >> 16) & 0xffu); }
__device__ __forceinline__ float cvt_ub3(uint32_t d) { return (float)(d >> 24); }

__device__ __forceinline__ void sw_axpy(f32x16& acc, float& corr, float w, const u32x4& vv) {
#pragma unroll
  for (int q = 0; q < 4; ++q) {
    const uint32_t d = vv[q];
    acc[4 * q + 0] = fmaf(w, cvt_ub0(d), acc[4 * q + 0]);
    acc[4 * q + 1] = fmaf(w, cvt_ub1(d), acc[4 * q + 1]);
    acc[4 * q + 2] = fmaf(w, cvt_ub2(d), acc[4 * q + 2]);
    acc[4 * q + 3] = fmaf(w, cvt_ub3(d), acc[4 * q + 3]);
  }
  corr += w;
}

__device__ __forceinline__ void sw_finish(int tok, int lane, const f32x16& acc, float corr, const SweepArgs& a) {
  float4 v[4];
  float sum = 0.f;
  const float c128 = 128.0f * corr;
#pragma unroll
  for (int i = 0; i < 4; ++i) {
    const float4 hh = *(const float4*)(a.h1 + (size_t)tok * D + 256 * i + 4 * lane);
    v[i].x = ALPHA * hh.x + (acc[4 * i + 0] - c128);
    v[i].y = ALPHA * hh.y + (acc[4 * i + 1] - c128);
    v[i].z = ALPHA * hh.z + (acc[4 * i + 2] - c128);
    v[i].w = ALPHA * hh.w + (acc[4 * i + 3] - c128);
    sum += (v[i].x + v[i].y) + (v[i].z + v[i].w);
  }
  const float mean = wave_sum(sum) * (1.0f / D);
  float sq = 0.f;
#pragma unroll
  for (int i = 0; i < 4; ++i) { v[i].x -= mean; v[i].y -= mean; v[i].z -= mean; v[i].w -= mean; sq += (v[i].x * v[i].x + v[i].y * v[i].y) + (v[i].z * v[i].z + v[i].w * v[i].w); }
  const float rstd = rsqrtf(wave_sum(sq) * (1.0f / D) + LN_EPS);
#pragma unroll
  for (int i = 0; i < 4; ++i) {
    const float4 gg = *(const float4*)(a.g2 + 256 * i + 4 * lane), bb = *(const float4*)(a.b2 + 256 * i + 4 * lane);
    float4 o;
    o.x = v[i].x * rstd * gg.x + bb.x; o.y = v[i].y * rstd * gg.y + bb.y; o.z = v[i].z * rstd * gg.z + bb.z; o.w = v[i].w * rstd * gg.w + bb.w;
    *(float4*)(a.y + (size_t)tok * D + 256 * i + 4 * lane) = o;
  }
}

__device__ __forceinline__ void sweep_wave(int tok0, int ntok, int pair_off, int lg_ppt, int partial, int lane, int wave,
                                           char* lds, const SweepArgs& a) {
  u32x4* list = (u32x4*)lds;
  uint8_t* xl = (uint8_t*)(lds + 8192);
  float* xscl = (float*)(lds + 8192 + 4096);
  const int npairs = ntok << lg_ppt;
  __syncthreads();
  for (int sidx = 0; sidx < ntok; ++sidx) *(u32x4*)(xl + sidx * 1024 + lane * 16) = *(const u32x4*)(a.xq + (size_t)(tok0 + sidx) * 1024 + lane * 16);
  if (lane < ntok) xscl[lane] = a.xs[tok0 + lane];
  int K[8];
  {
    const int* lp = a.lidx + (size_t)tok0 * 128;
#pragma unroll
    for (int q = 0; q < 2; ++q) {
      const int i0 = lane * 8 + q * 4;
      const int pid0 = ((i0 >> lg_ppt) << 7) + pair_off + (i0 & ((1 << lg_ppt) - 1));
      int4 e4 = make_int4(0, 0, 0, 0);
      if (i0 < npairs) e4 = *(const int4*)(lp + pid0);
      K[4 * q + 0] = i0 < npairs ? ((e4.x << 10) | (pid0 + 0)) : 0x7FFFFFFF;
      K[4 * q + 1] = i0 < npairs ? ((e4.y << 10) | (pid0 + 1)) : 0x7FFFFFFF;
      K[4 * q + 2] = i0 < npairs ? ((e4.z << 10) | (pid0 + 2)) : 0x7FFFFFFF;
      K[4 * q + 3] = i0 < npairs ? ((e4.w << 10) | (pid0 + 3)) : 0x7FFFFFFF;
    }
  }
#pragma unroll
  for (int k = 2; k <= 512; k <<= 1) {
#pragma unroll
    for (int j = k >> 1; j > 0; j >>= 1) {
      if (j >= 8) {
        const int lj = j >> 3;
        const bool upper = (lane & lj) != 0;
        const bool desc = (k < 512) && ((lane & (k >> 3)) != 0);
        const bool keepmax = upper != desc;
#pragma unroll
        for (int r = 0; r < 8; ++r) {
          const int o = __shfl_xor(K[r], lj);
          const int mn = min(K[r], o), mx = max(K[r], o);
          K[r] = keepmax ? mx : mn;
        }
      } else {
#pragma unroll
        for (int r = 0; r < 8; ++r) {
          if ((r & j) == 0) {
            const int pp = r | j;
            const int mn = min(K[r], K[pp]), mx = max(K[r], K[pp]);
            if (k >= 8) {
              const bool desc = (k < 512) && ((lane & (k >> 3)) != 0);
              K[r] = desc ? mx : mn; K[pp] = desc ? mn : mx;
            } else {
              const bool desc = (r & k) != 0;
              K[r] = desc ? mx : mn; K[pp] = desc ? mn : mx;
            }
          }
        }
      }
    }
  }
  __syncthreads();
#pragma unroll
  for (int r = 0; r < 8; ++r) {
    const int i = lane * 8 + r;
    if (i < npairs) {
      const int key = K[r];
      const int e = key >> 10, pid = key & 1023, slot = pid >> 7;
      const float gate = a.lgate[(size_t)tok0 * 128 + pid];
      u32x4 ent;
      ent[0] = ((uint32_t)e << 3) | (uint32_t)slot;
      ent[1] = __float_as_uint(a.su[e] * xscl[slot]);
      ent[2] = __float_as_uint(gate * a.sv[e]);
      ent[3] = 0;
      list[i] = ent;
    }
  }
  __syncthreads();
  f32x16 acc0, acc1, acc2, acc3;
#pragma unroll
  for (int e = 0; e < 16; ++e) { acc0[e] = 0.f; acc1[e] = 0.f; acc2[e] = 0.f; acc3[e] = 0.f; }
  float corr0 = 0.f, corr1 = 0.f, corr2 = 0.f, corr3 = 0.f;
  const int nb = npairs >> 3;
  const __amdgpu_buffer_rsrc_t rsU = __builtin_amdgcn_make_buffer_rsrc((void*)a.U8, 0, 16384 * 1024, 0x00020000);
  const __amdgpu_buffer_rsrc_t rsV = __builtin_amdgcn_make_buffer_rsrc((void*)a.V8, 0, 16384 * 1024, 0x00020000);
  const int lane16 = lane * 16;
  u32x4 ub[8], vb[8];
  u32x4 ent = make_u32x4_zero(), entN = make_u32x4_zero();
  if (nb > 0) {
    ent = list[lane & 7];
#pragma unroll
    for (int r = 0; r < 8; ++r) {
      const uint32_t key = (uint32_t)__builtin_amdgcn_readlane((int)ent[0], r);
      ub[r] = __builtin_amdgcn_raw_buffer_load_b128(rsU, lane16, (int)((key >> 3) << 10), 0);
      vb[r] = __builtin_amdgcn_raw_buffer_load_b128(rsV, lane16, (int)((key >> 3) << 10), 0);
    }
  }
  for (int bt = 0; bt < nb; ++bt) {
    const bool more = bt + 1 < nb;
    entN = list[(more ? (bt + 1) * 8 : 0) + (lane & 7)];
    int dsum[8];
    u32x4 xx = *(const u32x4*)(xl + ((uint32_t)__builtin_amdgcn_readlane((int)ent[0], 0) & 7) * 1024 + lane * 16);
#pragma unroll
    for (int r = 0; r < 8; ++r) {
      u32x4 xn = xx;
      if (r < 7) xn = *(const u32x4*)(xl + ((uint32_t)__builtin_amdgcn_readlane((int)ent[0], r + 1) & 7) * 1024 + lane * 16);
      int dd = __builtin_amdgcn_sdot4((int)ub[r][0], (int)xx[0], 0, false);
      dd = __builtin_amdgcn_sdot4((int)ub[r][1], (int)xx[1], dd, false);
      dd = __builtin_amdgcn_sdot4((int)ub[r][2], (int)xx[2], dd, false);
      dd = __builtin_amdgcn_sdot4((int)ub[r][3], (int)xx[3], dd, false);
      dsum[r] = dd;
      {
        const uint32_t keyn = (uint32_t)__builtin_amdgcn_readlane((int)entN[0], r);
        ub[r] = __builtin_amdgcn_raw_buffer_load_b128(rsU, lane16, (int)((keyn >> 3) << 10), 0);
      }
      xx = xn;
      __builtin_amdgcn_sched_barrier(0);
    }
    int t4[4], t2[2], t1;
#pragma unroll
    for (int q = 0; q < 4; ++q) {
      const bool hi = (lane & 1) != 0;
      const int keep = hi ? dsum[2 * q + 1] : dsum[2 * q], send = hi ? dsum[2 * q] : dsum[2 * q + 1];
      t4[q] = keep + lane_xor_i<1>(send);
    }
#pragma unroll
    for (int q = 0; q < 2; ++q) {
      const bool hi = (lane & 2) != 0;
      const int keep = hi ? t4[2 * q + 1] : t4[2 * q], send = hi ? t4[2 * q] : t4[2 * q + 1];
      t2[q] = keep + lane_xor_i<2>(send);
    }
    {
      const bool hi = (lane & 4) != 0;
      const int keep = hi ? t2[1] : t2[0], send = hi ? t2[0] : t2[1];
      t1 = keep + lane_xor_i<4>(send);
    }
    t1 += lane_xor_i<8>(t1); t1 += lane_xor_i<16>(t1); t1 += lane_xor_i<32>(t1);
    const float pre = (float)t1 * __uint_as_float(ent[1]);
    const float uu = 1.5957691216057308f * (pre + 0.044715f * pre * pre * pre);
    const float act = pre / (1.0f + __expf(-uu));
    const float wv = act * __uint_as_float(ent[2]);
#pragma unroll
    for (int r = 0; r < 8; ++r) {
      const uint32_t key = (uint32_t)__builtin_amdgcn_readlane((int)ent[0], r);
      const float w = __uint_as_float((uint32_t)__builtin_amdgcn_readlane((int)__float_as_uint(wv), r));
      switch (key & 3) {
        case 0: sw_axpy(acc0, corr0, w, vb[r]); break;
        case 1: sw_axpy(acc1, corr1, w, vb[r]); break;
        case 2: sw_axpy(acc2, corr2, w, vb[r]); break;
        default: sw_axpy(acc3, corr3, w, vb[r]); break;
      }
      {
        const uint32_t keyn = (uint32_t)__builtin_amdgcn_readlane((int)entN[0], r);
        vb[r] = __builtin_amdgcn_raw_buffer_load_b128(rsV, lane16, (int)((keyn >> 3) << 10), 0);
      }
      __builtin_amdgcn_sched_barrier(0);
    }
    ent = entN;
  }
  if (!partial) {
    if (ntok > 0) sw_finish(tok0 + 0, lane, acc0, corr0, a);
    if (ntok > 1) sw_finish(tok0 + 1, lane, acc1, corr1, a);
    if (ntok > 2) sw_finish(tok0 + 2, lane, acc2, corr2, a);
    if (ntok > 3) sw_finish(tok0 + 3, lane, acc3, corr3, a);
  } else {
    float* part = (float*)lds;
#pragma unroll
    for (int e = 0; e < 16; ++e) part[lane * 17 + e] = acc0[e];
    part[lane * 17 + 16] = corr0;
    __syncthreads();
    if (wave == 0 && ntok > 0) {
#pragma unroll
      for (int w2 = 1; w2 < 4; ++w2) {
        const float* pp = (const float*)(lds + w2 * SW_LDS_PER_WAVE);
#pragma unroll
        for (int e = 0; e < 16; ++e) acc0[e] += pp[lane * 17 + e];
        corr0 += pp[lane * 17 + 16];
      }
      sw_finish(tok0, lane, acc0, corr0, a);
    }
  }
}

__device__ __forceinline__ int unit_row0(int u) { return u < 256 ? (u >> 5) * SEQ + (u & 31) * 64 : NPROMPT + (u - 256) * 64; }

__device__ __forceinline__ void stage_T(char* dst, const bf16_t* __restrict__ src, const float* dec) {
  const int t = opaque_tid(), lane = t & 63, wave = t >> 6, tp = lane & 31;
#pragma unroll
  for (int item = 0; item < 2; ++item) {
    const int fc = (lane >> 5) + 2 * wave + 8 * item;
    const u32x4 a = *(const u32x4*)(src + (size_t)(2 * tp) * PW + fc * 8);
    const u32x4 b = *(const u32x4*)(src + (size_t)(2 * tp + 1) * PW + fc * 8);
    float d0 = 1.f, d1 = 1.f;
    if (dec) { d0 = dec[2 * tp]; d1 = dec[2 * tp + 1]; }
#pragma unroll
    for (int q = 0; q < 4; ++q) {
      uint32_t lo, hi;
      if (dec) {
        lo = pack_bf16(__uint_as_float(a[q] << 16) * d0, __uint_as_float(b[q] << 16) * d1);
        hi = pack_bf16(__uint_as_float(a[q] & 0xffff0000u) * d0, __uint_as_float(b[q] & 0xffff0000u) * d1);
      } else {
        lo = (a[q] & 0xffffu) | (b[q] << 16);
        hi = (a[q] >> 16) | (b[q] & 0xffff0000u);
      }
      const int f = fc * 8 + 2 * q;
      *(uint32_t*)(dst + tile_off(f, tp >> 2) + (tp & 3) * 4) = lo;
      *(uint32_t*)(dst + tile_off(f + 1, tp >> 2) + (tp & 3) * 4) = hi;
    }
  }
}

__device__ __forceinline__ void stage_R(char* dst, const bf16_t* __restrict__ src) {
  const int t = opaque_tid();
#pragma unroll
  for (int i = 0; i < 4; ++i) {
    const int q = t + 256 * i, row = q >> 4, c = q & 15;
    *(u32x4*)(dst + row * 256 + ((c ^ (row & 15)) << 4)) = *(const u32x4*)(src + (size_t)row * PW + c * 8);
  }
}

__device__ __forceinline__ void ret_state_unit(int u, int h, char* smem, const bf16_t* __restrict__ P, float* __restrict__ ST) {
  const int t = opaque_tid(), lane = t & 63, wave = t >> 6, r = lane & 31, hh = lane >> 5;
  char* RKT = smem;
  char* RVT = smem + 16384;
  float* dec = (float*)(smem + 32768);
  const int row0 = unit_row0(u);
  const float lg2 = log2f(1.0f - exp2f(-5.0f - (float)h));
  __syncthreads();
  if (t < 64) dec[t] = exp2f((float)(63 - t) * lg2);
  __syncthreads();
  stage_T(RKT, P + (size_t)row0 * PW + 1280 + h * 128, dec);
  stage_T(RVT, P + (size_t)row0 * PW + 1792 + h * 128, nullptr);
  __syncthreads();
  f32x16 acc[4];
#pragma unroll
  for (int j = 0; j < 4; ++j)
#pragma unroll
    for (int e = 0; e < 16; ++e) acc[j][e] = 0.f;
#pragma unroll
  for (int ks = 0; ks < 4; ++ks) {
    const bf16x8 af = *(const bf16x8*)(RVT + tile_off(32 * wave + r, 2 * ks + hh));
#pragma unroll
    for (int dj = 0; dj < 4; ++dj) {
      const bf16x8 bfr = *(const bf16x8*)(RKT + tile_off(32 * dj + r, 2 * ks + hh));
      acc[dj] = __builtin_amdgcn_mfma_f32_32x32x16_bf16(af, bfr, acc[dj], 0, 0, 0);
    }
  }
  float* o = ST + (size_t)(u * 4 + h) * 16384;
#pragma unroll
  for (int dj = 0; dj < 4; ++dj)
#pragma unroll
    for (int e = 0; e < 16; ++e) {
      const int er = 32 * wave + (e & 3) + 8 * (e >> 2) + 4 * hh;
      o[er * 128 + 32 * dj + r] = acc[dj][e];
    }
}

__device__ __forceinline__ void ret_scan_chain(int ci, const bf16_t* __restrict__ P, const float* __restrict__ state_in, float* __restrict__ ST, float* __restrict__ out) {
  const int d4 = ci & 31, e = (ci >> 5) & 127, h = (ci >> 12) & 3, b = (ci >> 14) & 7, samp = ci >> 17;
  const float gamma = 1.0f - exp2f(-5.0f - (float)h);
  const float g64 = exp2f(64.0f * log2f(gamma));
  float s[4];
  if (samp) {
    float* ptr = ST + ((size_t)((256 + b) * 4 + h) * 128 + e) * 128 + d4 * 4;
    const float4 a = *(const float4*)ptr;
    float sv4[4];
#pragma unroll
    for (int j = 0; j < 4; ++j) sv4[j] = state_in[((size_t)(b * 4 + h) * 128 + d4 * 4 + j) * 128 + e];
    *(float4*)ptr = make_float4(sv4[0], sv4[1], sv4[2], sv4[3]);
    const float av[4] = {a.x, a.y, a.z, a.w};
#pragma unroll
    for (int j = 0; j < 4; ++j) out[O_RETS + ((size_t)(b * 4 + h) * 128 + d4 * 4 + j) * 128 + e] = g64 * sv4[j] + av[j];
    return;
  }
#pragma unroll
  for (int j = 0; j < 4; ++j) s[j] = 0.f;
  for (int k = 0; k < 16; ++k) {
    const bf16_t* pr = P + (size_t)(NTOK + k) * PW;
    const float v = bf2f(pr[1792 + h * 128 + e]);
#pragma unroll
    for (int j = 0; j < 4; ++j) s[j] = gamma * s[j] + bf2f(pr[1280 + h * 128 + d4 * 4 + j]) * v;
  }
  for (int c = 0; c < 32; ++c) {
    float* ptr = ST + ((size_t)((b * 32 + c) * 4 + h) * 128 + e) * 128 + d4 * 4;
    const float4 a = *(const float4*)ptr;
    *(float4*)ptr = make_float4(s[0], s[1], s[2], s[3]);
    s[0] = g64 * s[0] + a.x; s[1] = g64 * s[1] + a.y; s[2] = g64 * s[2] + a.z; s[3] = g64 * s[3] + a.w;
  }
#pragma unroll
  for (int j = 0; j < 4; ++j) out[O_RETP + ((size_t)(b * 4 + h) * 128 + d4 * 4 + j) * 128 + e] = s[j];
}

__device__ __forceinline__ void ret_out_unit(int u, int h, char* smem, const bf16_t* __restrict__ P, const float* __restrict__ ST,
                                             const float* __restrict__ gn_g, bf16_t* __restrict__ mixed) {
  const int t = opaque_tid(), lane = t & 63, wave = t >> 6, r = lane & 31, hh = lane >> 5;
  char* RQ = smem;
  char* RK = smem + 16384;
  char* RVT = smem + 32768;
  char* YL = smem + 49152;
  float* red = (float*)smem;
  const int row0 = unit_row0(u);
  const float lg2 = log2f(1.0f - exp2f(-5.0f - (float)h));
  __syncthreads();
  stage_R(RQ, P + (size_t)row0 * PW + 768 + h * 128);
  stage_R(RK, P + (size_t)row0 * PW + 1280 + h * 128);
  stage_T(RVT, P + (size_t)row0 * PW + 1792 + h * 128, nullptr);
  __syncthreads();
  const int qt = wave & 1, ep = wave >> 1;
  const int q = 32 * qt + r;
  f32x16 X[2];
#pragma unroll
  for (int kt = 0; kt < 2; ++kt) {
#pragma unroll
    for (int e = 0; e < 16; ++e) X[kt][e] = 0.f;
    if (kt <= qt) {
#pragma unroll
      for (int ks = 0; ks < 8; ++ks) {
        const int krow = 32 * kt + r, qrow = 32 * qt + r;
        const bf16x8 kf = *(const bf16x8*)(RK + krow * 256 + (((2 * ks + hh) ^ (krow & 15)) << 4));
        const bf16x8 qf = *(const bf16x8*)(RQ + qrow * 256 + (((2 * ks + hh) ^ (qrow & 15)) << 4));
        X[kt] = __builtin_amdgcn_mfma_f32_32x32x16_bf16(kf, qf, X[kt], 0, 0, 0);
      }
#pragma unroll
      for (int e = 0; e < 16; ++e) {
        const int k = 32 * kt + (e & 3) + 8 * (e >> 2) + 4 * hh;
        X[kt][e] = (q >= k) ? X[kt][e] * exp2f((float)(q - k) * lg2) : 0.f;
      }
    }
  }
  f32x16 O[2];
  const float* Su = ST + (size_t)(u * 4 + h) * 16384;
#pragma unroll
  for (int ei = 0; ei < 2; ++ei) {
#pragma unroll
    for (int e = 0; e < 16; ++e) O[ei][e] = 0.f;
    const int erow = 32 * (2 * ep + ei) + r;
#pragma unroll
    for (int ks = 0; ks < 8; ++ks) {
      const float4 s0 = *(const float4*)(Su + erow * 128 + 16 * ks + 8 * hh);
      const float4 s1 = *(const float4*)(Su + erow * 128 + 16 * ks + 8 * hh + 4);
      u32x4 sp;
      sp[0] = pack_bf16(s0.x, s0.y); sp[1] = pack_bf16(s0.z, s0.w); sp[2] = pack_bf16(s1.x, s1.y); sp[3] = pack_bf16(s1.z, s1.w);
      bf16x8 sf;
      __builtin_memcpy(&sf, &sp, 16);
      const int qrow = 32 * qt + r;
      const bf16x8 qf = *(const bf16x8*)(RQ + qrow * 256 + (((2 * ks + hh) ^ (qrow & 15)) << 4));
      O[ei] = __builtin_amdgcn_mfma_f32_32x32x16_bf16(sf, qf, O[ei], 0, 0, 0);
    }
    const float qd = exp2f((float)(q + 1) * lg2);
#pragma unroll
    for (int e = 0; e < 16; ++e) O[ei][e] *= qd;
  }
#pragma unroll
  for (int kt = 0; kt < 2; ++kt) {
    if (kt <= qt) {
#pragma unroll
      for (int sidx = 0; sidx < 2; ++sidx) {
        u32x4 xp;
#pragma unroll
        for (int j = 0; j < 4; ++j) xp[j] = pack_bf16(X[kt][8 * sidx + 2 * j], X[kt][8 * sidx + 2 * j + 1]);
        bf16x8 xf;
        __builtin_memcpy(&xf, &xp, 16);
#pragma unroll
        for (int ei = 0; ei < 2; ++ei) {
          const int erow = 32 * (2 * ep + ei) + r;
          const uint2 a0 = *(const uint2*)(RVT + tile_off(erow, 4 * kt + 2 * sidx) + 8 * hh);
          const uint2 a1 = *(const uint2*)(RVT + tile_off(erow, 4 * kt + 2 * sidx + 1) + 8 * hh);
          u32x4 ap;
          ap[0] = a0.x; ap[1] = a0.y; ap[2] = a1.x; ap[3] = a1.y;
          bf16x8 af;
          __builtin_memcpy(&af, &ap, 16);
          O[ei] = __builtin_amdgcn_mfma_f32_32x32x16_bf16(af, xf, O[ei], 0, 0, 0);
        }
      }
    }
  }
  float s1 = 0.f, s2 = 0.f;
#pragma unroll
  for (int ei = 0; ei < 2; ++ei)
#pragma unroll
    for (int e = 0; e < 16; ++e) { s1 += O[ei][e]; s2 += O[ei][e] * O[ei][e]; }
  s1 += __shfl_xor(s1, 32);
  s2 += __shfl_xor(s2, 32);
  __syncthreads();
  if (hh == 0) { red[(wave * 32 + r) * 2] = s1; red[(wave * 32 + r) * 2 + 1] = s2; }
  __syncthreads();
  {
    const int pw = wave ^ 2;
    s1 += red[(pw * 32 + r) * 2];
    s2 += red[(pw * 32 + r) * 2 + 1];
  }
  const float mean = s1 * (1.0f / 128.0f);
  const float rstd = rsqrtf(fmaxf(s2 * (1.0f / 128.0f) - mean * mean, 0.f) + LN_EPS);
  const bf16_t* rgp = P + (size_t)(row0 + q) * PW + 2304 + h * 128;
#pragma unroll
  for (int ei = 0; ei < 2; ++ei)
#pragma unroll
    for (int g = 0; g < 4; ++g) {
      const int e0 = 32 * (2 * ep + ei) + 8 * g + 4 * hh;
      const uint2 rg = *(const uint2*)(rgp + e0);
      const float4 gg = *(const float4*)(gn_g + h * 128 + e0);
      const float g0 = __uint_as_float(rg.x << 16), g1 = __uint_as_float(rg.x & 0xffff0000u), g2 = __uint_as_float(rg.y << 16), g3 = __uint_as_float(rg.y & 0xffff0000u);
      const float y0 = (O[ei][4 * g + 0] - mean) * rstd * gg.x * (g0 / (1.0f + __expf(-g0)));
      const float y1 = (O[ei][4 * g + 1] - mean) * rstd * gg.y * (g1 / (1.0f + __expf(-g1)));
      const float y2 = (O[ei][4 * g + 2] - mean) * rstd * gg.z * (g2 / (1.0f + __expf(-g2)));
      const float y3 = (O[ei][4 * g + 3] - mean) * rstd * gg.w * (g3 / (1.0f + __expf(-g3)));
      uint2 w;
      w.x = pack_bf16(y0, y1); w.y = pack_bf16(y2, y3);
      const int c = e0 >> 3;
      *(uint2*)(YL + q * 256 + ((c ^ (q & 15)) << 4) + 8 * hh) = w;
    }
  __syncthreads();
#pragma unroll
  for (int i = 0; i < 4; ++i) {
    const int qq = t + 256 * i, row = qq >> 4, c = qq & 15;
    *(u32x4*)(mixed + (size_t)(row0 + row) * D + 512 + h * 128 + c * 8) = *(const u32x4*)(YL + row * 256 + ((c ^ (row & 15)) << 4));
  }
}


constexpr int VT_STRIDE = 456;

struct AttnSrc {
  const bf16_t* P; const float *cmk, *cmv, *csk, *csv;
  int samp, b, c, kvh;
  __device__ __forceinline__ u32x4 load(int kk, int ch, bool isv) const {
    u32x4 z = make_u32x4_zero();
    const bf16_t* src = nullptr;
    const float* fsrc = nullptr;
    const int col = (isv ? 640 : 512) + kvh * 64 + ch * 8;
    if (kk < 16) {
      if (samp) fsrc = (isv ? cmv : cmk) + ((size_t)(b * 16 + kk) * 2 + kvh) * 64 + ch * 8;
      else src = P + (size_t)(NTOK + kk) * PW + col;
    } else if (kk < 208) {
      const int jb = kk - 16;
      if (samp) {
        if (jb < 128) fsrc = (isv ? csv : csk) + ((size_t)(b * 128 + jb) * 2 + kvh) * 64 + ch * 8;
        else src = P + (size_t)(NPROMPT + b * 64 + (jb - 128)) * PW + col;
      } else {
        const int f = (c - 2) * 64 + jb;
        if (f >= 0) src = P + (size_t)(b * SEQ + f) * PW + col;
      }
    }
    if (src) z = *(const u32x4*)src;
    else if (fsrc) {
      const float4 a = *(const float4*)fsrc, bq = *(const float4*)(fsrc + 4);
      z[0] = pack_bf16(a.x, a.y); z[1] = pack_bf16(a.z, a.w); z[2] = pack_bf16(bq.x, bq.y); z[3] = pack_bf16(bq.z, bq.w);
    }
    return z;
  }
};

__device__ __forceinline__ void attn_unit(int u, int kvh, char* smem, const bf16_t* __restrict__ P, const float* __restrict__ cmk,
                                          const float* __restrict__ cmv, const float* __restrict__ csk, const float* __restrict__ csv,
                                          const float* __restrict__ rel_bias, const float* __restrict__ sinks, bf16_t* __restrict__ mixed) {
  const int t = opaque_tid(), lane = t & 63, g = t >> 6, r = lane & 31, hh = lane >> 5;
  char* KT = smem;
  char* VT = smem + 28672;
  float* TB = (float*)(smem + 28672 + 64 * VT_STRIDE) + g * 384;
  AttnSrc as;
  as.P = P; as.cmk = cmk; as.cmv = cmv; as.csk = csk; as.csv = csv;
  as.samp = u >= 256; as.b = as.samp ? u - 256 : u >> 5; as.c = as.samp ? 32 : (u & 31); as.kvh = kvh;
  const int H = kvh * 4 + g;
  const int row0 = unit_row0(u);
  __syncthreads();
#pragma unroll
  for (int i = 0; i < 7; ++i) {
    const int qidx = t + 256 * i, key = qidx >> 3, ch = qidx & 7;
    *(u32x4*)(KT + tile_off(key, ch)) = as.load(key, ch, false);
  }
  for (int item = t; item < 896; item += 256) {
    const int fc = item / 112, tp = item - fc * 112;
    const u32x4 a = as.load(2 * tp, fc, true), bq = as.load(2 * tp + 1, fc, true);
#pragma unroll
    for (int q = 0; q < 4; ++q) {
      *(uint32_t*)(VT + (fc * 8 + 2 * q) * VT_STRIDE + tp * 4) = (a[q] & 0xffffu) | (bq[q] << 16);
      *(uint32_t*)(VT + (fc * 8 + 2 * q + 1) * VT_STRIDE + tp * 4) = (a[q] >> 16) | (bq[q] & 0xffff0000u);
    }
  }
  for (int idx = lane; idx < 383; idx += 64) TB[idx] = rel_bias[t5_bucket(idx - 191) * 8 + H];
  __syncthreads();
  const float sink = sinks[H];
#pragma unroll 1
  for (int qt = 0; qt < 2; ++qt) {
    bf16x8 qf[4];
#pragma unroll
    for (int ks = 0; ks < 4; ++ks) qf[ks] = *(const bf16x8*)(P + (size_t)(row0 + 32 * qt + r) * PW + H * 64 + ks * 16 + 8 * hh);
    f32x16 S[7];
#pragma unroll
    for (int kt = 0; kt < 7; ++kt) {
#pragma unroll
      for (int e = 0; e < 16; ++e) S[kt][e] = 0.f;
#pragma unroll
      for (int ks = 0; ks < 4; ++ks) {
        const bf16x8 kf = *(const bf16x8*)(KT + tile_off(32 * kt + r, 2 * ks + hh));
        S[kt] = __builtin_amdgcn_mfma_f32_32x32x16_bf16(kf, qf[ks], S[kt], 0, 0, 0);
      }
    }
    const int i = 32 * qt + r, posq = 16 + as.c * 64 + i;
    float mx = -3.0e38f;
#pragma unroll
    for (int kt = 0; kt < 7; ++kt)
#pragma unroll
      for (int e = 0; e < 16; ++e) {
        const int kk = 32 * kt + (e & 3) + 8 * (e >> 2) + 4 * hh;
        const int rel = kk < 16 ? kk - posq : kk - 144 - i;
        const bool valid = kk < 16 || (kk < 208 && (as.samp || (as.c - 2) * 64 + (kk - 16) >= 0));
        const int ti = (rel < -191 ? -191 : rel) + 191;
        const float sv = valid ? S[kt][e] * 0.125f + TB[ti] : -1.0e30f;
        S[kt][e] = sv;
        mx = fmaxf(mx, sv);
        if (e == 15) __builtin_amdgcn_sched_barrier(0);
      }
    mx = fmaxf(mx, __shfl_xor(mx, 32));
    const float m = fmaxf(mx, sink);
    float ls = 0.f;
#pragma unroll
    for (int kt = 0; kt < 7; ++kt)
#pragma unroll
      for (int e = 0; e < 16; ++e) {
        const float pv = __expf(S[kt][e] - m);
        S[kt][e] = pv;
        ls += pv;
        if (e == 15) __builtin_amdgcn_sched_barrier(0);
      }
    ls += __shfl_xor(ls, 32);
    const float inv = 1.0f / (ls + __expf(sink - m));
    f32x16 O[2];
#pragma unroll
    for (int dt = 0; dt < 2; ++dt)
#pragma unroll
      for (int e = 0; e < 16; ++e) O[dt][e] = 0.f;
#pragma unroll
    for (int kt = 0; kt < 7; ++kt)
#pragma unroll
      for (int sidx = 0; sidx < 2; ++sidx) {
        u32x4 xp;
#pragma unroll
        for (int j = 0; j < 4; ++j) xp[j] = pack_bf16(S[kt][8 * sidx + 2 * j], S[kt][8 * sidx + 2 * j + 1]);
        bf16x8 xf;
        __builtin_memcpy(&xf, &xp, 16);
#pragma unroll
        for (int dt = 0; dt < 2; ++dt) {
          const char* vp = VT + (32 * dt + r) * VT_STRIDE + (32 * kt + 16 * sidx + 4 * hh) * 2;
          const uint2 a0 = *(const uint2*)vp, a1 = *(const uint2*)(vp + 16);
          u32x4 ap;
          ap[0] = a0.x; ap[1] = a0.y; ap[2] = a1.x; ap[3] = a1.y;
          bf16x8 af;
          __builtin_memcpy(&af, &ap, 16);
          O[dt] = __builtin_amdgcn_mfma_f32_32x32x16_bf16(af, xf, O[dt], 0, 0, 0);
        }
      }
    bf16_t* op = mixed + (size_t)(row0 + i) * D + H * 64 + 4 * hh;
#pragma unroll
    for (int dt = 0; dt < 2; ++dt)
#pragma unroll
      for (int g4 = 0; g4 < 4; ++g4) {
        uint2 w;
        w.x = pack_bf16(O[dt][4 * g4] * inv, O[dt][4 * g4 + 1] * inv);
        w.y = pack_bf16(O[dt][4 * g4 + 2] * inv, O[dt][4 * g4 + 3] * inv);
        *(uint2*)(op + 32 * dt + 8 * g4) = w;
      }
  }
}


#define XB_TMO      128
#define XB_XCNT(j)  (256  + 64 * (j))
#define XB_XSUB(j)  (1280 + 64 * (j))
#define XB_XGEN(j)  (2304 + 64 * (j))
#define XB_TOP      3328
#define XB_TOPGEN   3392
#define XCD_BAR_WORDS 3456
#define XB_SPIN_CAP (1u << 18)
#define LAS __attribute__((address_space(3)))
__device__ __forceinline__ unsigned xb_ld(unsigned* p)              { return __hip_atomic_load(p, __ATOMIC_RELAXED, __HIP_MEMORY_SCOPE_AGENT); }
__device__ __forceinline__ unsigned xb_add(unsigned* p, unsigned v) { return __hip_atomic_fetch_add(p, v, __ATOMIC_RELAXED, __HIP_MEMORY_SCOPE_AGENT); }
__device__ __forceinline__ unsigned xb_xcc_id() { return (unsigned)__builtin_amdgcn_s_getreg((3 << 11) | 20) & 0xFu; }
#define XB_SPIN(cond, bar) do { unsigned _sp = 0; while (cond) { __builtin_amdgcn_s_sleep(1); \
    if ((++_sp & 255u) == 0u) { if (xb_ld(&(bar)[XB_TMO])) break; if (_sp > XB_SPIN_CAP) { atomicAdd(&(bar)[XB_TMO], 1u); break; } } } } while (0)
struct XcdBarrier { unsigned* bar; unsigned x; volatile LAS unsigned* st; };
__device__ __forceinline__ XcdBarrier xcd_barrier_post(unsigned* bar, volatile LAS unsigned* st) {
  XcdBarrier b; b.bar = bar; b.x = xb_xcc_id(); b.st = st;
  if (threadIdx.x == 0) (void)xb_add(&bar[XB_XCNT(b.x)], 1u);
  return b;
}
__device__ __forceinline__ void xcd_barrier_complete(unsigned* bar, unsigned x, unsigned& nloc, unsigned& nx) {
  const unsigned G = gridDim.x * gridDim.y * gridDim.z;
  unsigned sum, cnt, mine, sp = 0u;
  for (;;) {
    sum = 0u; cnt = 0u; mine = 0u;
#pragma unroll
    for (unsigned j = 0; j < 16; ++j) { const unsigned c = xb_ld(&bar[XB_XCNT(j)]); sum += c; cnt += (c > 0u) ? 1u : 0u; mine = (j == x) ? c : mine; }
    if (sum == G) break;
    __builtin_amdgcn_s_sleep(1);
    if ((++sp & 255u) == 0u) { if (xb_ld(&bar[XB_TMO])) break; if (sp > XB_SPIN_CAP) { atomicAdd(&bar[XB_TMO], 1u); break; } }
  }
  nloc = mine > 0u ? mine : 1u; nx = cnt > 0u ? cnt : 1u;
}
__device__ __forceinline__ void xcd_barrier(const XcdBarrier& b) {
  asm volatile("s_waitcnt vmcnt(0)" ::: "memory");
  __syncthreads();
  if (threadIdx.x == 0) {
    unsigned* bar = b.bar;
    __builtin_amdgcn_s_waitcnt(0);
    unsigned nloc = b.st[0], nx = b.st[1];
    if (nloc == 0u) { xcd_barrier_complete(bar, b.x, nloc, nx); b.st[0] = nloc; b.st[1] = nx; }
    const unsigned old = xb_add(&bar[XB_XSUB(b.x)], 1u);
    const unsigned gen = old / nloc;
    if (old + 1u == (gen + 1u) * nloc) {
      __builtin_amdgcn_fence(__ATOMIC_RELEASE, "agent");
      asm volatile("s_waitcnt vmcnt(0)" ::: "memory");
      const unsigned og = xb_add(&bar[XB_TOP], 1u);
      const unsigned tg = og / nx;
      if (og + 1u == (tg + 1u) * nx) xb_add(&bar[XB_TOPGEN], 1u);
      else XB_SPIN(xb_ld(&bar[XB_TOPGEN]) == tg, bar);
      __builtin_amdgcn_fence(__ATOMIC_ACQUIRE, "agent");
      xb_add(&bar[XB_XGEN(b.x)], 1u);
      asm volatile("s_waitcnt vmcnt(0)" ::: "memory");
    } else {
      XB_SPIN(xb_ld(&bar[XB_XGEN(b.x)]) == gen, bar);
      __builtin_amdgcn_fence(__ATOMIC_ACQUIRE, "agent");
      asm volatile("s_waitcnt vmcnt(0)" ::: "memory");
    }
  }
  __syncthreads();
}

struct Params {
  const float *x_prompt, *x_sample, *cmk, *cmv, *csk, *csv, *state_ret, *meta_tokens, *ln_in_g, *ln_in_b, *rel_bias, *w_in,
      *w_out, *sinks, *gn_g, *ln1_g, *ln1_b, *peer_wq, *subk, *peer_u, *peer_v, *ln2_g, *ln2_b;
  float* out;
  char* ws;
};

#ifndef PHASE_MASK
#define PHASE_MASK 0x1ff
#endif
#ifndef PHASE_TWICE
#define PHASE_TWICE 0
#endif
#define PH_ON(n) (((PHASE_MASK) >> (n)) & 1)
#define PH_REP(n) for (int rep_ = 0; rep_ < 1 + (((PHASE_TWICE) >> (n)) & 1); ++rep_)

__global__ void __launch_bounds__(256, 2) mega_kernel(Params p) {
  __shared__ __attribute__((aligned(16))) char smem[65536 + 16];
  if (threadIdx.x < 4) ((unsigned*)(smem + 65536))[threadIdx.x] = 0u;
  __syncthreads();
  const XcdBarrier xb = xcd_barrier_post((unsigned*)(p.ws + W_BAR), (volatile LAS unsigned*)(smem + 65536));
  const int G = gridDim.x, bid = blockIdx.x;
  bf16_t* hbf = (bf16_t*)(p.ws + W_HBF);
  bf16_t* P = (bf16_t*)(p.ws + W_P);
  float* z = (float*)(p.ws + W_P);
  bf16_t* mixed = (bf16_t*)(p.ws + W_MIXED);
  int* lidx = (int*)(p.ws + W_LIDX);
  float* lgate = (float*)(p.ws + W_LGATE);
  bf16_t* wt_in = (bf16_t*)(p.ws + W_WTIN);
  bf16_t* wt_out = (bf16_t*)(p.ws + W_WTOUT);
  bf16_t* wt_q = (bf16_t*)(p.ws + W_WTQ);
  float2* rope = (float2*)(p.ws + W_ROPE);
  bf16_t* h1bf = mixed;
  uint8_t* U8 = (uint8_t*)(p.ws + W_U8);
  uint8_t* V8 = (uint8_t*)(p.ws + W_V8);
  float* su = (float*)(p.ws + W_SU);
  float* sv = (float*)(p.ws + W_SV);
  uint8_t* xq = (uint8_t*)(p.ws + W_XQ);
  bf16_t* subk_bf = (bf16_t*)(p.ws + W_SUBK);
  float* xs = (float*)(p.ws + W_XS);
  float* ST = p.out;
  const int nw = blockDim.x >> 6, W = G * nw;

  if (PH_ON(0)) PH_REP(0) {
    const int lane = opaque_tid() & 63, gw = bid * nw + (opaque_tid() >> 6);
    for (int r = bid; r < NROWS; r += G) ln_in_body(r, (float*)smem, p.x_prompt, p.x_sample, p.meta_tokens, p.ln_in_g, p.ln_in_b, hbf);
    for (int u = bid; u < 704 + 256 + 256; u += G) {
      if (u < 704) transpose_tile(u % 16, u / 16, smem, p.w_in, PW, D, wt_in);
      else if (u < 960) transpose_tile((u - 704) % 16, (u - 704) / 16, smem, p.w_out, D, D, wt_out);
      else transpose_tile((u - 960) % 16, (u - 960) / 16, smem, p.peer_wq, D, D, wt_q);
    }
    for (int idx = bid * 256 + opaque_tid(); idx < 2128 * 64; idx += G * 256) {
      const int pos = idx >> 6, d = idx & 63;
      const float inv = powf(10000.0f, -(float)d / 64.0f);
      float sn, cs;
      sincosf((float)pos * inv, &sn, &cs);
      rope[idx] = make_float2(cs, sn);
    }
    for (int idx = bid * 256 + opaque_tid(); idx < 131072; idx += G * 256) subk_bf[idx] = f2bf(p.subk[idx]);
    for (int r = gw; r < 32768; r += W) {
      if (r < 16384) quant_table_row(p.peer_u + (size_t)r * D, lane, U8 + (size_t)r * 1024, su + r, false);
      else quant_table_row(p.peer_v + (size_t)(r - 16384) * D, lane, V8 + (size_t)(r - 16384) * 1024, sv + (r - 16384), true);
    }
  }
  xcd_barrier(xb);
  if (PH_ON(1)) PH_REP(1)
    for (int u = bid; u < 22 * 133; u += G) gemm_mfma_tile(u / 22, u % 22, smem, hbf, NROWS, wt_in, D, EpiInProjM{P, p.out, rope});
  xcd_barrier(xb);
  if (PH_ON(2)) PH_REP(2)
    for (int u = bid; u < 1056 + 528; u += G) {
      if (u < 1056) ret_state_unit(u >> 2, u & 3, smem, P, ST);
      else attn_unit((u - 1056) >> 1, (u - 1056) & 1, smem, P, p.cmk, p.cmv, p.csk, p.csv, p.rel_bias, p.sinks, mixed);
    }
  xcd_barrier(xb);
  if (PH_ON(3))
    for (int ci = bid * 256 + opaque_tid(); ci < 262144; ci += G * 256) ret_scan_chain(ci, P, p.state_ret, ST, p.out);
  xcd_barrier(xb);
  if (PH_ON(4)) PH_REP(4)
    for (int u = bid; u < 1056; u += G) ret_out_unit(u >> 2, u & 3, smem, P, ST, p.gn_g, mixed);
  xcd_barrier(xb);
  if (PH_ON(5)) PH_REP(5)
    for (int u = bid; u < 8 * 132; u += G) gemm_mfma_tile(u / 8, u % 8, smem, mixed, NTOK, wt_out, D, EpiOutProjM{hbf, z});
  xcd_barrier(xb);
  if (PH_ON(6)) {
    const int lane = opaque_tid() & 63, gw = bid * nw + (opaque_tid() >> 6);
    for (int r = gw; r < NTOK; r += W) ln1_row_wave(r, lane, z, p.ln1_g, p.ln1_b, h1bf, xq, xs);
  }
  xcd_barrier(xb);
  if (PH_ON(7)) PH_REP(7)
    for (int u = bid; u < 8 * 132; u += G) gemm_mfma_tile(u / 8, u % 8, smem, h1bf, NTOK, wt_q, D, EpiTopK{subk_bf, lidx, lgate});
  xcd_barrier(xb);
  if (PH_ON(8)) PH_REP(8) {
    const int lane = opaque_tid() & 63, wave = opaque_tid() >> 6, gw = bid * nw + wave;
    const SweepArgs sa{lidx, lgate, U8, V8, su, sv, xq, xs, z, p.ln2_g, p.ln2_b, p.out};
    const int TPP = W * 4;
    const int NPF = NTOK / TPP;
    for (int pass = 0; pass < NPF; ++pass)
      sweep_wave(pass * TPP + gw * 4, 4, 0, 7, 0, lane, wave, smem + wave * SW_LDS_PER_WAVE, sa);
    for (int tk = NPF * TPP + bid; tk < NTOK; tk += G)
      sweep_wave(tk, 1, wave * 32, 5, 1, lane, wave, smem + wave * SW_LDS_PER_WAVE, sa);
  }
#ifdef PROBE_SYNCS
  for (int i = 0; i < PROBE_SYNCS; ++i) xcd_barrier(xb);
#endif
}

}

extern "C" void kernel_launch(void* const* d_in, const int* in_sizes, int n_in, void* d_out, int out_size, void* d_ws,
                              size_t ws_size, hipStream_t stream) {
  static int grid_blocks = 0;
  if (!grid_blocks) {
    int dev = 0, cus = 0, per_cu = 0;
    (void)hipGetDevice(&dev);
    (void)hipDeviceGetAttribute(&cus, hipDeviceAttributeMultiprocessorCount, dev);
    (void)hipOccupancyMaxActiveBlocksPerMultiprocessor(&per_cu, mega_kernel, 256, 0);
    if (per_cu > 2) per_cu = 2;
    if (per_cu < 1) per_cu = 1;
    grid_blocks = cus * per_cu;
  }
  Params p{};
  const float** pp = (const float**)&p;
  for (int i = 0; i < 23; ++i) pp[i] = (const float*)d_in[i];
  p.out = (float*)d_out;
  p.ws = (char*)d_ws;
  void* args[] = {&p};
  (void)hipMemsetAsync((char*)d_ws + W_BAR, 0, 3456 * 4, stream);
  hipError_t e = hipLaunchCooperativeKernel((void*)mega_kernel, dim3(grid_blocks), dim3(256), args, 0, stream);
  if (e != hipSuccess) fprintf(stderr, "cooperative launch failed: %s (grid %d)\n", hipGetErrorString(e), grid_blocks);
}
```

```cpp
#include <hip/hip_runtime.h>
#include <hip/hip_cooperative_groups.h>
#include <stdint.h>
#include <cstdio>
namespace cg = cooperative_groups;

namespace {

constexpr int D = 1024;
constexpr int NB = 8, SEQ = 2048, DSEQ = 64;
constexpr int NPROMPT = NB * SEQ;
constexpr int NSAMPLE = NB * DSEQ;
constexpr int NTOK = NPROMPT + NSAMPLE;
constexpr int NMETA = 16;
constexpr int NROWS = NTOK + NMETA;
constexpr int PW = 2816;
constexpr float LN_EPS = 1e-5f;
constexpr float ALPHA = 1.18920711500272f;

constexpr size_t O_Y = 0;
constexpr size_t O_METAK = 17301504;
constexpr size_t O_METAV = O_METAK + 16384;
constexpr size_t O_SWAKP = O_METAV + 16384;
constexpr size_t O_SWAVP = O_SWAKP + 131072;
constexpr size_t O_RETP = O_SWAVP + 131072;
constexpr size_t O_SWAKS = O_RETP + 524288;
constexpr size_t O_SWAVS = O_SWAKS + 65536;
constexpr size_t O_RETS = O_SWAVS + 65536;

constexpr size_t W_HBF = 0;
constexpr size_t W_P = W_HBF + (size_t)NROWS * D * 2;
constexpr size_t W_MIXED = W_P + (size_t)NROWS * PW * 2;
constexpr size_t W_LIDX = W_MIXED + (size_t)NTOK * D * 2;
constexpr size_t W_LGATE = W_LIDX + (size_t)NTOK * 128 * 4;
constexpr size_t W_WTIN = W_LGATE + (size_t)NTOK * 128 * 4;
constexpr size_t W_WTOUT = W_WTIN + (size_t)PW * D * 2;
constexpr size_t W_WTQ = W_WTOUT + (size_t)D * D * 2;
constexpr size_t W_ROPE = W_WTQ + (size_t)D * D * 2;
constexpr size_t W_U8 = W_ROPE + (size_t)2128 * 64 * 8;
constexpr size_t W_V8 = W_U8 + (size_t)16384 * 1024;
constexpr size_t W_SU = W_V8 + (size_t)16384 * 1024;
constexpr size_t W_SV = W_SU + 65536;
constexpr size_t W_XQ = W_SV + 65536;
constexpr size_t W_XS = W_XQ + (size_t)NTOK * 1024;
constexpr size_t W_SUBK = W_XS + (size_t)NTOK * 4 + 256;
constexpr size_t W_BAR = W_SUBK + 131072 * 2;
constexpr size_t W_END = W_BAR + 3456 * 4;
static_assert(W_END <= (size_t)256 * 1024 * 1024, "workspace overflow");

typedef uint16_t bf16_t;

__device__ __forceinline__ int opaque_tid() { int t = (int)threadIdx.x; asm volatile("" : "+v"(t)); return t; }

__device__ __forceinline__ bf16_t f2bf(float f) {
  uint32_t u = __float_as_uint(f);
  u += 0x7FFFu + ((u >> 16) & 1u);
  return (bf16_t)(u >> 16);
}
__device__ __forceinline__ float bf2f(bf16_t h) { return __uint_as_float(((uint32_t)h) << 16); }

__device__ __forceinline__ int row_pos(int r) {
  if (r < NPROMPT) return 16 + (r & 2047);
  if (r < NTOK) return 16 + 2048 + ((r - NPROMPT) & 63);
  return r - NTOK;
}


template <int M> __device__ __forceinline__ int lane_xor_i(int x) {
  if (M == 1) return __builtin_amdgcn_mov_dpp(x, 0xB1, 0xF, 0xF, true);
  else if (M == 2) return __builtin_amdgcn_mov_dpp(x, 0x4E, 0xF, 0xF, true);
  else if (M == 4) return __builtin_amdgcn_mov_dpp(__builtin_amdgcn_mov_dpp(x, 0x141, 0xF, 0xF, true), 0x1B, 0xF, 0xF, true);
  else if (M == 8) return __builtin_amdgcn_mov_dpp(__builtin_amdgcn_mov_dpp(x, 0x140, 0xF, 0xF, true), 0x141, 0xF, 0xF, true);
  else if (M == 16) return __builtin_amdgcn_ds_swizzle(x, 0x401F);
  else {
    const auto r = __builtin_amdgcn_permlane32_swap((unsigned)x, (unsigned)x, false, false);
    return (int)((__builtin_amdgcn_mbcnt_hi(~0u, __builtin_amdgcn_mbcnt_lo(~0u, 0u)) < 32u) ? r[1] : r[0]);
  }
}
template <int M> __device__ __forceinline__ float lane_xor_f(float x) { return __int_as_float(lane_xor_i<M>(__float_as_int(x))); }

__device__ __forceinline__ float wave_sum(float v) {
  v += lane_xor_f<1>(v); v += lane_xor_f<2>(v); v += lane_xor_f<4>(v); v += lane_xor_f<8>(v); v += lane_xor_f<16>(v); v += lane_xor_f<32>(v);
  return v;
}


__device__ __forceinline__ int t5_bucket(int rel) {
  int n = rel < 0 ? -rel : rel;
  int b;
  if (n < 8) b = n;
  else {
    int l = 2 + 31 - __clz(n * n);
    b = l > 15 ? 15 : l;
  }
  return (rel > 0 ? 16 : 0) + b;
}

__device__ __forceinline__ float gelu_tanh(float x) {
  float u = 0.7978845608028654f * (x + 0.044715f * x * x * x);
  return 0.5f * x * (1.0f + tanhf(u));
}


typedef short bf16x8 __attribute__((ext_vector_type(8)));
typedef float f32x16 __attribute__((ext_vector_type(16)));
typedef uint32_t u32x4 __attribute__((ext_vector_type(4)));
__device__ __forceinline__ u32x4 make_u32x4_zero() { u32x4 r; r[0] = 0; r[1] = 0; r[2] = 0; r[3] = 0; return r; }

__device__ __forceinline__ uint32_t pack_bf16(float lo, float hi) { return (uint32_t)f2bf(lo) | ((uint32_t)f2bf(hi) << 16); }

__device__ __forceinline__ int tile_off(int row, int c) {
  const int s = row >> 1;
  const int sc = ((row & 1) << 3) | c;
  return s * 256 + ((sc ^ (s & 15)) << 4);
}

template <int GV, class EPI>
__device__ __forceinline__ void gemm_mfma_tile_v(int mt, int nt, char* smem, const bf16_t* __restrict__ A, int M,
                                               const bf16_t* __restrict__ Bt, int K, const EPI& epi) {
  const int t = opaque_tid(), lane = t & 63, wave = t >> 6, r = lane & 31, h = lane >> 5;
  const int m0 = mt * 128, n0 = nt * 128;
  const bf16_t* ag[4];
  const bf16_t* bg[4];
#pragma unroll
  for (int i = 0; i < 4; ++i) {
    const int o = (wave * 4 + i) * 1024 + lane * 16;
    const int sr = o >> 8, scp = (o >> 4) & 15, sc = scp ^ (sr & 15);
    const int row = 2 * sr + (sc >> 3), c = sc & 7;
    int ar = m0 + row;
    ar = ar < M ? ar : M - 1;
    ag[i] = A + (size_t)ar * K + c * 8;
    bg[i] = Bt + (size_t)(n0 + row) * K + c * 8;
  }
  int roff[4];
#pragma unroll
  for (int ks = 0; ks < 4; ++ks) roff[ks] = tile_off(r, ks * 2 + h);
  f32x16 acc[4];
#pragma unroll
  for (int j = 0; j < 4; ++j)
#pragma unroll
    for (int e = 0; e < 16; ++e) acc[j][e] = 0.f;
  __syncthreads();
#pragma unroll
  for (int i = 0; i < 4; ++i) {
    __builtin_amdgcn_global_load_lds((const unsigned*)ag[i], (unsigned*)(smem + (wave * 4 + i) * 1024), 16, 0, 0);
    __builtin_amdgcn_global_load_lds((const unsigned*)bg[i], (unsigned*)(smem + 16384 + (wave * 4 + i) * 1024), 16, 0, 0);
  }
  __syncthreads();
  const int nk = K >> 6;
  for (int kt = 0; kt < nk; ++kt) {
    char* cur = smem + (kt & 1) * 32768;
    char* nxt = smem + ((kt + 1) & 1) * 32768;
    if (GV != 1 && kt + 1 < nk) {
#pragma unroll
      for (int i = 0; i < 4; ++i) {
        __builtin_amdgcn_global_load_lds((const unsigned*)(ag[i] + (kt + 1) * 64), (unsigned*)(nxt + (wave * 4 + i) * 1024), 16, 0, 0);
        __builtin_amdgcn_global_load_lds((const unsigned*)(bg[i] + (kt + 1) * 64), (unsigned*)(nxt + 16384 + (wave * 4 + i) * 1024), 16, 0, 0);
      }
    }
    const char* sa = cur + wave * 4096;
    const char* sb = cur + 16384;
    if (GV != 2) {
#pragma unroll
    for (int ks = 0; ks < 4; ++ks) {
      const bf16x8 af = *(const bf16x8*)(sa + roff[ks]);
#pragma unroll
      for (int j = 0; j < 4; ++j) {
        const bf16x8 bfr = *(const bf16x8*)(sb + j * 4096 + roff[ks]);
        acc[j] = __builtin_amdgcn_mfma_f32_32x32x16_bf16(bfr, af, acc[j], 0, 0, 0);
      }
    }
    }
    __syncthreads();
  }
  const int row = m0 + wave * 32 + r;
  if (GV == 4) { epi(row, 0, h, acc, smem); return; }
  if (GV == 5) { epi(row, 6 + (nt & 7), h, acc, smem); return; }
  if (GV != 0) { asm volatile("" :: "v"(acc[0]), "v"(acc[1]), "v"(acc[2]), "v"(acc[3])); return; }
  epi(row, nt, h, acc, smem);
}
template <class EPI>
__device__ __forceinline__ void gemm_mfma_tile(int mt, int nt, char* smem, const bf16_t* __restrict__ A, int M,
                                               const bf16_t* __restrict__ Bt, int K, const EPI& epi) {
  gemm_mfma_tile_v<0, EPI>(mt, nt, smem, A, M, Bt, K, epi);
}


template <class EPI>
__device__ __forceinline__ void gemm_mfma_tile_n256(int mt, int nt2, char* smem, const bf16_t* __restrict__ A, int M,
                                                    const bf16_t* __restrict__ Bt, int K, const EPI& epi) {
  const int t = opaque_tid(), lane = t & 63, wave = t >> 6, r = lane & 31, h = lane >> 5;
  const int m0 = mt * 128, n0 = nt2 * 256;
  const bf16_t* gsrc[6];
  int ldst[6];
#pragma unroll
  for (int i = 0; i < 6; ++i) {
    const int q = wave * 6 + i;
    const int rowl = lane >> 2, pc = lane & 3;
    const bool isA = q < 8;
    const int row = 16 * (isA ? q : q - 8) + rowl;
    const int c = pc ^ ((row >> 2) & 3);
    int ar = m0 + row;
    ar = ar < M ? ar : M - 1;
    gsrc[i] = isA ? A + (size_t)ar * K + c * 8 : Bt + (size_t)(n0 + row) * K + c * 8;
    ldst[i] = q * 1024;
  }
  int roff[2];
#pragma unroll
  for (int ks = 0; ks < 2; ++ks) roff[ks] = r * 64 + (((2 * ks + h) ^ ((r >> 2) & 3)) << 4);
  f32x16 acc[8];
#pragma unroll
  for (int j = 0; j < 8; ++j)
#pragma unroll
    for (int e = 0; e < 16; ++e) acc[j][e] = 0.f;
  __syncthreads();
  const int nk = K >> 5;
#pragma unroll
  for (int i = 0; i < 6; ++i) __builtin_amdgcn_global_load_lds((const unsigned*)gsrc[i], (unsigned*)(smem + ldst[i]), 16, 0, 0);
#pragma unroll
  for (int i = 0; i < 6; ++i) __builtin_amdgcn_global_load_lds((const unsigned*)(gsrc[i] + 32), (unsigned*)(smem + 24576 + ldst[i]), 16, 0, 0);
  asm volatile("s_waitcnt vmcnt(6)" ::: "memory");
  asm volatile("s_waitcnt lgkmcnt(0)" ::: "memory");
  __builtin_amdgcn_s_barrier();
  int cs = 0;
  for (int kt = 0; kt < nk; ++kt) {
    char* cur = smem + cs * 24576;
    const int ns = cs >= 1 ? cs - 1 : 2;
    if (kt + 2 < nk) {
      char* nxt = smem + ns * 24576;
#pragma unroll
      for (int i = 0; i < 6; ++i) __builtin_amdgcn_global_load_lds((const unsigned*)(gsrc[i] + (kt + 2) * 32), (unsigned*)(nxt + ldst[i]), 16, 0, 0);
    }
    const char* sa = cur + wave * 2048;
    const char* sb = cur + 8192;
    bf16x8 af[2], bfr[2][8];
#pragma unroll
    for (int ks = 0; ks < 2; ++ks) {
      af[ks] = *(const bf16x8*)(sa + roff[ks]);
#pragma unroll
      for (int j = 0; j < 8; ++j) bfr[ks][j] = *(const bf16x8*)(sb + j * 2048 + roff[ks]);
    }
    asm volatile("" : "+v"(af[0]), "+v"(af[1]), "+v"(bfr[0][0]), "+v"(bfr[0][1]), "+v"(bfr[0][2]), "+v"(bfr[0][3]), "+v"(bfr[0][4]), "+v"(bfr[0][5]), "+v"(bfr[0][6]), "+v"(bfr[0][7]));
    asm volatile("" : "+v"(bfr[1][0]), "+v"(bfr[1][1]), "+v"(bfr[1][2]), "+v"(bfr[1][3]), "+v"(bfr[1][4]), "+v"(bfr[1][5]), "+v"(bfr[1][6]), "+v"(bfr[1][7]));
#pragma unroll
    for (int ks = 0; ks < 2; ++ks)
#pragma unroll
      for (int j = 0; j < 8; ++j) acc[j] = __builtin_amdgcn_mfma_f32_32x32x16_bf16(bfr[ks][j], af[ks], acc[j], 0, 0, 0);
    __builtin_amdgcn_sched_barrier(0);
    if (kt + 2 < nk) asm volatile("s_waitcnt vmcnt(6)" ::: "memory");
    else asm volatile("s_waitcnt vmcnt(0)" ::: "memory");
    asm volatile("s_waitcnt lgkmcnt(0)" ::: "memory");
    __builtin_amdgcn_s_barrier();
    cs = cs == 2 ? 0 : cs + 1;
  }
  const int row = m0 + wave * 32 + r;
  epi(row, 2 * nt2, h, *reinterpret_cast<f32x16(*)[4]>(&acc[0]), smem);
  epi(row, 2 * nt2 + 1, h, *reinterpret_cast<f32x16(*)[4]>(&acc[4]), smem);
}

struct EpiInProjM {
  bf16_t* P; float* out; const float2* rope;
  __device__ __forceinline__ void operator()(int row, int nt, int h, f32x16 (&acc)[4], char* smem) const {
    if (nt >= 6 && nt < 14) {
      const float sc = nt >= 10 ? 0.08838834764831845f : 1.0f;
      const float2* rp = rope + (size_t)row_pos(row) * 64;
#pragma unroll
      for (int j = 0; j < 2; ++j)
#pragma unroll
        for (int g = 0; g < 4; ++g)
#pragma unroll
          for (int i = 0; i < 4; ++i) {
            const float2 cs = rp[j * 32 + 8 * g + 4 * h + i];
            const float x1 = acc[j][4 * g + i], x2 = acc[j + 2][4 * g + i];
            acc[j][4 * g + i] = (x1 * cs.x - x2 * cs.y) * sc;
            acc[j + 2][4 * g + i] = (x1 * cs.y + x2 * cs.x) * sc;
          }
    }
    {
      const int lane = opaque_tid() & 63, wave = opaque_tid() >> 6, r = lane & 31;
      char* st = smem + wave * 8704;
#pragma unroll
      for (int j = 0; j < 4; ++j)
#pragma unroll
        for (int g = 0; g < 4; ++g) {
          uint2 w;
          w.x = pack_bf16(acc[j][4 * g], acc[j][4 * g + 1]);
          w.y = pack_bf16(acc[j][4 * g + 2], acc[j][4 * g + 3]);
          *(uint2*)(st + r * 272 + (j * 32 + 8 * g + 4 * h) * 2) = w;
        }
      const int rbase = row - r;
#pragma unroll
      for (int it = 0; it < 8; ++it) {
        const int rl = it * 4 + (lane >> 4), ch = lane & 15;
        const u32x4 v = *(const u32x4*)(st + rl * 272 + ch * 16);
        if (rbase + rl < NROWS) *(u32x4*)(P + (size_t)(rbase + rl) * PW + nt * 128 + ch * 8) = v;
      }
    }
    if (row >= NROWS) return;
    if (nt == 4 || nt == 5) {
      const bool isv = nt == 5;
#pragma unroll
      for (int j = 0; j < 4; ++j)
#pragma unroll
        for (int g = 0; g < 4; ++g) {
          const int col = j * 32 + 8 * g + 4 * h;
          const float4 val = make_float4(acc[j][4 * g], acc[j][4 * g + 1], acc[j][4 * g + 2], acc[j][4 * g + 3]);
          if (row < NPROMPT) {
            const int b = row >> 11, sidx = row & 2047;
            if (sidx >= SEQ - 128) *(float4*)(out + (isv ? O_SWAVP : O_SWAKP) + (size_t)(b * 128 + (sidx - (SEQ - 128))) * 128 + col) = val;
          } else if (row < NTOK) {
            *(float4*)(out + (isv ? O_SWAVS : O_SWAKS) + (size_t)(row - NPROMPT) * 128 + col) = val;
          } else {
            const int m = row - NTOK;
            for (int b = 0; b < NB; ++b) *(float4*)(out + (isv ? O_METAV : O_METAK) + (size_t)(b * 16 + m) * 128 + col) = val;
          }
        }
    }
  }
};

struct EpiOutProjM {
  const bf16_t* hbf; bf16_t* z;
  __device__ __forceinline__ void operator()(int row, int nt, int h, f32x16 (&acc)[4], char* smem) const {
    const int lane = opaque_tid() & 63, wave = opaque_tid() >> 6, r = lane & 31;
    char* st = smem + wave * 8704;
#pragma unroll
    for (int j = 0; j < 4; ++j)
#pragma unroll
      for (int g = 0; g < 4; ++g) {
        uint2 w;
        w.x = pack_bf16(acc[j][4 * g], acc[j][4 * g + 1]);
        w.y = pack_bf16(acc[j][4 * g + 2], acc[j][4 * g + 3]);
        *(uint2*)(st + r * 272 + (j * 32 + 8 * g + 4 * h) * 2) = w;
      }
    const int rbase = row - r;
#pragma unroll
    for (int it = 0; it < 8; ++it) {
      const int rl = it * 4 + (lane >> 4), ch = lane & 15;
      const u32x4 m = *(const u32x4*)(st + rl * 272 + ch * 16);
      const size_t off = (size_t)(rbase + rl) * D + nt * 128 + ch * 8;
      const u32x4 hv = *(const u32x4*)(hbf + off);
      u32x4 o;
#pragma unroll
      for (int q = 0; q < 4; ++q)
        o[q] = pack_bf16(ALPHA * __uint_as_float(hv[q] << 16) + __uint_as_float(m[q] << 16),
                         ALPHA * __uint_as_float(hv[q] & 0xffff0000u) + __uint_as_float(m[q] & 0xffff0000u));
      *(u32x4*)(z + off) = o;
    }
  }
};

struct EpiPlainF32M {
  float* C;
  __device__ __forceinline__ void operator()(int row, int nt, int h, f32x16 (&acc)[4], char* smem) const {
    const size_t base = (size_t)row * D + nt * 128 + 4 * h;
#pragma unroll
    for (int j = 0; j < 4; ++j)
#pragma unroll
      for (int g = 0; g < 4; ++g)
        *(float4*)(C + base + j * 32 + 8 * g) = make_float4(acc[j][4 * g], acc[j][4 * g + 1], acc[j][4 * g + 2], acc[j][4 * g + 3]);
  }
};


constexpr int NET16[63][2] = {{0,1}, {2,3}, {0,2}, {1,3}, {1,2}, {4,5}, {6,7}, {4,6}, {5,7}, {5,6}, {0,4}, {2,6}, {2,4}, {1,5}, {3,7}, {3,5}, {1,2}, {3,4}, {5,6}, {8,9}, {10,11}, {8,10}, {9,11}, {9,10}, {12,13}, {14,15}, {12,14}, {13,15}, {13,14}, {8,12}, {10,14}, {10,12}, {9,13}, {11,15}, {11,13}, {9,10}, {11,12}, {13,14}, {0,8}, {4,12}, {4,8}, {2,10}, {6,14}, {6,10}, {2,4}, {6,8}, {10,12}, {1,9}, {5,13}, {5,9}, {3,11}, {7,15}, {7,11}, {3,5}, {7,9}, {11,13}, {1,2}, {3,4}, {5,6}, {7,8}, {9,10}, {11,12}, {13,14}};
constexpr int CLEAN16[32][2] = {{0,8}, {1,9}, {2,10}, {3,11}, {4,12}, {5,13}, {6,14}, {7,15}, {0,4}, {1,5}, {2,6}, {3,7}, {8,12}, {9,13}, {10,14}, {11,15}, {0,2}, {1,3}, {4,6}, {5,7}, {8,10}, {9,11}, {12,14}, {13,15}, {0,1}, {2,3}, {4,5}, {6,7}, {8,9}, {10,11}, {12,13}, {14,15}};
constexpr int CAND_REST[34][2] = {{1,0}, {1,1}, {1,2}, {1,3}, {1,4}, {1,5}, {1,6}, {1,7}, {2,0}, {2,1}, {2,2}, {2,3}, {2,4}, {3,0}, {3,1}, {3,2}, {3,3}, {4,0}, {4,1}, {4,2}, {5,0}, {5,1}, {6,0}, {6,1}, {7,0}, {7,1}, {8,0}, {9,0}, {10,0}, {11,0}, {12,0}, {13,0}, {14,0}, {15,0}};
#define CE_DESC(a, b) { const int hi_ = max(a, b), lo_ = min(a, b); a = hi_; b = lo_; }
__device__ __forceinline__ void sort16_desc(int (&x)[16]) {
#pragma unroll
  for (int t = 0; t < 63; ++t) CE_DESC(x[NET16[t][0]], x[NET16[t][1]])
}
__device__ __forceinline__ void merge_top16(int (&a)[16], const int (&b)[16]) {
#pragma unroll
  for (int i = 0; i < 16; ++i) a[i] = max(a[i], b[15 - i]);
#pragma unroll
  for (int t = 0; t < 32; ++t) CE_DESC(a[CLEAN16[t][0]], a[CLEAN16[t][1]])
}
__device__ __forceinline__ int f2ord(float f) { const int b = __float_as_int(f); return b ^ ((b >> 31) & 0x7FFFFFFF); }
__device__ __forceinline__ float ord2f(int k) { return __int_as_float(k ^ ((k >> 31) & 0x7FFFFFFF)); }

struct EpiTopK {
  const bf16_t* subk;
  int* lidx; float* lgate;
  __device__ __forceinline__ void operator()(int row, int p, int h, f32x16 (&acc)[4], char* smem) const {
    const int lane = opaque_tid() & 63, wave = opaque_tid() >> 6, r = lane & 31;
    char* qw = smem + wave * 16384;
    int* sl = (int*)(smem + wave * 16384 + 8192);
#pragma unroll
    for (int j = 0; j < 4; ++j)
#pragma unroll
      for (int g = 0; g < 4; ++g) {
        uint2 w;
        w.x = pack_bf16(acc[j][4 * g], acc[j][4 * g + 1]);
        w.y = pack_bf16(acc[j][4 * g + 2], acc[j][4 * g + 3]);
        *(uint2*)(qw + r * 256 + (((4 * j + g) ^ (r & 15)) << 4) + 8 * h) = w;
      }
    int S[2][16];
#pragma unroll
    for (int c = 0; c < 2; ++c) {
      f32x16 sc[4];
#pragma unroll
      for (int mi = 0; mi < 4; ++mi)
#pragma unroll
        for (int e = 0; e < 16; ++e) sc[mi][e] = 0.f;
      const bf16_t* kb = subk + (size_t)((p * 2 + c) * 128 + r) * 64 + 8 * h;
#pragma unroll
      for (int ks = 0; ks < 4; ++ks) {
        const bf16x8 qf = *(const bf16x8*)(qw + r * 256 + (((8 * c + 2 * ks + h) ^ (r & 15)) << 4));
#pragma unroll
        for (int mi = 0; mi < 4; ++mi) {
          const bf16x8 kf = *(const bf16x8*)(kb + mi * 32 * 64 + ks * 16);
          sc[mi] = __builtin_amdgcn_mfma_f32_32x32x16_bf16(kf, qf, sc[mi], 0, 0, 0);
        }
      }
      int L[16];
#pragma unroll
      for (int mi = 0; mi < 4; ++mi) {
        int x[16];
#pragma unroll
        for (int e = 0; e < 16; ++e) x[e] = (f2ord(sc[mi][e]) & ~127) | (32 * mi + (e & 3) + 8 * (e >> 2) + 4 * h);
        sort16_desc(x);
        if (mi == 0) {
#pragma unroll
          for (int e = 0; e < 16; ++e) L[e] = x[e];
        } else merge_top16(L, x);
      }
      int Pn[16];
#pragma unroll
      for (int e = 0; e < 16; ++e) Pn[e] = __shfl_xor(L[e], 32);
      merge_top16(L, Pn);
#pragma unroll
      for (int e = 0; e < 16; ++e) { S[c][e] = L[e]; sl[(c * 16 + e) * 64 + lane] = L[e]; }
    }
    float f0[16], f1[16];
#pragma unroll
    for (int e = 0; e < 16; ++e) { f0[e] = ord2f(S[0][e]); f1[e] = ord2f(S[1][e]); }
    int T[16];
#pragma unroll
    for (int b = 0; b < 16; ++b) T[b] = (f2ord(f0[0] + f1[b]) & ~255) | (15 - b);
#pragma unroll
    for (int gi = 0; gi < 3; ++gi) {
      int x[16];
#pragma unroll
      for (int e = 0; e < 16; ++e) {
        const int ci = gi * 16 + e;
        if (ci < 34) x[e] = (f2ord(f0[CAND_REST[ci][0]] + f1[CAND_REST[ci][1]]) & ~255) | (CAND_REST[ci][0] << 4) | (15 - CAND_REST[ci][1]);
        else x[e] = (int)0x80000000;
      }
      sort16_desc(x);
      merge_top16(T, x);
    }
    float ev[16], den = 0.f;
    const float vmax = ord2f(T[0]);
#pragma unroll
    for (int k = 0; k < 16; ++k) { ev[k] = __expf(ord2f(T[k]) - vmax); den += ev[k]; }
    const float inv = 1.0f / den;
    int eo[16];
#pragma unroll
    for (int k = 0; k < 16; ++k) {
      const int ab = T[k] & 255;
      const int i1 = sl[(ab >> 4) * 64 + lane] & 127, i2 = sl[(16 + 15 - (ab & 15)) * 64 + lane] & 127;
      eo[k] = i1 * 128 + i2;
    }
    if (h == 0) {
      int* lp = lidx + (size_t)row * 128 + p * 16;
      float* gp = lgate + (size_t)row * 128 + p * 16;
#pragma unroll
      for (int q = 0; q < 4; ++q) {
        *(int4*)(lp + 4 * q) = make_int4(eo[4 * q], eo[4 * q + 1], eo[4 * q + 2], eo[4 * q + 3]);
        *(float4*)(gp + 4 * q) = make_float4(ev[4 * q] * inv, ev[4 * q + 1] * inv, ev[4 * q + 2] * inv, ev[4 * q + 3] * inv);
      }
    }
  }
};

__device__ __forceinline__ void transpose_tile(int kt, int ntile, char* smem, const float* __restrict__ W, int N, int K, bf16_t* __restrict__ Wt) {
  float (*T)[65] = (float (*)[65])smem;
  const int t = opaque_tid();
  __syncthreads();
#pragma unroll
  for (int pss = 0; pss < 4; ++pss) {
    const int kk = pss * 16 + (t >> 4), nn = (t & 15) * 4;
    const float4 v = *(const float4*)(W + (size_t)(kt * 64 + kk) * N + ntile * 64 + nn);
    T[kk][nn] = v.x; T[kk][nn + 1] = v.y; T[kk][nn + 2] = v.z; T[kk][nn + 3] = v.w;
  }
  __syncthreads();
#pragma unroll
  for (int pss = 0; pss < 4; ++pss) {
    const int nn = pss * 16 + (t >> 4), kk = (t & 15) * 4;
    uint2 w;
    w.x = pack_bf16(T[kk][nn], T[kk + 1][nn]);
    w.y = pack_bf16(T[kk + 2][nn], T[kk + 3][nn]);
    *(uint2*)(Wt + (size_t)(ntile * 64 + nn) * K + kt * 64 + kk) = w;
  }
}


__device__ __forceinline__ float wave_max(float v) {
  v = fmaxf(v, lane_xor_f<1>(v)); v = fmaxf(v, lane_xor_f<2>(v)); v = fmaxf(v, lane_xor_f<4>(v));
  v = fmaxf(v, lane_xor_f<8>(v)); v = fmaxf(v, lane_xor_f<16>(v)); v = fmaxf(v, lane_xor_f<32>(v));
  return v;
}

__device__ __forceinline__ float quant_row_regs(const float4 (&v)[4], int lane, uint8_t* __restrict__ dst, bool biased) {
  float m = 0.f;
#pragma unroll
  for (int i = 0; i < 4; ++i) m = fmaxf(m, fmaxf(fmaxf(fabsf(v[i].x), fabsf(v[i].y)), fmaxf(fabsf(v[i].z), fabsf(v[i].w))));
  m = wave_max(m);
  const float scale = m * (1.0f / 127.0f);
  const float inv = m > 0.f ? 127.0f / m : 0.f;
  u32x4 w;
#pragma unroll
  for (int i = 0; i < 4; ++i) {
    int a = (int)rintf(v[i].x * inv), b = (int)rintf(v[i].y * inv), c = (int)rintf(v[i].z * inv), d = (int)rintf(v[i].w * inv);
    if (biased) { a += 128; b += 128; c += 128; d += 128; }
    w[i] = (uint32_t)(a & 255) | ((uint32_t)(b & 255) << 8) | ((uint32_t)(c & 255) << 16) | ((uint32_t)(d & 255) << 24);
  }
  *(u32x4*)(dst + lane * 16) = w;
  return scale;
}

__device__ __forceinline__ void quant_table_row(const float* __restrict__ src, int lane, uint8_t* __restrict__ dst, float* __restrict__ sc, bool biased) {
  float4 v[4];
#pragma unroll
  for (int i = 0; i < 4; ++i) v[i] = *(const float4*)(src + 256 * i + 4 * lane);
  const float scale = quant_row_regs(v, lane, dst, biased);
  if (lane == 0) *sc = scale;
}


template <int NR>
__device__ __forceinline__ void ln_in_rows(const int (&rows)[NR], int lane, const float* __restrict__ xp, const float* __restrict__ xs,
                                           const float* __restrict__ meta, const float* __restrict__ g, const float* __restrict__ b,
                                           bf16_t* __restrict__ hbf) {
  float4 v[NR][4];
#pragma unroll
  for (int n = 0; n < NR; ++n) {
    const int r = rows[n];
    const float* src = r < NPROMPT ? xp + (size_t)r * D : (r < NTOK ? xs + (size_t)(r - NPROMPT) * D : meta + (size_t)(r - NTOK) * D);
#pragma unroll
    for (int i = 0; i < 4; ++i) v[n][i] = *(const float4*)(src + 256 * i + 4 * lane);
  }
  float4 gg[4], bb[4];
#pragma unroll
  for (int i = 0; i < 4; ++i) { gg[i] = *(const float4*)(g + 256 * i + 4 * lane); bb[i] = *(const float4*)(b + 256 * i + 4 * lane); }
#pragma unroll
  for (int n = 0; n < NR; ++n) {
    float sum = 0.f;
#pragma unroll
    for (int i = 0; i < 4; ++i) sum += (v[n][i].x + v[n][i].y) + (v[n][i].z + v[n][i].w);
    const float mean = wave_sum(sum) * (1.0f / D);
    float sq = 0.f;
#pragma unroll
    for (int i = 0; i < 4; ++i) { v[n][i].x -= mean; v[n][i].y -= mean; v[n][i].z -= mean; v[n][i].w -= mean; sq += (v[n][i].x * v[n][i].x + v[n][i].y * v[n][i].y) + (v[n][i].z * v[n][i].z + v[n][i].w * v[n][i].w); }
    const float rstd = rsqrtf(wave_sum(sq) * (1.0f / D) + LN_EPS);
#pragma unroll
    for (int i = 0; i < 4; ++i) {
      uint2 w;
      w.x = pack_bf16(v[n][i].x * rstd * gg[i].x + bb[i].x, v[n][i].y * rstd * gg[i].y + bb[i].y);
      w.y = pack_bf16(v[n][i].z * rstd * gg[i].z + bb[i].z, v[n][i].w * rstd * gg[i].w + bb[i].w);
      *(uint2*)(hbf + (size_t)rows[n] * D + 256 * i + 4 * lane) = w;
    }
  }
}
template <int NR>
__device__ __forceinline__ void ln1_rows(const int (&rows)[NR], int lane, const bf16_t* __restrict__ z, const float* __restrict__ g,
                                         const float* __restrict__ b, bf16_t* __restrict__ h1bf, uint8_t* __restrict__ xq, float* __restrict__ xs) {
  uint2 zz[NR][4];
#pragma unroll
  for (int n = 0; n < NR; ++n)
#pragma unroll
    for (int i = 0; i < 4; ++i) zz[n][i] = *(const uint2*)(z + (size_t)rows[n] * D + 256 * i + 4 * lane);
  float4 gg[4], bb[4];
#pragma unroll
  for (int i = 0; i < 4; ++i) { gg[i] = *(const float4*)(g + 256 * i + 4 * lane); bb[i] = *(const float4*)(b + 256 * i + 4 * lane); }
#pragma unroll
  for (int n = 0; n < NR; ++n) {
    float4 v[4];
    float sum = 0.f;
#pragma unroll
    for (int i = 0; i < 4; ++i) {
      v[i].x = __uint_as_float(zz[n][i].x << 16); v[i].y = __uint_as_float(zz[n][i].x & 0xffff0000u);
      v[i].z = __uint_as_float(zz[n][i].y << 16); v[i].w = __uint_as_float(zz[n][i].y & 0xffff0000u);
      sum += (v[i].x + v[i].y) + (v[i].z + v[i].w);
    }
    const float mean = wave_sum(sum) * (1.0f / D);
    float sq = 0.f;
#pragma unroll
    for (int i = 0; i < 4; ++i) { v[i].x -= mean; v[i].y -= mean; v[i].z -= mean; v[i].w -= mean; sq += (v[i].x * v[i].x + v[i].y * v[i].y) + (v[i].z * v[i].z + v[i].w * v[i].w); }
    const float rstd = rsqrtf(wave_sum(sq) * (1.0f / D) + LN_EPS);
#pragma unroll
    for (int i = 0; i < 4; ++i) {
      v[i].x = v[i].x * rstd * gg[i].x + bb[i].x; v[i].y = v[i].y * rstd * gg[i].y + bb[i].y; v[i].z = v[i].z * rstd * gg[i].z + bb[i].z; v[i].w = v[i].w * rstd * gg[i].w + bb[i].w;
      uint2 w;
      w.x = pack_bf16(v[i].x, v[i].y); w.y = pack_bf16(v[i].z, v[i].w);
      *(uint2*)(h1bf + (size_t)rows[n] * D + 256 * i + 4 * lane) = w;
    }
    const float scale = quant_row_regs(v, lane, xq + (size_t)rows[n] * 1024, false);
    if (lane == 0) xs[rows[n]] = scale;
  }
}

struct SweepArgs {
  const int* lidx; const float* lgate; const uint8_t* U8; const uint8_t* V8; const float* su; const float* sv;
  const uint8_t* xq; const float* xs; const bf16_t* h1; const float* g2; const float* b2; float* y;
};

#ifndef SG_CACHE
#define SG_CACHE ""
#endif
#define SG_KMAX 256
#define SG_K0 192
#define SG_LDS_PER_WAVE (4 * SG_KMAX * 16)
static_assert(SG_KMAX % 16 == 0 && 4 * SG_LDS_PER_WAVE <= 73728, "schedule ring: bubble init covers 16 slots per pass; 4 waves must fit the LDS buffer");

template <int CTRL> __device__ __forceinline__ int dpp_mov_i(int x) { return __builtin_amdgcn_mov_dpp(x, CTRL, 0xF, 0xF, true); }
__device__ __forceinline__ int row_sum_i(int v) {
  v += dpp_mov_i<0x128>(v); v += dpp_mov_i<0x124>(v); v += dpp_mov_i<0x122>(v); v += dpp_mov_i<0x121>(v);
  return v;
}
__device__ __forceinline__ float row_sum_f(float v) {
  v += __int_as_float(dpp_mov_i<0x128>(__float_as_int(v))); v += __int_as_float(dpp_mov_i<0x124>(__float_as_int(v)));
  v += __int_as_float(dpp_mov_i<0x122>(__float_as_int(v))); v += __int_as_float(dpp_mov_i<0x121>(__float_as_int(v)));
  return v;
}
__device__ __forceinline__ int row_xor_i(int x, int m) {
  return m == 1 ? lane_xor_i<1>(x) : (m == 2 ? lane_xor_i<2>(x) : (m == 4 ? lane_xor_i<4>(x) : lane_xor_i<8>(x)));
}

typedef _Float16 h16x2 __attribute__((ext_vector_type(2)));
template <int KP> __device__ __forceinline__ h16x2 ub_pair_f16(uint32_t d) {
  const uint32_t bits = __builtin_amdgcn_perm(0x64646464u, d, (4u << 24) | ((unsigned)(2 * KP + 1) << 16) | (4u << 8) | (unsigned)(2 * KP));
  h16x2 r;
  __builtin_memcpy(&r, &bits, 4);
  return r;
}
__device__ __forceinline__ float sg_fmix_lo(float acc, float w, uint32_t p) { asm("v_fma_mix_f32 %0, %1, %2, %0 op_sel:[0,0,0] op_sel_hi:[0,1,0]" : "+v"(acc) : "v"(w), "v"(p)); return acc; }
__device__ __forceinline__ float sg_fmix_hi(float acc, float w, uint32_t p) { asm("v_fma_mix_f32 %0, %1, %2, %0 op_sel:[0,1,0] op_sel_hi:[0,1,0]" : "+v"(acc) : "v"(w), "v"(p)); return acc; }
template <int KP> __device__ __forceinline__ uint32_t ub_pair_bits(uint32_t d) {
  return __builtin_amdgcn_perm(0x64646464u, d, (4u << 24) | ((unsigned)(2 * KP + 1) << 16) | (4u << 8) | (unsigned)(2 * KP));
}
struct SgBuf { u32x4 u[4]; u32x4 v[4]; };

template <int OFF> __device__ __forceinline__ void asm_bload(u32x4& dst, int voff, const u32x4& rs) {
  asm volatile("buffer_load_dwordx4 %0, %1, %2, 0 offen offset:%3 " SG_CACHE : "+v"(dst) : "v"(voff), "s"(rs), "n"(OFF));
}
__device__ __forceinline__ void sg_issue(const u32x4& ent, int c16, const u32x4& rsU, const u32x4& rsV, SgBuf& b) {
  const int off = (int)ent[0] * 2048 + c16;
  asm_bload<0>(b.u[0], off, rsU); asm_bload<256>(b.u[1], off, rsU); asm_bload<512>(b.u[2], off, rsU); asm_bload<768>(b.u[3], off, rsU);
  asm_bload<0>(b.v[0], off, rsV); asm_bload<256>(b.v[1], off, rsV); asm_bload<512>(b.v[2], off, rsV); asm_bload<768>(b.v[3], off, rsV);
}

template <int VAR>
__device__ __forceinline__ void sg_half(u32x4& ent, const u32x4& entN, SgBuf& b, const u32x4 (&x)[4], f32x16 (&acc)[4], float& corr,
                                        int c16, const u32x4& rsU, const u32x4& rsV) {
  if (VAR != 2) asm volatile("s_waitcnt vmcnt(12)" : "+v"(b.u[0]), "+v"(b.u[1]), "+v"(b.u[2]), "+v"(b.u[3]));
  int d0 = 0, d1 = 0, d2 = 0, d3 = 0;
#pragma unroll
  for (int q = 0; q < 4; ++q) {
    d0 = __builtin_amdgcn_sdot4((int)b.u[0][q], (int)x[0][q], d0, false);
    d1 = __builtin_amdgcn_sdot4((int)b.u[1][q], (int)x[1][q], d1, false);
    d2 = __builtin_amdgcn_sdot4((int)b.u[2][q], (int)x[2][q], d2, false);
    d3 = __builtin_amdgcn_sdot4((int)b.u[3][q], (int)x[3][q], d3, false);
  }
  int dd = (d0 + d1) + (d2 + d3);
  asm volatile("" : "+v"(dd));
  const int offN = (int)entN[0] * 2048 + c16;
  if (VAR != 2) { asm_bload<0>(b.u[0], offN, rsU); asm_bload<256>(b.u[1], offN, rsU); asm_bload<512>(b.u[2], offN, rsU); asm_bload<768>(b.u[3], offN, rsU); }
  else asm volatile("" : "+v"(b.u[0]), "+v"(b.u[1]), "+v"(b.u[2]), "+v"(b.u[3]) : "v"(offN));
  dd = row_sum_i(dd);
  const float pre = (float)dd * __uint_as_float(ent[1]);
  const float uu = 1.5957691216057308f * (pre + 0.044715f * pre * pre * pre);
  const float act = pre * __builtin_amdgcn_rcpf(1.0f + __expf(-uu));
  const float w = act * __uint_as_float(ent[2]);
#define SG_VPIECE(I, OFFB)                                                                   \
  {                                                                                          \
    if (VAR != 2) asm volatile("s_waitcnt vmcnt(15)" : "+v"(b.v[I]));                        \
    if (VAR != 1) _Pragma("unroll") for (int q = 0; q < 4; ++q) {                            \
      const uint32_t d = b.v[I][q];                                                          \
      const uint32_t p0 = ub_pair_bits<0>(d), p1 = ub_pair_bits<1>(d);                       \
      acc[I][4 * q + 0] = sg_fmix_lo(acc[I][4 * q + 0], w, p0);                              \
      acc[I][4 * q + 1] = sg_fmix_hi(acc[I][4 * q + 1], w, p0);                              \
      acc[I][4 * q + 2] = sg_fmix_lo(acc[I][4 * q + 2], w, p1);                              \
      acc[I][4 * q + 3] = sg_fmix_hi(acc[I][4 * q + 3], w, p1);                              \
    }                                                                                        \
    asm volatile("" : "+v"(acc[I]));                                                         \
    if (VAR != 2) asm_bload<OFFB>(b.v[I], offN, rsV);                                        \
    else asm volatile("" : "+v"(b.v[I]));                                                    \
  }
  SG_VPIECE(0, 0) SG_VPIECE(1, 256) SG_VPIECE(2, 512) SG_VPIECE(3, 768)
#undef SG_VPIECE
  corr += w;
  asm volatile("" : "+v"(corr));
  ent = entN;
}

template <bool NOSTORE>
__device__ __forceinline__ void sweep_groups(int tokbase, int lane, char* lds, const SweepArgs& a, int rot = 0, unsigned long long t0 = 0ull, int dticks = 0) {
#if defined(PROBE_CUT) && PROBE_CUT == 0
  if (NOSTORE) return;
#endif
  const int g = lane >> 4, c = lane & 15, c16 = c * 16;
  const int tok = tokbase + g;
  u32x4* sched = (u32x4*)lds + g * SG_KMAX;
  int K[8];
  {
    const int4 e0 = *(const int4*)(a.lidx + (size_t)tok * 128 + c * 8), e1 = *(const int4*)(a.lidx + (size_t)tok * 128 + c * 8 + 4);
    K[0] = (((e0.x - rot) & 16383) << 7) | (c * 8 + 0); K[1] = (((e0.y - rot) & 16383) << 7) | (c * 8 + 1);
    K[2] = (((e0.z - rot) & 16383) << 7) | (c * 8 + 2); K[3] = (((e0.w - rot) & 16383) << 7) | (c * 8 + 3);
    K[4] = (((e1.x - rot) & 16383) << 7) | (c * 8 + 4); K[5] = (((e1.y - rot) & 16383) << 7) | (c * 8 + 5);
    K[6] = (((e1.z - rot) & 16383) << 7) | (c * 8 + 6); K[7] = (((e1.w - rot) & 16383) << 7) | (c * 8 + 7);
  }
#pragma unroll
  for (int k = 2; k <= 128; k <<= 1) {
#pragma unroll
    for (int j = k >> 1; j > 0; j >>= 1) {
      if (j >= 8) {
        const int lj = j >> 3;
        const bool upper = (c & lj) != 0;
        const bool desc = (k < 128) && ((c & (k >> 3)) != 0);
        const bool keepmax = upper != desc;
#pragma unroll
        for (int r = 0; r < 8; ++r) {
          const int o = row_xor_i(K[r], lj);
          const int mn = min(K[r], o), mx = max(K[r], o);
          K[r] = keepmax ? mx : mn;
        }
      } else {
#pragma unroll
        for (int r = 0; r < 8; ++r) {
          if ((r & j) == 0) {
            const int pp = r | j;
            const int mn = min(K[r], K[pp]), mx = max(K[r], K[pp]);
            if (k >= 8) {
              const bool desc = (k < 128) && ((c & (k >> 3)) != 0);
              K[r] = desc ? mx : mn; K[pp] = desc ? mn : mx;
            } else {
              const bool desc = (r & k) != 0;
              K[r] = desc ? mx : mn; K[pp] = desc ? mn : mx;
            }
          }
        }
      }
    }
  }
#if defined(PROBE_CUT) && PROBE_CUT == 1
  if (NOSTORE) { asm volatile("" :: "v"(K[0]), "v"(K[1]), "v"(K[2]), "v"(K[3]), "v"(K[4]), "v"(K[5]), "v"(K[6]), "v"(K[7])); return; }
#endif
  int tt[8];
  {
    int av[8], fw[8], bw[8];
    int run = -100000;
#pragma unroll
    for (int r = 0; r < 8; ++r) {
      av[r] = (((K[r] >> 7) * SG_K0) >> 14) - (c * 8 + r);
      run = max(run, av[r]);
      fw[r] = run;
    }
    int sc = run;
    sc = max(sc, __builtin_amdgcn_update_dpp(-100000, sc, 0x111, 0xF, 0xF, false));
    sc = max(sc, __builtin_amdgcn_update_dpp(-100000, sc, 0x112, 0xF, 0xF, false));
    sc = max(sc, __builtin_amdgcn_update_dpp(-100000, sc, 0x114, 0xF, 0xF, false));
    sc = max(sc, __builtin_amdgcn_update_dpp(-100000, sc, 0x118, 0xF, 0xF, false));
    const int exclF = __builtin_amdgcn_update_dpp(-100000, sc, 0x111, 0xF, 0xF, false);
    int rmin = 100000;
#pragma unroll
    for (int r = 7; r >= 0; --r) { rmin = min(rmin, av[r]); bw[r] = rmin; }
    int sb = rmin;
    sb = min(sb, __builtin_amdgcn_update_dpp(100000, sb, 0x101, 0xF, 0xF, false));
    sb = min(sb, __builtin_amdgcn_update_dpp(100000, sb, 0x102, 0xF, 0xF, false));
    sb = min(sb, __builtin_amdgcn_update_dpp(100000, sb, 0x104, 0xF, 0xF, false));
    sb = min(sb, __builtin_amdgcn_update_dpp(100000, sb, 0x108, 0xF, 0xF, false));
    const int exclB = __builtin_amdgcn_update_dpp(100000, sb, 0x101, 0xF, 0xF, false);
#pragma unroll
    for (int r = 0; r < 8; ++r) tt[r] = c * 8 + r + ((max(fw[r], exclF) + min(bw[r], exclB)) >> 1);
    const int t0g = __builtin_amdgcn_readlane(tt[0], 0), t1g = __builtin_amdgcn_readlane(tt[0], 16), t2g = __builtin_amdgcn_readlane(tt[0], 32), t3g = __builtin_amdgcn_readlane(tt[0], 48);
    const int tg = g == 0 ? t0g : (g == 1 ? t1g : (g == 2 ? t2g : t3g));
    const int sh = tg < 0 ? -tg : 0;
#pragma unroll
    for (int r = 0; r < 8; ++r) tt[r] += sh;
  }
  int Kw = max(max(__builtin_amdgcn_readlane(tt[7], 15), __builtin_amdgcn_readlane(tt[7], 31)),
               max(__builtin_amdgcn_readlane(tt[7], 47), __builtin_amdgcn_readlane(tt[7], 63))) + 1;
  if (Kw > SG_KMAX) {
#pragma unroll
    for (int r = 0; r < 8; ++r) tt[r] = c * 8 + r;
    Kw = 128;
  }
  Kw = (Kw + 1) & ~1;
  {
#pragma unroll
    for (int q = 0; q < SG_KMAX / 16; ++q) {
      const int t = c + 16 * q;
      u32x4 bub; bub[0] = 0u; bub[1] = 0; bub[2] = 0; bub[3] = 0;
      sched[t] = bub;
    }
    const float xsc = a.xs[tok];
#pragma unroll
    for (int r = 0; r < 8; ++r) {
      const int e = ((K[r] >> 7) + rot) & 16383, jp = K[r] & 127;
      u32x4 ent;
#ifdef PROBE_EMASK
      ent[0] = NOSTORE ? ((uint32_t)e & PROBE_EMASK) : (uint32_t)e;
#else
      ent[0] = (uint32_t)e;
#endif
      ent[1] = __float_as_uint(a.su[e] * xsc);
      ent[2] = __float_as_uint(a.lgate[(size_t)tok * 128 + jp] * a.sv[e]);
      ent[3] = 0;
      sched[tt[r]] = ent;
    }
  }
#if defined(PROBE_CUT) && PROBE_CUT == 2
  if (NOSTORE) return;
#endif
  u32x4 x[4];
#pragma unroll
  for (int i = 0; i < 4; ++i) x[i] = *(const u32x4*)(a.xq + (size_t)tok * 1024 + 256 * i + c16);
  f32x16 acc[4];
#pragma unroll
  for (int i = 0; i < 4; ++i)
#pragma unroll
    for (int e = 0; e < 16; ++e) acc[i][e] = 0.f;
  float corr = 0.f;
  u32x4 rsU, rsV;
  {
    const uint64_t pu = (uint64_t)a.U8, pv = (uint64_t)a.V8;
    rsU[0] = (uint32_t)__builtin_amdgcn_readfirstlane((int)(uint32_t)pu); rsU[1] = (uint32_t)__builtin_amdgcn_readfirstlane((int)(uint32_t)(pu >> 32)) & 0xffffu;
    rsU[2] = 16384u * 2048u; rsU[3] = 0x00020000u;
    rsV[0] = (uint32_t)__builtin_amdgcn_readfirstlane((int)(uint32_t)pv); rsV[1] = (uint32_t)__builtin_amdgcn_readfirstlane((int)(uint32_t)(pv >> 32)) & 0xffffu;
    rsV[2] = 16384u * 2048u - 1024u; rsV[3] = 0x00020000u;
  }
  SgBuf bA, bB;
#pragma unroll
  for (int i = 0; i < 4; ++i) { bA.u[i] = make_u32x4_zero(); bA.v[i] = make_u32x4_zero(); bB.u[i] = make_u32x4_zero(); bB.v[i] = make_u32x4_zero(); }
  asm volatile("s_waitcnt vmcnt(0)" ::: "memory");
  u32x4 entA = sched[0], entB = sched[1];
  sg_issue(entA, c16, rsU, rsV, bA);
  sg_issue(entB, c16, rsU, rsV, bB);
#ifdef PROBE_SG_NOLOOP
  if (NOSTORE) Kw = 0;
#endif
#ifdef PROBE_LOOPVAR
  constexpr int LV = NOSTORE ? PROBE_LOOPVAR : 0;
#else
  constexpr int LV = 0;
#endif
  for (int k = 0; k < Kw; k += 2) {
    if (dticks > 0 && (k & 15) == 0) {
      const unsigned long long target = t0 + (unsigned long long)(k * dticks);
      while (__builtin_amdgcn_s_memrealtime() < target) __builtin_amdgcn_s_sleep(2);
    }
    const u32x4 nA = sched[(k + 2 < Kw) ? k + 2 : 0];
    const u32x4 nB = sched[(k + 3 < Kw) ? k + 3 : 0];
    sg_half<LV>(entA, nA, bA, x, acc, corr, c16, rsU, rsV);
    __builtin_amdgcn_sched_barrier(0);
    sg_half<LV>(entB, nB, bB, x, acc, corr, c16, rsU, rsV);
    __builtin_amdgcn_sched_barrier(0);
  }
  asm volatile("s_waitcnt vmcnt(0)" : "+v"(bA.u[0]), "+v"(bA.u[1]), "+v"(bA.u[2]), "+v"(bA.u[3]), "+v"(bA.v[0]), "+v"(bA.v[1]), "+v"(bA.v[2]), "+v"(bA.v[3]));
  asm volatile("" : "+v"(bB.u[0]), "+v"(bB.u[1]), "+v"(bB.u[2]), "+v"(bB.u[3]), "+v"(bB.v[0]), "+v"(bB.v[1]), "+v"(bB.v[2]), "+v"(bB.v[3]));
#if defined(PROBE_CUT) && PROBE_CUT == 3
  if (NOSTORE) { asm volatile("" :: "v"(acc[0]), "v"(acc[1]), "v"(acc[2]), "v"(acc[3]), "v"(corr)); return; }
#endif
  const float c128 = 1152.0f * corr;
  float sum = 0.f;
#pragma unroll
  for (int i = 0; i < 4; ++i)
#pragma unroll
    for (int q = 0; q < 4; ++q) {
      const uint2 hb = *(const uint2*)(a.h1 + (size_t)tok * D + 256 * q + 4 * (16 * i + c));
      const float4 hh = make_float4(__uint_as_float(hb.x << 16), __uint_as_float(hb.x & 0xffff0000u), __uint_as_float(hb.y << 16), __uint_as_float(hb.y & 0xffff0000u));
      acc[i][4 * q + 0] = ALPHA * hh.x + (acc[i][4 * q + 0] - c128);
      acc[i][4 * q + 1] = ALPHA * hh.y + (acc[i][4 * q + 1] - c128);
      acc[i][4 * q + 2] = ALPHA * hh.z + (acc[i][4 * q + 2] - c128);
      acc[i][4 * q + 3] = ALPHA * hh.w + (acc[i][4 * q + 3] - c128);
      sum += (acc[i][4 * q + 0] + acc[i][4 * q + 1]) + (acc[i][4 * q + 2] + acc[i][4 * q + 3]);
    }
  const float mean = row_sum_f(sum) * (1.0f / D);
  float sq = 0.f;
#pragma unroll
  for (int i = 0; i < 4; ++i)
#pragma unroll
    for (int e = 0; e < 16; ++e) { acc[i][e] -= mean; sq += acc[i][e] * acc[i][e]; }
  const float rstd = rsqrtf(row_sum_f(sq) * (1.0f / D) + LN_EPS);
#pragma unroll
  for (int i = 0; i < 4; ++i)
#pragma unroll
    for (int q = 0; q < 4; ++q) {
      const int col = 256 * q + 4 * (16 * i + c);
      const float4 gg = *(const float4*)(a.g2 + col), bb = *(const float4*)(a.b2 + col);
      float4 o;
      o.x = acc[i][4 * q + 0] * rstd * gg.x + bb.x;
      o.y = acc[i][4 * q + 1] * rstd * gg.y + bb.y;
      o.z = acc[i][4 * q + 2] * rstd * gg.z + bb.z;
      o.w = acc[i][4 * q + 3] * rstd * gg.w + bb.w;
      if (!NOSTORE) *(float4*)(a.y + (size_t)tok * D + col) = o;
      else asm volatile("" :: "v"(o.x), "v"(o.y), "v"(o.z), "v"(o.w));
    }
}


__device__ __forceinline__ void sweep_mini(int tok, int lane, int wave, char* smem, const SweepArgs& a) {
  const int g = lane >> 4, c = lane & 15, c16 = c * 16, gi = wave * 4 + g;
  u32x4* sched = (u32x4*)(smem + wave * SG_LDS_PER_WAVE) + g * SG_KMAX;
  __syncthreads();
  if (c < 8) {
    const int jp = gi * 8 + c;
    const int e = a.lidx[(size_t)tok * 128 + jp];
    u32x4 ent;
    ent[0] = (uint32_t)e;
    ent[1] = __float_as_uint(a.su[e] * a.xs[tok]);
    ent[2] = __float_as_uint(a.lgate[(size_t)tok * 128 + jp] * a.sv[e]);
    ent[3] = 0;
    sched[c] = ent;
  }
  u32x4 x[4];
#pragma unroll
  for (int i = 0; i < 4; ++i) x[i] = *(const u32x4*)(a.xq + (size_t)tok * 1024 + 256 * i + c16);
  f32x16 acc[4];
#pragma unroll
  for (int i = 0; i < 4; ++i)
#pragma unroll
    for (int e = 0; e < 16; ++e) acc[i][e] = 0.f;
  float corr = 0.f;
  u32x4 rsU, rsV;
  {
    const uint64_t pu = (uint64_t)a.U8, pv = (uint64_t)a.V8;
    rsU[0] = (uint32_t)__builtin_amdgcn_readfirstlane((int)(uint32_t)pu); rsU[1] = (uint32_t)__builtin_amdgcn_readfirstlane((int)(uint32_t)(pu >> 32)) & 0xffffu;
    rsU[2] = 16384u * 2048u; rsU[3] = 0x00020000u;
    rsV[0] = (uint32_t)__builtin_amdgcn_readfirstlane((int)(uint32_t)pv); rsV[1] = (uint32_t)__builtin_amdgcn_readfirstlane((int)(uint32_t)(pv >> 32)) & 0xffffu;
    rsV[2] = 16384u * 2048u - 1024u; rsV[3] = 0x00020000u;
  }
  SgBuf bA, bB;
#pragma unroll
  for (int i = 0; i < 4; ++i) { bA.u[i] = make_u32x4_zero(); bA.v[i] = make_u32x4_zero(); bB.u[i] = make_u32x4_zero(); bB.v[i] = make_u32x4_zero(); }
  asm volatile("s_waitcnt vmcnt(0)" ::: "memory");
  u32x4 entA = sched[0], entB = sched[1];
  sg_issue(entA, c16, rsU, rsV, bA);
  sg_issue(entB, c16, rsU, rsV, bB);
#pragma unroll 1
  for (int k = 0; k < 8; k += 2) {
    const u32x4 nA = sched[(k + 2 < 8) ? k + 2 : 0];
    const u32x4 nB = sched[(k + 3 < 8) ? k + 3 : 0];
    sg_half<0>(entA, nA, bA, x, acc, corr, c16, rsU, rsV);
    __builtin_amdgcn_sched_barrier(0);
    sg_half<0>(entB, nB, bB, x, acc, corr, c16, rsU, rsV);
    __builtin_amdgcn_sched_barrier(0);
  }
  asm volatile("s_waitcnt vmcnt(0)" : "+v"(bA.u[0]), "+v"(bA.u[1]), "+v"(bA.u[2]), "+v"(bA.u[3]), "+v"(bA.v[0]), "+v"(bA.v[1]), "+v"(bA.v[2]), "+v"(bA.v[3]));
  asm volatile("" : "+v"(bB.u[0]), "+v"(bB.u[1]), "+v"(bB.u[2]), "+v"(bB.u[3]), "+v"(bB.v[0]), "+v"(bB.v[1]), "+v"(bB.v[2]), "+v"(bB.v[3]));
#pragma unroll
  for (int i = 0; i < 4; ++i)
#pragma unroll
    for (int e = 0; e < 16; ++e) { float v = acc[i][e]; v += lane_xor_f<16>(v); v += lane_xor_f<32>(v); acc[i][e] = v; }
  corr += lane_xor_f<16>(corr); corr += lane_xor_f<32>(corr);
  __syncthreads();
  float* part = (float*)smem;
  if (lane < 16) {
#pragma unroll
    for (int i = 0; i < 4; ++i)
#pragma unroll
      for (int e = 0; e < 16; ++e) part[(wave * 16 + c) * 65 + 16 * i + e] = acc[i][e];
    part[(wave * 16 + c) * 65 + 64] = corr;
  }
  __syncthreads();
  if (wave == 0) {
#pragma unroll
    for (int w2 = 1; w2 < 4; ++w2) {
#pragma unroll
      for (int i = 0; i < 4; ++i)
#pragma unroll
        for (int e = 0; e < 16; ++e) acc[i][e] += part[(w2 * 16 + c) * 65 + 16 * i + e];
      corr += part[(w2 * 16 + c) * 65 + 64];
    }
    const float c128 = 1152.0f * corr;
    float sum = 0.f;
#pragma unroll
    for (int i = 0; i < 4; ++i)
#pragma unroll
      for (int q = 0; q < 4; ++q) {
        const uint2 hb = *(const uint2*)(a.h1 + (size_t)tok * D + 256 * q + 4 * (16 * i + c));
        const float4 hh = make_float4(__uint_as_float(hb.x << 16), __uint_as_float(hb.x & 0xffff0000u), __uint_as_float(hb.y << 16), __uint_as_float(hb.y & 0xffff0000u));
        acc[i][4 * q + 0] = ALPHA * hh.x + (acc[i][4 * q + 0] - c128);
        acc[i][4 * q + 1] = ALPHA * hh.y + (acc[i][4 * q + 1] - c128);
        acc[i][4 * q + 2] = ALPHA * hh.z + (acc[i][4 * q + 2] - c128);
        acc[i][4 * q + 3] = ALPHA * hh.w + (acc[i][4 * q + 3] - c128);
        sum += (acc[i][4 * q + 0] + acc[i][4 * q + 1]) + (acc[i][4 * q + 2] + acc[i][4 * q + 3]);
      }
    const float mean = row_sum_f(sum) * (1.0f / D);
    float sq = 0.f;
#pragma unroll
    for (int i = 0; i < 4; ++i)
#pragma unroll
      for (int e = 0; e < 16; ++e) { acc[i][e] -= mean; sq += acc[i][e] * acc[i][e]; }
    const float rstd = rsqrtf(row_sum_f(sq) * (1.0f / D) + LN_EPS);
    if (lane < 16) {
#pragma unroll
      for (int i = 0; i < 4; ++i)
#pragma unroll
        for (int q = 0; q < 4; ++q) {
          const int col = 256 * q + 4 * (16 * i + c);
          const float4 gg = *(const float4*)(a.g2 + col), bb = *(const float4*)(a.b2 + col);
          float4 o;
          o.x = acc[i][4 * q + 0] * rstd * gg.x + bb.x;
          o.y = acc[i][4 * q + 1] * rstd * gg.y + bb.y;
          o.z = acc[i][4 * q + 2] * rstd * gg.z + bb.z;
          o.w = acc[i][4 * q + 3] * rstd * gg.w + bb.w;
          *(float4*)(a.y + (size_t)tok * D + col) = o;
        }
    }
  }
}

__device__ __forceinline__ int unit_row0(int u) { return u < 256 ? (u >> 5) * SEQ + (u & 31) * 64 : NPROMPT + (u - 256) * 64; }

__device__ __forceinline__ void stage_T(char* dst, const bf16_t* __restrict__ src, const float* dec) {
  const int t = opaque_tid(), lane = t & 63, wave = t >> 6, tp = lane & 31;
#pragma unroll
  for (int item = 0; item < 2; ++item) {
    const int fc = (lane >> 5) + 2 * wave + 8 * item;
    const u32x4 a = *(const u32x4*)(src + (size_t)(2 * tp) * PW + fc * 8);
    const u32x4 b = *(const u32x4*)(src + (size_t)(2 * tp + 1) * PW + fc * 8);
    float d0 = 1.f, d1 = 1.f;
    if (dec) { d0 = dec[2 * tp]; d1 = dec[2 * tp + 1]; }
#pragma unroll
    for (int q = 0; q < 4; ++q) {
      uint32_t lo, hi;
      if (dec) {
        lo = pack_bf16(__uint_as_float(a[q] << 16) * d0, __uint_as_float(b[q] << 16) * d1);
        hi = pack_bf16(__uint_as_float(a[q] & 0xffff0000u) * d0, __uint_as_float(b[q] & 0xffff0000u) * d1);
      } else {
        lo = (a[q] & 0xffffu) | (b[q] << 16);
        hi = (a[q] >> 16) | (b[q] & 0xffff0000u);
      }
      const int f = fc * 8 + 2 * q;
      *(uint32_t*)(dst + tile_off(f, tp >> 2) + (tp & 3) * 4) = lo;
      *(uint32_t*)(dst + tile_off(f + 1, tp >> 2) + (tp & 3) * 4) = hi;
    }
  }
}

__device__ __forceinline__ void stage_R(char* dst, const bf16_t* __restrict__ src) {
  const int t = opaque_tid();
#pragma unroll
  for (int i = 0; i < 4; ++i) {
    const int q = t + 256 * i, row = q >> 4, c = q & 15;
    *(u32x4*)(dst + row * 256 + ((c ^ (row & 15)) << 4)) = *(const u32x4*)(src + (size_t)row * PW + c * 8);
  }
}

__device__ __forceinline__ void ret_state_unit(int u, int h, char* smem, const bf16_t* __restrict__ P, bf16_t* __restrict__ ST) {
  const int t = opaque_tid(), lane = t & 63, wave = t >> 6, r = lane & 31, hh = lane >> 5;
  char* RKT = smem;
  char* RVT = smem + 16384;
  float* dec = (float*)(smem + 32768);
  const int row0 = unit_row0(u);
  const float lg2 = log2f(1.0f - exp2f(-5.0f - (float)h));
  __syncthreads();
  if (t < 64) dec[t] = exp2f((float)(63 - t) * lg2);
  __syncthreads();
  stage_T(RKT, P + (size_t)row0 * PW + 1280 + h * 128, dec);
  stage_T(RVT, P + (size_t)row0 * PW + 1792 + h * 128, nullptr);
  __syncthreads();
  f32x16 acc[4];
#pragma unroll
  for (int j = 0; j < 4; ++j)
#pragma unroll
    for (int e = 0; e < 16; ++e) acc[j][e] = 0.f;
#pragma unroll
  for (int ks = 0; ks < 4; ++ks) {
    const bf16x8 af = *(const bf16x8*)(RKT + tile_off(32 * wave + r, 2 * ks + hh));
#pragma unroll
    for (int ej = 0; ej < 4; ++ej) {
      const bf16x8 bfr = *(const bf16x8*)(RVT + tile_off(32 * ej + r, 2 * ks + hh));
      acc[ej] = __builtin_amdgcn_mfma_f32_32x32x16_bf16(af, bfr, acc[ej], 0, 0, 0);
    }
  }
  bf16_t* o = ST + (size_t)(u * 4 + h) * 16384;
#pragma unroll
  for (int ej = 0; ej < 4; ++ej)
#pragma unroll
    for (int g = 0; g < 4; ++g) {
      uint2 w;
      w.x = pack_bf16(acc[ej][4 * g], acc[ej][4 * g + 1]);
      w.y = pack_bf16(acc[ej][4 * g + 2], acc[ej][4 * g + 3]);
      *(uint2*)(o + (32 * ej + r) * 128 + 32 * wave + 8 * g + 4 * hh) = w;
    }
}

__device__ __forceinline__ void unpack4(const uint2 v, float (&f)[4]) {
  f[0] = __uint_as_float(v.x << 16); f[1] = __uint_as_float(v.x & 0xffff0000u); f[2] = __uint_as_float(v.y << 16); f[3] = __uint_as_float(v.y & 0xffff0000u);
}
__device__ __forceinline__ void ret_scan_chain(int ci, const bf16_t* __restrict__ P, const float* __restrict__ state_in, bf16_t* __restrict__ ST, float* __restrict__ out) {
  const int d4 = ci & 31, e = (ci >> 5) & 127, h = (ci >> 12) & 3, b = (ci >> 14) & 7, samp = ci >> 17;
  const float gamma = 1.0f - exp2f(-5.0f - (float)h);
  const float g64 = exp2f(64.0f * log2f(gamma));
  float s[4], av[4];
  if (samp) {
    const bf16_t* ptr = ST + ((size_t)((256 + b) * 4 + h) * 128 + e) * 128 + d4 * 4;
    unpack4(*(const uint2*)ptr, av);
#pragma unroll
    for (int j = 0; j < 4; ++j) {
      const float sv = state_in[((size_t)(b * 4 + h) * 128 + d4 * 4 + j) * 128 + e];
      out[O_RETS + ((size_t)(b * 4 + h) * 128 + d4 * 4 + j) * 128 + e] = g64 * sv + av[j];
    }
    return;
  }
#pragma unroll
  for (int j = 0; j < 4; ++j) s[j] = 0.f;
  for (int k = 0; k < 16; ++k) {
    const bf16_t* pr = P + (size_t)(NTOK + k) * PW;
    const float v = bf2f(pr[1792 + h * 128 + e]);
#pragma unroll
    for (int j = 0; j < 4; ++j) s[j] = gamma * s[j] + bf2f(pr[1280 + h * 128 + d4 * 4 + j]) * v;
  }
  for (int c = 0; c < 32; ++c) {
    bf16_t* ptr = ST + ((size_t)((b * 32 + c) * 4 + h) * 128 + e) * 128 + d4 * 4;
    unpack4(*(const uint2*)ptr, av);
    uint2 w;
    w.x = pack_bf16(s[0], s[1]); w.y = pack_bf16(s[2], s[3]);
    *(uint2*)ptr = w;
#pragma unroll
    for (int j = 0; j < 4; ++j) s[j] = g64 * s[j] + av[j];
  }
#pragma unroll
  for (int j = 0; j < 4; ++j) out[O_RETP + ((size_t)(b * 4 + h) * 128 + d4 * 4 + j) * 128 + e] = s[j];
}

__device__ __forceinline__ void ret_out_unit(int u, int h, char* smem, const bf16_t* __restrict__ P, const bf16_t* __restrict__ Su,
                                             const float* __restrict__ gn_g, bf16_t* __restrict__ mixed) {
  const int t = opaque_tid(), lane = t & 63, wave = t >> 6, r = lane & 31, hh = lane >> 5;
  char* RQ = smem;
  char* RK = smem + 16384;
  char* RVT = smem + 32768;
  char* YL = smem + 49152;
  float* red = (float*)smem;
  const int row0 = unit_row0(u);
  const float lg2 = log2f(1.0f - exp2f(-5.0f - (float)h));
  __syncthreads();
  stage_R(RQ, P + (size_t)row0 * PW + 768 + h * 128);
  stage_R(RK, P + (size_t)row0 * PW + 1280 + h * 128);
  stage_T(RVT, P + (size_t)row0 * PW + 1792 + h * 128, nullptr);
  __syncthreads();
  const int qt = wave & 1, ep = wave >> 1;
  const int q = 32 * qt + r;
  f32x16 X[2];
#pragma unroll
  for (int kt = 0; kt < 2; ++kt) {
#pragma unroll
    for (int e = 0; e < 16; ++e) X[kt][e] = 0.f;
    if (kt <= qt) {
#pragma unroll
      for (int ks = 0; ks < 8; ++ks) {
        const int krow = 32 * kt + r, qrow = 32 * qt + r;
        const bf16x8 kf = *(const bf16x8*)(RK + krow * 256 + (((2 * ks + hh) ^ (krow & 15)) << 4));
        const bf16x8 qf = *(const bf16x8*)(RQ + qrow * 256 + (((2 * ks + hh) ^ (qrow & 15)) << 4));
        X[kt] = __builtin_amdgcn_mfma_f32_32x32x16_bf16(kf, qf, X[kt], 0, 0, 0);
      }
#pragma unroll
      for (int e = 0; e < 16; ++e) {
        const int k = 32 * kt + (e & 3) + 8 * (e >> 2) + 4 * hh;
        X[kt][e] = (q >= k) ? X[kt][e] * exp2f((float)(q - k) * lg2) : 0.f;
      }
    }
  }
  f32x16 O[2];
#pragma unroll
  for (int ei = 0; ei < 2; ++ei) {
#pragma unroll
    for (int e = 0; e < 16; ++e) O[ei][e] = 0.f;
    const int erow = 32 * (2 * ep + ei) + r;
#pragma unroll
    for (int ks = 0; ks < 8; ++ks) {
      const bf16x8 sf = *(const bf16x8*)(Su + erow * 128 + 16 * ks + 8 * hh);
      const int qrow = 32 * qt + r;
      const bf16x8 qf = *(const bf16x8*)(RQ + qrow * 256 + (((2 * ks + hh) ^ (qrow & 15)) << 4));
      O[ei] = __builtin_amdgcn_mfma_f32_32x32x16_bf16(sf, qf, O[ei], 0, 0, 0);
    }
    const float qd = exp2f((float)(q + 1) * lg2);
#pragma unroll
    for (int e = 0; e < 16; ++e) O[ei][e] *= qd;
  }
#pragma unroll
  for (int kt = 0; kt < 2; ++kt) {
    if (kt <= qt) {
#pragma unroll
      for (int sidx = 0; sidx < 2; ++sidx) {
        u32x4 xp;
#pragma unroll
        for (int j = 0; j < 4; ++j) xp[j] = pack_bf16(X[kt][8 * sidx + 2 * j], X[kt][8 * sidx + 2 * j + 1]);
        bf16x8 xf;
        __builtin_memcpy(&xf, &xp, 16);
#pragma unroll
        for (int ei = 0; ei < 2; ++ei) {
          const int erow = 32 * (2 * ep + ei) + r;
          const uint2 a0 = *(const uint2*)(RVT + tile_off(erow, 4 * kt + 2 * sidx) + 8 * hh);
          const uint2 a1 = *(const uint2*)(RVT + tile_off(erow, 4 * kt + 2 * sidx + 1) + 8 * hh);
          u32x4 ap;
          ap[0] = a0.x; ap[1] = a0.y; ap[2] = a1.x; ap[3] = a1.y;
          bf16x8 af;
          __builtin_memcpy(&af, &ap, 16);
          O[ei] = __builtin_amdgcn_mfma_f32_32x32x16_bf16(af, xf, O[ei], 0, 0, 0);
        }
      }
    }
  }
  float s1 = 0.f, s2 = 0.f;
#pragma unroll
  for (int ei = 0; ei < 2; ++ei)
#pragma unroll
    for (int e = 0; e < 16; ++e) { s1 += O[ei][e]; s2 += O[ei][e] * O[ei][e]; }
  s1 += __shfl_xor(s1, 32);
  s2 += __shfl_xor(s2, 32);
  __syncthreads();
  if (hh == 0) { red[(wave * 32 + r) * 2] = s1; red[(wave * 32 + r) * 2 + 1] = s2; }
  __syncthreads();
  {
    const int pw = wave ^ 2;
    s1 += red[(pw * 32 + r) * 2];
    s2 += red[(pw * 32 + r) * 2 + 1];
  }
  const float mean = s1 * (1.0f / 128.0f);
  const float rstd = rsqrtf(fmaxf(s2 * (1.0f / 128.0f) - mean * mean, 0.f) + LN_EPS);
  const bf16_t* rgp = P + (size_t)(row0 + q) * PW + 2304 + h * 128;
#pragma unroll
  for (int ei = 0; ei < 2; ++ei)
#pragma unroll
    for (int g = 0; g < 4; ++g) {
      const int e0 = 32 * (2 * ep + ei) + 8 * g + 4 * hh;
      const uint2 rg = *(const uint2*)(rgp + e0);
      const float4 gg = *(const float4*)(gn_g + h * 128 + e0);
      const float g0 = __uint_as_float(rg.x << 16), g1 = __uint_as_float(rg.x & 0xffff0000u), g2 = __uint_as_float(rg.y << 16), g3 = __uint_as_float(rg.y & 0xffff0000u);
      const float y0 = (O[ei][4 * g + 0] - mean) * rstd * gg.x * (g0 / (1.0f + __expf(-g0)));
      const float y1 = (O[ei][4 * g + 1] - mean) * rstd * gg.y * (g1 / (1.0f + __expf(-g1)));
      const float y2 = (O[ei][4 * g + 2] - mean) * rstd * gg.z * (g2 / (1.0f + __expf(-g2)));
      const float y3 = (O[ei][4 * g + 3] - mean) * rstd * gg.w * (g3 / (1.0f + __expf(-g3)));
      uint2 w;
      w.x = pack_bf16(y0, y1); w.y = pack_bf16(y2, y3);
      const int c = e0 >> 3;
      *(uint2*)(YL + q * 256 + ((c ^ (q & 15)) << 4) + 8 * hh) = w;
    }
  __syncthreads();
#pragma unroll
  for (int i = 0; i < 4; ++i) {
    const int qq = t + 256 * i, row = qq >> 4, c = qq & 15;
    *(u32x4*)(mixed + (size_t)(row0 + row) * D + 512 + h * 128 + c * 8) = *(const u32x4*)(YL + row * 256 + ((c ^ (row & 15)) << 4));
  }
}


constexpr int VT_STRIDE = 456;

struct AttnSrc {
  const bf16_t* P; const float *cmk, *cmv, *csk, *csv;
  int samp, b, c, kvh;
  __device__ __forceinline__ u32x4 load(int kk, int ch, bool isv) const {
    u32x4 z = make_u32x4_zero();
    const bf16_t* src = nullptr;
    const float* fsrc = nullptr;
    const int col = (isv ? 640 : 512) + kvh * 64 + ch * 8;
    if (kk < 16) {
      if (samp) fsrc = (isv ? cmv : cmk) + ((size_t)(b * 16 + kk) * 2 + kvh) * 64 + ch * 8;
      else src = P + (size_t)(NTOK + kk) * PW + col;
    } else if (kk < 208) {
      const int jb = kk - 16;
      if (samp) {
        if (jb < 128) fsrc = (isv ? csv : csk) + ((size_t)(b * 128 + jb) * 2 + kvh) * 64 + ch * 8;
        else src = P + (size_t)(NPROMPT + b * 64 + (jb - 128)) * PW + col;
      } else {
        const int f = (c - 2) * 64 + jb;
        if (f >= 0) src = P + (size_t)(b * SEQ + f) * PW + col;
      }
    }
    if (src) z = *(const u32x4*)src;
    else if (fsrc) {
      const float4 a = *(const float4*)fsrc, bq = *(const float4*)(fsrc + 4);
      z[0] = pack_bf16(a.x, a.y); z[1] = pack_bf16(a.z, a.w); z[2] = pack_bf16(bq.x, bq.y); z[3] = pack_bf16(bq.z, bq.w);
    }
    return z;
  }
};

__device__ __forceinline__ void attn_unit(int u, int kvh, int qt_lo, int qt_hi, char* smem, const bf16_t* __restrict__ P, const float* __restrict__ cmk,
                                          const float* __restrict__ cmv, const float* __restrict__ csk, const float* __restrict__ csv,
                                          const float* __restrict__ rel_bias, const float* __restrict__ sinks, bf16_t* __restrict__ mixed) {
  const int t = opaque_tid(), lane = t & 63, g = t >> 6, r = lane & 31, hh = lane >> 5;
  char* KT = smem;
  char* VT = smem + 28672;
  float* TB = (float*)(smem + 28672 + 64 * VT_STRIDE) + g * 384;
  AttnSrc as;
  as.P = P; as.cmk = cmk; as.cmv = cmv; as.csk = csk; as.csv = csv;
  as.samp = u >= 256; as.b = as.samp ? u - 256 : u >> 5; as.c = as.samp ? 32 : (u & 31); as.kvh = kvh;
  const int H = kvh * 4 + g;
  const int row0 = unit_row0(u);
  __syncthreads();
#pragma unroll
  for (int i = 0; i < 7; ++i) {
    const int qidx = t + 256 * i, key = qidx >> 3, ch = qidx & 7;
    *(u32x4*)(KT + tile_off(key, ch)) = as.load(key, ch, false);
  }
  for (int item = t; item < 896; item += 256) {
    const int fc = item / 112, tp = item - fc * 112;
    const u32x4 a = as.load(2 * tp, fc, true), bq = as.load(2 * tp + 1, fc, true);
#pragma unroll
    for (int q = 0; q < 4; ++q) {
      *(uint32_t*)(VT + (fc * 8 + 2 * q) * VT_STRIDE + tp * 4) = (a[q] & 0xffffu) | (bq[q] << 16);
      *(uint32_t*)(VT + (fc * 8 + 2 * q + 1) * VT_STRIDE + tp * 4) = (a[q] >> 16) | (bq[q] & 0xffff0000u);
    }
  }
  for (int idx = lane; idx < 383; idx += 64) TB[idx] = rel_bias[t5_bucket(idx - 191) * 8 + H];
  __syncthreads();
  const float sink = sinks[H];
#pragma unroll 1
  for (int qt = qt_lo; qt < qt_hi; ++qt) {
    bf16x8 qf[4];
#pragma unroll
    for (int ks = 0; ks < 4; ++ks) qf[ks] = *(const bf16x8*)(P + (size_t)(row0 + 32 * qt + r) * PW + H * 64 + ks * 16 + 8 * hh);
    f32x16 S[7];
#pragma unroll
    for (int kt = 0; kt < 7; ++kt) {
#pragma unroll
      for (int e = 0; e < 16; ++e) S[kt][e] = 0.f;
#pragma unroll
      for (int ks = 0; ks < 4; ++ks) {
        const bf16x8 kf = *(const bf16x8*)(KT + tile_off(32 * kt + r, 2 * ks + hh));
        S[kt] = __builtin_amdgcn_mfma_f32_32x32x16_bf16(kf, qf[ks], S[kt], 0, 0, 0);
      }
    }
    const int i = 32 * qt + r, posq = 16 + as.c * 64 + i;
    float mx = -3.0e38f;
    const float* tbl = TB + (47 - i + 4 * hh);
    const int kmin = as.samp ? 16 : (as.c >= 2 ? 16 : 144 - 64 * as.c);
#pragma unroll
    for (int kt = 0; kt < 7; ++kt)
#pragma unroll
      for (int e = 0; e < 16; ++e) {
        const int kb = 32 * kt + (e & 3) + 8 * (e >> 2);
        float sv;
        if (kb < 16) {
          const int rel = kb + 4 * hh - posq;
          sv = S[kt][e] * 0.125f + TB[(rel < -191 ? -191 : rel) + 191];
        } else if (kb >= 208) {
          sv = -1.0e30f;
        } else {
          const float bv = tbl[kb];
          sv = (kb >= kmin) ? S[kt][e] * 0.125f + bv : -1.0e30f;
        }
        S[kt][e] = sv;
        mx = fmaxf(mx, sv);
        if (e == 15) __builtin_amdgcn_sched_barrier(0);
      }
    mx = fmaxf(mx, __shfl_xor(mx, 32));
    const float m = fmaxf(mx, sink);
    float ls = 0.f;
#pragma unroll
    for (int kt = 0; kt < 7; ++kt)
#pragma unroll
      for (int e = 0; e < 16; ++e) {
        const float pv = __expf(S[kt][e] - m);
        S[kt][e] = pv;
        ls += pv;
        if (e == 15) __builtin_amdgcn_sched_barrier(0);
      }
    ls += __shfl_xor(ls, 32);
    const float inv = 1.0f / (ls + __expf(sink - m));
    f32x16 O[2];
#pragma unroll
    for (int dt = 0; dt < 2; ++dt)
#pragma unroll
      for (int e = 0; e < 16; ++e) O[dt][e] = 0.f;
#pragma unroll
    for (int kt = 0; kt < 7; ++kt)
#pragma unroll
      for (int sidx = 0; sidx < 2; ++sidx) {
        u32x4 xp;
#pragma unroll
        for (int j = 0; j < 4; ++j) xp[j] = pack_bf16(S[kt][8 * sidx + 2 * j], S[kt][8 * sidx + 2 * j + 1]);
        bf16x8 xf;
        __builtin_memcpy(&xf, &xp, 16);
#pragma unroll
        for (int dt = 0; dt < 2; ++dt) {
          const char* vp = VT + (32 * dt + r) * VT_STRIDE + (32 * kt + 16 * sidx + 4 * hh) * 2;
          const uint2 a0 = *(const uint2*)vp, a1 = *(const uint2*)(vp + 16);
          u32x4 ap;
          ap[0] = a0.x; ap[1] = a0.y; ap[2] = a1.x; ap[3] = a1.y;
          bf16x8 af;
          __builtin_memcpy(&af, &ap, 16);
          O[dt] = __builtin_amdgcn_mfma_f32_32x32x16_bf16(af, xf, O[dt], 0, 0, 0);
        }
      }
    bf16_t* op = mixed + (size_t)(row0 + i) * D + H * 64 + 4 * hh;
#pragma unroll
    for (int dt = 0; dt < 2; ++dt)
#pragma unroll
      for (int g4 = 0; g4 < 4; ++g4) {
        uint2 w;
        w.x = pack_bf16(O[dt][4 * g4] * inv, O[dt][4 * g4 + 1] * inv);
        w.y = pack_bf16(O[dt][4 * g4 + 2] * inv, O[dt][4 * g4 + 3] * inv);
        *(uint2*)(op + 32 * dt + 8 * g4) = w;
      }
  }
}


#define XB_TMO      128
#define XB_XCNT(j)  (256  + 64 * (j))
#define XB_XSUB(j)  (1280 + 64 * (j))
#define XB_XGEN(j)  (2304 + 64 * (j))
#define XB_TOP      3328
#define XB_TOPGEN   3392
#define XCD_BAR_WORDS 3456
#define XB_SPIN_CAP (1u << 18)
#define LAS __attribute__((address_space(3)))
__device__ __forceinline__ unsigned xb_ld(unsigned* p)              { return __hip_atomic_load(p, __ATOMIC_RELAXED, __HIP_MEMORY_SCOPE_AGENT); }
__device__ __forceinline__ unsigned xb_add(unsigned* p, unsigned v) { return __hip_atomic_fetch_add(p, v, __ATOMIC_RELAXED, __HIP_MEMORY_SCOPE_AGENT); }
__device__ __forceinline__ unsigned xb_xcc_id() { return (unsigned)__builtin_amdgcn_s_getreg((3 << 11) | 20) & 0xFu; }
#define XB_SPIN(cond, bar) do { unsigned _sp = 0; while (cond) { __builtin_amdgcn_s_sleep(1); \
    if ((++_sp & 255u) == 0u) { if (xb_ld(&(bar)[XB_TMO])) break; if (_sp > XB_SPIN_CAP) { atomicAdd(&(bar)[XB_TMO], 1u); break; } } } } while (0)
struct XcdBarrier { unsigned* bar; unsigned x; volatile LAS unsigned* st; };
__device__ __forceinline__ XcdBarrier xcd_barrier_post(unsigned* bar, volatile LAS unsigned* st) {
  XcdBarrier b; b.bar = bar; b.x = xb_xcc_id(); b.st = st;
  if (threadIdx.x == 0) (void)xb_add(&bar[XB_XCNT(b.x)], 1u);
  return b;
}
__device__ __forceinline__ void xcd_barrier_complete(unsigned* bar, unsigned x, unsigned& nloc, unsigned& nx) {
  const unsigned G = gridDim.x * gridDim.y * gridDim.z;
  unsigned sum, cnt, mine, sp = 0u;
  for (;;) {
    sum = 0u; cnt = 0u; mine = 0u;
#pragma unroll
    for (unsigned j = 0; j < 16; ++j) { const unsigned c = xb_ld(&bar[XB_XCNT(j)]); sum += c; cnt += (c > 0u) ? 1u : 0u; mine = (j == x) ? c : mine; }
    if (sum == G) break;
    __builtin_amdgcn_s_sleep(1);
    if ((++sp & 255u) == 0u) { if (xb_ld(&bar[XB_TMO])) break; if (sp > XB_SPIN_CAP) { atomicAdd(&bar[XB_TMO], 1u); break; } }
  }
  nloc = mine > 0u ? mine : 1u; nx = cnt > 0u ? cnt : 1u;
}
__device__ __forceinline__ void xcd_barrier(const XcdBarrier& b) {
  asm volatile("s_waitcnt vmcnt(0)" ::: "memory");
  __syncthreads();
  if (threadIdx.x == 0) {
    unsigned* bar = b.bar;
    __builtin_amdgcn_s_waitcnt(0);
    unsigned nloc = b.st[0], nx = b.st[1];
    if (nloc == 0u) { xcd_barrier_complete(bar, b.x, nloc, nx); b.st[0] = nloc; b.st[1] = nx; }
    const unsigned old = xb_add(&bar[XB_XSUB(b.x)], 1u);
    const unsigned gen = old / nloc;
    if (old + 1u == (gen + 1u) * nloc) {
      __builtin_amdgcn_fence(__ATOMIC_RELEASE, "agent");
      asm volatile("s_waitcnt vmcnt(0)" ::: "memory");
      const unsigned og = xb_add(&bar[XB_TOP], 1u);
      const unsigned tg = og / nx;
      if (og + 1u == (tg + 1u) * nx) xb_add(&bar[XB_TOPGEN], 1u);
      else XB_SPIN(xb_ld(&bar[XB_TOPGEN]) == tg, bar);
      __builtin_amdgcn_fence(__ATOMIC_ACQUIRE, "agent");
      xb_add(&bar[XB_XGEN(b.x)], 1u);
      asm volatile("s_waitcnt vmcnt(0)" ::: "memory");
    } else {
      XB_SPIN(xb_ld(&bar[XB_XGEN(b.x)]) == gen, bar);
      __builtin_amdgcn_fence(__ATOMIC_ACQUIRE, "agent");
      asm volatile("s_waitcnt vmcnt(0)" ::: "memory");
    }
  }
  __syncthreads();
}

struct Params {
  const float *x_prompt, *x_sample, *cmk, *cmv, *csk, *csv, *state_ret, *meta_tokens, *ln_in_g, *ln_in_b, *rel_bias, *w_in,
      *w_out, *sinks, *gn_g, *ln1_g, *ln1_b, *peer_wq, *subk, *peer_u, *peer_v, *ln2_g, *ln2_b;
  float* out;
  char* ws;
};

#ifndef PHASE_MASK
#define PHASE_MASK 0x1ff
#endif
#ifndef PHASE_TWICE
#define PHASE_TWICE 0
#endif
#define PH_ON(n) (((PHASE_MASK) >> (n)) & 1)
#define PH_REP(n) for (int rep_ = 0; rep_ < 1 + (((PHASE_TWICE) >> (n)) & 1); ++rep_)

__global__ void __launch_bounds__(256, 2) mega_kernel(Params p) {
  __shared__ __attribute__((aligned(16))) char smem[73728 + 16];
  if (threadIdx.x < 4) ((unsigned*)(smem + 73728))[threadIdx.x] = 0u;
  __syncthreads();
  const XcdBarrier xb = xcd_barrier_post((unsigned*)(p.ws + W_BAR), (volatile LAS unsigned*)(smem + 73728));
  const int G = gridDim.x, bid = blockIdx.x;
  bf16_t* hbf = (bf16_t*)(p.ws + W_HBF);
  bf16_t* P = (bf16_t*)(p.ws + W_P);
  bf16_t* z = (bf16_t*)(p.ws + W_P);
  bf16_t* mixed = (bf16_t*)(p.ws + W_MIXED);
  int* lidx = (int*)(p.ws + W_LIDX);
  float* lgate = (float*)(p.ws + W_LGATE);
  bf16_t* wt_in = (bf16_t*)(p.ws + W_WTIN);
  bf16_t* wt_out = (bf16_t*)(p.ws + W_WTOUT);
  bf16_t* wt_q = (bf16_t*)(p.ws + W_WTQ);
  float2* rope = (float2*)(p.ws + W_ROPE);
  bf16_t* h1bf = mixed;
  uint8_t* U8 = (uint8_t*)(p.ws + W_U8);
  uint8_t* V8 = (uint8_t*)(p.ws + W_U8) + 1024;
  float* su = (float*)(p.ws + W_SU);
  float* sv = (float*)(p.ws + W_SV);
  uint8_t* xq = (uint8_t*)(p.ws + W_XQ);
  bf16_t* subk_bf = (bf16_t*)(p.ws + W_SUBK);
  float* xs = (float*)(p.ws + W_XS);
  bf16_t* ST = (bf16_t*)p.out;
  bf16_t* STs = (bf16_t*)(p.ws + W_LIDX);
  const int nw = blockDim.x >> 6, W = G * nw;

  if (PH_ON(0)) PH_REP(0) {
    const int lane = opaque_tid() & 63, gw = bid * nw + (opaque_tid() >> 6);
    {
      int r = gw;
      for (; r + 3 * W < NROWS; r += 4 * W) { const int rows[4] = {r, r + W, r + 2 * W, r + 3 * W}; ln_in_rows<4>(rows, lane, p.x_prompt, p.x_sample, p.meta_tokens, p.ln_in_g, p.ln_in_b, hbf); }
      for (; r < NROWS; r += W) { const int rows[1] = {r}; ln_in_rows<1>(rows, lane, p.x_prompt, p.x_sample, p.meta_tokens, p.ln_in_g, p.ln_in_b, hbf); }
    }
    for (int u = bid; u < 704; u += G) transpose_tile(u % 16, u / 16, smem, p.w_in, PW, D, wt_in);
    for (int idx = bid * 256 + opaque_tid(); idx < 2128 * 64; idx += G * 256) {
      const int pos = idx >> 6, d = idx & 63;
      const float inv = powf(10000.0f, -(float)d / 64.0f);
      float sn, cs;
      sincosf((float)pos * inv, &sn, &cs);
      rope[idx] = make_float2(cs, sn);
    }
  }
  xcd_barrier(xb);
#ifdef PROBE_GEMM
  for (int u = bid; u < 22 * 133; u += G) gemm_mfma_tile_v<PROBE_GEMM>(u / 22, u % 22, smem, hbf, NROWS, wt_in, D, EpiInProjM{P, p.out, rope});
#endif
  if (PH_ON(1)) PH_REP(1)
  {
    const int lane = opaque_tid() & 63, gw = bid * nw + (opaque_tid() >> 6);
    int qr = gw;
    for (int u = bid; u < 11 * 133; u += G) {
      gemm_mfma_tile_n256(u / 11, u % 11, smem, hbf, NROWS, wt_in, D, EpiInProjM{P, p.out, rope});
      for (int it = 0; it < 6 && qr < 32768; ++it, qr += W) {
        if (qr < 16384) quant_table_row(p.peer_u + (size_t)qr * D, lane, U8 + (size_t)qr * 2048, su + qr, false);
        else quant_table_row(p.peer_v + (size_t)(qr - 16384) * D, lane, V8 + (size_t)(qr - 16384) * 2048, sv + (qr - 16384), true);
      }
    }
    for (; qr < 32768; qr += W) {
      if (qr < 16384) quant_table_row(p.peer_u + (size_t)qr * D, lane, U8 + (size_t)qr * 2048, su + qr, false);
      else quant_table_row(p.peer_v + (size_t)(qr - 16384) * D, lane, V8 + (size_t)(qr - 16384) * 2048, sv + (qr - 16384), true);
    }
  }
  xcd_barrier(xb);
  if (PH_ON(2)) PH_REP(2)
    for (int u = bid; u < 1056; u += G) ret_state_unit(u >> 2, u & 3, smem, P, ST);
  for (int idx = bid * 256 + opaque_tid(); idx < 32 * 16384; idx += G * 256) {
    const int d = idx & 127, e = (idx >> 7) & 127, bh = idx >> 14;
    STs[idx] = f2bf(p.state_ret[((size_t)bh * 128 + d) * 128 + e]);
  }
  xcd_barrier(xb);
#ifdef PROBE_ATTN
  for (int rep = 0; rep < PROBE_ATTN; ++rep)
    for (int u = bid; u < 528; u += G) attn_unit(u >> 1, u & 1, 0, 2, smem, P, p.cmk, p.cmv, p.csk, p.csv, p.rel_bias, p.sinks, mixed);
  xcd_barrier(xb);
#endif
  if (PH_ON(3)) {
    const int lane = opaque_tid() & 63, gw = bid * nw + (opaque_tid() >> 6);
    const bool attn_first = (bid & 1) != 0;
    for (int half = 0; half < 2; ++half) {
      if ((half == 0) == attn_first) {
        for (int u = G - 1 - bid; u < 32; u += G) ret_out_unit(256 + (u >> 2), u & 3, smem, P, STs + (size_t)u * 16384, p.gn_g, mixed);
        for (int u = bid; u < 512 + 32; u += G) {
          if (u < 512) attn_unit(u >> 1, u & 1, 0, 2, smem, P, p.cmk, p.cmv, p.csk, p.csv, p.rel_bias, p.sinks, mixed);
          else { const int v = u - 512; attn_unit(256 + (v >> 2), (v >> 1) & 1, v & 1, (v & 1) + 1, smem, P, p.cmk, p.cmv, p.csk, p.csv, p.rel_bias, p.sinks, mixed); }
        }
      } else {
        for (int ci = bid * 256 + opaque_tid(); ci < 262144; ci += G * 256) ret_scan_chain(ci, P, p.state_ret, ST, p.out);
        for (int u = bid; u < 512; u += G) {
          if (u < 256) transpose_tile(u % 16, u / 16, smem, p.w_out, D, D, wt_out);
          else transpose_tile((u - 256) % 16, (u - 256) / 16, smem, p.peer_wq, D, D, wt_q);
        }
        for (int idx = bid * 256 + opaque_tid(); idx < 131072; idx += G * 256) subk_bf[idx] = f2bf(p.subk[idx]);
      }
    }
  }
  xcd_barrier(xb);
  if (PH_ON(4)) PH_REP(4)
    for (int u = bid; u < 1024; u += G) ret_out_unit(u >> 2, u & 3, smem, P, ST + (size_t)u * 16384, p.gn_g, mixed);
  xcd_barrier(xb);
  if (PH_ON(5)) PH_REP(5)
    for (int u = bid; u < 8 * 132; u += G) gemm_mfma_tile(u / 8, u % 8, smem, mixed, NTOK, wt_out, D, EpiOutProjM{hbf, z});
  xcd_barrier(xb);
  if (PH_ON(6)) {
    const int lane = opaque_tid() & 63, gw = bid * nw + (opaque_tid() >> 6);
    int r = gw;
    for (; r + 3 * W < NTOK; r += 4 * W) { const int rows[4] = {r, r + W, r + 2 * W, r + 3 * W}; ln1_rows<4>(rows, lane, z, p.ln1_g, p.ln1_b, h1bf, xq, xs); }
    for (; r < NTOK; r += W) { const int rows[1] = {r}; ln1_rows<1>(rows, lane, z, p.ln1_g, p.ln1_b, h1bf, xq, xs); }
  }
  xcd_barrier(xb);
#ifdef PROBE_PQ
  for (int u = bid; u < 8 * 132; u += G) gemm_mfma_tile_v<PROBE_PQ>(u / 8, u % 8, smem, h1bf, NTOK, wt_q, D, EpiTopK{subk_bf, lidx, lgate});
#endif
  if (PH_ON(7)) PH_REP(7)
    for (int u = bid; u < 8 * 132; u += G) gemm_mfma_tile(u / 8, u % 8, smem, h1bf, NTOK, wt_q, D, EpiTopK{subk_bf, lidx, lgate});
  xcd_barrier(xb);
  if (PH_ON(8)) PH_REP(8) {
    const int lane = opaque_tid() & 63, wave = opaque_tid() >> 6, gw = bid * nw + wave;
    const SweepArgs sa{lidx, lgate, U8, V8, su, sv, xq, xs, h1bf, p.ln2_g, p.ln2_b, p.out};
    const int TPP = W * 4;
    const int NPF = NTOK / TPP;
    for (int pass = 0; pass < NPF; ++pass)
      sweep_groups<false>(pass * TPP + gw * 4, lane, smem + wave * SG_LDS_PER_WAVE, sa);
#ifdef PROBE_SG
    {
#ifdef PROBE_PACE
      const unsigned long long tstart = __builtin_amdgcn_s_memrealtime();
      for (int pass = 0; pass < NPF; ++pass)
        sweep_groups<true>(pass * TPP + gw * 4, lane, smem + wave * SG_LDS_PER_WAVE, sa, 0, tstart + 1500ull + (unsigned long long)pass * (175ull * PROBE_PACE + 1500ull), PROBE_PACE);
#else
      for (int pass = 0; pass < NPF; ++pass)
#ifdef PROBE_ROT
        sweep_groups<true>(pass * TPP + gw * 4, lane, smem + wave * SG_LDS_PER_WAVE, sa, (int)(xb_xcc_id() & 7u) * PROBE_ROT);
#else
        sweep_groups<true>(pass * TPP + gw * 4, lane, smem + wave * SG_LDS_PER_WAVE, sa);
#endif
#endif
    }
#endif
    for (int tk = NPF * TPP + bid; tk < NTOK; tk += G)
      sweep_mini(tk, lane, wave, smem, sa);
  }
#ifdef PROBE_SYNCS
  for (int i = 0; i < PROBE_SYNCS; ++i) xcd_barrier(xb);
#endif
}

}

extern "C" void kernel_launch(void* const* d_in, const int* in_sizes, int n_in, void* d_out, int out_size, void* d_ws,
                              size_t ws_size, hipStream_t stream) {
  static int grid_blocks = 0;
  if (!grid_blocks) {
    int dev = 0, cus = 0, per_cu = 0;
    (void)hipGetDevice(&dev);
    (void)hipDeviceGetAttribute(&cus, hipDeviceAttributeMultiprocessorCount, dev);
    (void)hipOccupancyMaxActiveBlocksPerMultiprocessor(&per_cu, mega_kernel, 256, 0);
    if (per_cu > 2) per_cu = 2;
    if (per_cu < 1) per_cu = 1;
    grid_blocks = cus * per_cu;
  }
  Params p{};
  const float** pp = (const float**)&p;
  for (int i = 0; i < 23; ++i) pp[i] = (const float*)d_in[i];
  p.out = (float*)d_out;
  p.ws = (char*)d_ws;
  void* args[] = {&p};
  (void)hipMemsetAsync((char*)d_ws + W_BAR, 0, 3456 * 4, stream);
  hipError_t e = hipLaunchCooperativeKernel((void*)mega_kernel, dim3(grid_blocks), dim3(256), args, 0, stream);
  if (e != hipSuccess) fprintf(stderr, "cooperative launch failed: %s (grid %d)\n", hipGetErrorString(e), grid_blocks);
}
```

```cpp
#include <hip/hip_runtime.h>
#include <hip/hip_cooperative_groups.h>
#include <stdint.h>
#include <cstdio>
namespace cg = cooperative_groups;

namespace {

constexpr int D = 1024;
constexpr int NB = 8, SEQ = 2048, DSEQ = 64;
constexpr int NPROMPT = NB * SEQ;
constexpr int NSAMPLE = NB * DSEQ;
constexpr int NTOK = NPROMPT + NSAMPLE;
constexpr int NMETA = 16;
constexpr int NROWS = NTOK + NMETA;
constexpr int PW = 2816;
constexpr float LN_EPS = 1e-5f;
constexpr float ALPHA = 1.18920711500272f;

constexpr size_t O_Y = 0;
constexpr size_t O_METAK = 17301504;
constexpr size_t O_METAV = O_METAK + 16384;
constexpr size_t O_SWAKP = O_METAV + 16384;
constexpr size_t O_SWAVP = O_SWAKP + 131072;
constexpr size_t O_RETP = O_SWAVP + 131072;
constexpr size_t O_SWAKS = O_RETP + 524288;
constexpr size_t O_SWAVS = O_SWAKS + 65536;
constexpr size_t O_RETS = O_SWAVS + 65536;

constexpr size_t W_HBF = 0;
constexpr size_t W_P = W_HBF + (size_t)NROWS * D * 2;
constexpr size_t W_MIXED = W_P + (size_t)NROWS * PW * 2;
constexpr size_t W_LIDX = W_MIXED + (size_t)NTOK * D * 2;
constexpr size_t W_LGATE = W_LIDX + (size_t)NTOK * 128 * 4;
constexpr size_t W_WTIN = W_LGATE + (size_t)NTOK * 128 * 4;
constexpr size_t W_WTOUT = W_WTIN + (size_t)PW * D * 2;
constexpr size_t W_WTQ = W_WTOUT + (size_t)D * D * 2;
constexpr size_t W_ROPE = W_WTQ + (size_t)D * D * 2;
constexpr size_t W_U8 = W_ROPE + (size_t)2128 * 64 * 8;
constexpr size_t W_V8 = W_U8 + (size_t)16384 * 1024;
constexpr size_t W_SU = W_V8 + (size_t)16384 * 1024;
constexpr size_t W_SV = W_SU + 65536;
constexpr size_t W_XQ = W_SV + 65536;
constexpr size_t W_XS = W_XQ + (size_t)NTOK * 1024;
constexpr size_t W_SUBK = W_XS + (size_t)NTOK * 4 + 256;
constexpr size_t W_BAR = W_SUBK + 131072 * 2;
constexpr size_t W_END = W_BAR + 3456 * 4;
static_assert(W_END <= (size_t)256 * 1024 * 1024, "workspace overflow");

typedef uint16_t bf16_t;

__device__ __forceinline__ int opaque_tid() { int t = (int)threadIdx.x; asm volatile("" : "+v"(t)); return t; }

__device__ __forceinline__ bf16_t f2bf(float f) {
  uint32_t u = __float_as_uint(f);
  u += 0x7FFFu + ((u >> 16) & 1u);
  return (bf16_t)(u >> 16);
}
__device__ __forceinline__ float bf2f(bf16_t h) { return __uint_as_float(((uint32_t)h) << 16); }

__device__ __forceinline__ int row_pos(int r) {
  if (r < NPROMPT) return 16 + (r & 2047);
  if (r < NTOK) return 16 + 2048 + ((r - NPROMPT) & 63);
  return r - NTOK;
}


template <int M> __device__ __forceinline__ int lane_xor_i(int x) {
  if (M == 1) return __builtin_amdgcn_mov_dpp(x, 0xB1, 0xF, 0xF, true);
  else if (M == 2) return __builtin_amdgcn_mov_dpp(x, 0x4E, 0xF, 0xF, true);
  else if (M == 4) return __builtin_amdgcn_mov_dpp(__builtin_amdgcn_mov_dpp(x, 0x141, 0xF, 0xF, true), 0x1B, 0xF, 0xF, true);
  else if (M == 8) return __builtin_amdgcn_mov_dpp(__builtin_amdgcn_mov_dpp(x, 0x140, 0xF, 0xF, true), 0x141, 0xF, 0xF, true);
  else if (M == 16) return __builtin_amdgcn_ds_swizzle(x, 0x401F);
  else {
    const auto r = __builtin_amdgcn_permlane32_swap((unsigned)x, (unsigned)x, false, false);
    return (int)((__builtin_amdgcn_mbcnt_hi(~0u, __builtin_amdgcn_mbcnt_lo(~0u, 0u)) < 32u) ? r[1] : r[0]);
  }
}
template <int M> __device__ __forceinline__ float lane_xor_f(float x) { return __int_as_float(lane_xor_i<M>(__float_as_int(x))); }

__device__ __forceinline__ float wave_sum(float v) {
  v += lane_xor_f<1>(v); v += lane_xor_f<2>(v); v += lane_xor_f<4>(v); v += lane_xor_f<8>(v); v += lane_xor_f<16>(v); v += lane_xor_f<32>(v);
  return v;
}


__device__ __forceinline__ int t5_bucket(int rel) {
  int n = rel < 0 ? -rel : rel;
  int b;
  if (n < 8) b = n;
  else {
    int l = 2 + 31 - __clz(n * n);
    b = l > 15 ? 15 : l;
  }
  return (rel > 0 ? 16 : 0) + b;
}

__device__ __forceinline__ float gelu_tanh(float x) {
  float u = 0.7978845608028654f * (x + 0.044715f * x * x * x);
  return 0.5f * x * (1.0f + tanhf(u));
}


typedef short bf16x8 __attribute__((ext_vector_type(8)));
typedef float f32x16 __attribute__((ext_vector_type(16)));
typedef uint32_t u32x4 __attribute__((ext_vector_type(4)));
__device__ __forceinline__ u32x4 make_u32x4_zero() { u32x4 r; r[0] = 0; r[1] = 0; r[2] = 0; r[3] = 0; return r; }

__device__ __forceinline__ uint32_t pack_bf16(float lo, float hi) { return (uint32_t)f2bf(lo) | ((uint32_t)f2bf(hi) << 16); }

__device__ __forceinline__ int tile_off(int row, int c) {
  const int s = row >> 1;
  const int sc = ((row & 1) << 3) | c;
  return s * 256 + ((sc ^ (s & 15)) << 4);
}

template <int GV, class EPI>
__device__ __forceinline__ void gemm_mfma_tile_v(int mt, int nt, char* smem, const bf16_t* __restrict__ A, int M,
                                               const bf16_t* __restrict__ Bt, int K, const EPI& epi) {
  const int t = opaque_tid(), lane = t & 63, wave = t >> 6, r = lane & 31, h = lane >> 5;
  const int m0 = mt * 128, n0 = nt * 128;
  const bf16_t* ag[4];
  const bf16_t* bg[4];
#pragma unroll
  for (int i = 0; i < 4; ++i) {
    const int o = (wave * 4 + i) * 1024 + lane * 16;
    const int sr = o >> 8, scp = (o >> 4) & 15, sc = scp ^ (sr & 15);
    const int row = 2 * sr + (sc >> 3), c = sc & 7;
    int ar = m0 + row;
    ar = ar < M ? ar : M - 1;
    ag[i] = A + (size_t)ar * K + c * 8;
    bg[i] = Bt + (size_t)(n0 + row) * K + c * 8;
  }
  int roff[4];
#pragma unroll
  for (int ks = 0; ks < 4; ++ks) roff[ks] = tile_off(r, ks * 2 + h);
  f32x16 acc[4];
#pragma unroll
  for (int j = 0; j < 4; ++j)
#pragma unroll
    for (int e = 0; e < 16; ++e) acc[j][e] = 0.f;
  __syncthreads();
#pragma unroll
  for (int i = 0; i < 4; ++i) {
    __builtin_amdgcn_global_load_lds((const unsigned*)ag[i], (unsigned*)(smem + (wave * 4 + i) * 1024), 16, 0, 0);
    __builtin_amdgcn_global_load_lds((const unsigned*)bg[i], (unsigned*)(smem + 16384 + (wave * 4 + i) * 1024), 16, 0, 0);
  }
  __syncthreads();
  const int nk = K >> 6;
  for (int kt = 0; kt < nk; ++kt) {
    char* cur = smem + (kt & 1) * 32768;
    char* nxt = smem + ((kt + 1) & 1) * 32768;
    if (GV != 1 && kt + 1 < nk) {
#pragma unroll
      for (int i = 0; i < 4; ++i) {
        __builtin_amdgcn_global_load_lds((const unsigned*)(ag[i] + (kt + 1) * 64), (unsigned*)(nxt + (wave * 4 + i) * 1024), 16, 0, 0);
        __builtin_amdgcn_global_load_lds((const unsigned*)(bg[i] + (kt + 1) * 64), (unsigned*)(nxt + 16384 + (wave * 4 + i) * 1024), 16, 0, 0);
      }
    }
    const char* sa = cur + wave * 4096;
    const char* sb = cur + 16384;
    if (GV != 2) {
#pragma unroll
    for (int ks = 0; ks < 4; ++ks) {
      const bf16x8 af = *(const bf16x8*)(sa + roff[ks]);
#pragma unroll
      for (int j = 0; j < 4; ++j) {
        const bf16x8 bfr = *(const bf16x8*)(sb + j * 4096 + roff[ks]);
        acc[j] = __builtin_amdgcn_mfma_f32_32x32x16_bf16(bfr, af, acc[j], 0, 0, 0);
      }
    }
    }
    __syncthreads();
  }
  const int row = m0 + wave * 32 + r;
  if (GV == 4) { epi(row, 0, h, acc, smem); return; }
  if (GV == 5) { epi(row, 6 + (nt & 7), h, acc, smem); return; }
  if (GV != 0) { asm volatile("" :: "v"(acc[0]), "v"(acc[1]), "v"(acc[2]), "v"(acc[3])); return; }
  epi(row, nt, h, acc, smem);
}
template <class EPI>
__device__ __forceinline__ void gemm_mfma_tile(int mt, int nt, char* smem, const bf16_t* __restrict__ A, int M,
                                               const bf16_t* __restrict__ Bt, int K, const EPI& epi) {
  gemm_mfma_tile_v<0, EPI>(mt, nt, smem, A, M, Bt, K, epi);
}


template <class EPI>
__device__ __forceinline__ void gemm_mfma_tile_n256(int mt, int nt2, char* smem, const bf16_t* __restrict__ A, int M,
                                                    const bf16_t* __restrict__ Bt, int K, const EPI& epi) {
  const int t = opaque_tid(), lane = t & 63, wave = t >> 6, r = lane & 31, h = lane >> 5;
  const int m0 = mt * 128, n0 = nt2 * 256;
  const bf16_t* gsrc[6];
  int ldst[6];
#pragma unroll
  for (int i = 0; i < 6; ++i) {
    const int q = wave * 6 + i;
    const int rowl = lane >> 2, pc = lane & 3;
    const bool isA = q < 8;
    const int row = 16 * (isA ? q : q - 8) + rowl;
    const int c = pc ^ ((row >> 2) & 3);
    int ar = m0 + row;
    ar = ar < M ? ar : M - 1;
    gsrc[i] = isA ? A + (size_t)ar * K + c * 8 : Bt + (size_t)(n0 + row) * K + c * 8;
    ldst[i] = q * 1024;
  }
  int roff[2];
#pragma unroll
  for (int ks = 0; ks < 2; ++ks) roff[ks] = r * 64 + (((2 * ks + h) ^ ((r >> 2) & 3)) << 4);
  f32x16 acc[8];
#pragma unroll
  for (int j = 0; j < 8; ++j)
#pragma unroll
    for (int e = 0; e < 16; ++e) acc[j][e] = 0.f;
  __syncthreads();
  const int nk = K >> 5;
#pragma unroll
  for (int i = 0; i < 6; ++i) __builtin_amdgcn_global_load_lds((const unsigned*)gsrc[i], (unsigned*)(smem + ldst[i]), 16, 0, 0);
#pragma unroll
  for (int i = 0; i < 6; ++i) __builtin_amdgcn_global_load_lds((const unsigned*)(gsrc[i] + 32), (unsigned*)(smem + 24576 + ldst[i]), 16, 0, 0);
  asm volatile("s_waitcnt vmcnt(6)" ::: "memory");
  asm volatile("s_waitcnt lgkmcnt(0)" ::: "memory");
  __builtin_amdgcn_s_barrier();
  int cs = 0;
  for (int kt = 0; kt < nk; ++kt) {
    char* cur = smem + cs * 24576;
    const int ns = cs >= 1 ? cs - 1 : 2;
    if (kt + 2 < nk) {
      char* nxt = smem + ns * 24576;
#pragma unroll
      for (int i = 0; i < 6; ++i) __builtin_amdgcn_global_load_lds((const unsigned*)(gsrc[i] + (kt + 2) * 32), (unsigned*)(nxt + ldst[i]), 16, 0, 0);
    }
    const char* sa = cur + wave * 2048;
    const char* sb = cur + 8192;
    bf16x8 af[2], bfr[2][8];
#pragma unroll
    for (int ks = 0; ks < 2; ++ks) {
      af[ks] = *(const bf16x8*)(sa + roff[ks]);
#pragma unroll
      for (int j = 0; j < 8; ++j) bfr[ks][j] = *(const bf16x8*)(sb + j * 2048 + roff[ks]);
    }
    asm volatile("" : "+v"(af[0]), "+v"(af[1]), "+v"(bfr[0][0]), "+v"(bfr[0][1]), "+v"(bfr[0][2]), "+v"(bfr[0][3]), "+v"(bfr[0][4]), "+v"(bfr[0][5]), "+v"(bfr[0][6]), "+v"(bfr[0][7]));
    asm volatile("" : "+v"(bfr[1][0]), "+v"(bfr[1][1]), "+v"(bfr[1][2]), "+v"(bfr[1][3]), "+v"(bfr[1][4]), "+v"(bfr[1][5]), "+v"(bfr[1][6]), "+v"(bfr[1][7]));
#pragma unroll
    for (int ks = 0; ks < 2; ++ks)
#pragma unroll
      for (int j = 0; j < 8; ++j) acc[j] = __builtin_amdgcn_mfma_f32_32x32x16_bf16(bfr[ks][j], af[ks], acc[j], 0, 0, 0);
    __builtin_amdgcn_sched_barrier(0);
    if (kt + 2 < nk) asm volatile("s_waitcnt vmcnt(6)" ::: "memory");
    else asm volatile("s_waitcnt vmcnt(0)" ::: "memory");
    asm volatile("s_waitcnt lgkmcnt(0)" ::: "memory");
    __builtin_amdgcn_s_barrier();
    cs = cs == 2 ? 0 : cs + 1;
  }
  const int row = m0 + wave * 32 + r;
  epi(row, 2 * nt2, h, *reinterpret_cast<f32x16(*)[4]>(&acc[0]), smem);
  epi(row, 2 * nt2 + 1, h, *reinterpret_cast<f32x16(*)[4]>(&acc[4]), smem);
}

struct EpiInProjM {
  bf16_t* P; float* out; const float2* rope;
  __device__ __forceinline__ void operator()(int row, int nt, int h, f32x16 (&acc)[4], char* smem) const {
    if (nt >= 6 && nt < 14) {
      const float sc = nt >= 10 ? 0.08838834764831845f : 1.0f;
      const float2* rp = rope + (size_t)row_pos(row) * 64;
#pragma unroll
      for (int j = 0; j < 2; ++j)
#pragma unroll
        for (int g = 0; g < 4; ++g)
#pragma unroll
          for (int i = 0; i < 4; ++i) {
            const float2 cs = rp[j * 32 + 8 * g + 4 * h + i];
            const float x1 = acc[j][4 * g + i], x2 = acc[j + 2][4 * g + i];
            acc[j][4 * g + i] = (x1 * cs.x - x2 * cs.y) * sc;
            acc[j + 2][4 * g + i] = (x1 * cs.y + x2 * cs.x) * sc;
          }
    }
    {
      const int lane = opaque_tid() & 63, wave = opaque_tid() >> 6, r = lane & 31;
      char* st = smem + wave * 8704;
#pragma unroll
      for (int j = 0; j < 4; ++j)
#pragma unroll
        for (int g = 0; g < 4; ++g) {
          uint2 w;
          w.x = pack_bf16(acc[j][4 * g], acc[j][4 * g + 1]);
          w.y = pack_bf16(acc[j][4 * g + 2], acc[j][4 * g + 3]);
          *(uint2*)(st + r * 272 + (j * 32 + 8 * g + 4 * h) * 2) = w;
        }
      const int rbase = row - r;
#pragma unroll
      for (int it = 0; it < 8; ++it) {
        const int rl = it * 4 + (lane >> 4), ch = lane & 15;
        const u32x4 v = *(const u32x4*)(st + rl * 272 + ch * 16);
        if (rbase + rl < NROWS) *(u32x4*)(P + (size_t)(rbase + rl) * PW + nt * 128 + ch * 8) = v;
      }
    }
    if (row >= NROWS) return;
    if (nt == 4 || nt == 5) {
      const bool isv = nt == 5;
#pragma unroll
      for (int j = 0; j < 4; ++j)
#pragma unroll
        for (int g = 0; g < 4; ++g) {
          const int col = j * 32 + 8 * g + 4 * h;
          const float4 val = make_float4(acc[j][4 * g], acc[j][4 * g + 1], acc[j][4 * g + 2], acc[j][4 * g + 3]);
          if (row < NPROMPT) {
            const int b = row >> 11, sidx = row & 2047;
            if (sidx >= SEQ - 128) *(float4*)(out + (isv ? O_SWAVP : O_SWAKP) + (size_t)(b * 128 + (sidx - (SEQ - 128))) * 128 + col) = val;
          } else if (row < NTOK) {
            *(float4*)(out + (isv ? O_SWAVS : O_SWAKS) + (size_t)(row - NPROMPT) * 128 + col) = val;
          } else {
            const int m = row - NTOK;
            for (int b = 0; b < NB; ++b) *(float4*)(out + (isv ? O_METAV : O_METAK) + (size_t)(b * 16 + m) * 128 + col) = val;
          }
        }
    }
  }
};

struct EpiOutProjM {
  const bf16_t* hbf; bf16_t* z;
  __device__ __forceinline__ void operator()(int row, int nt, int h, f32x16 (&acc)[4], char* smem) const {
    const int lane = opaque_tid() & 63, wave = opaque_tid() >> 6, r = lane & 31;
    char* st = smem + wave * 8704;
#pragma unroll
    for (int j = 0; j < 4; ++j)
#pragma unroll
      for (int g = 0; g < 4; ++g) {
        uint2 w;
        w.x = pack_bf16(acc[j][4 * g], acc[j][4 * g + 1]);
        w.y = pack_bf16(acc[j][4 * g + 2], acc[j][4 * g + 3]);
        *(uint2*)(st + r * 272 + (j * 32 + 8 * g + 4 * h) * 2) = w;
      }
    const int rbase = row - r;
#pragma unroll
    for (int it = 0; it < 8; ++it) {
      const int rl = it * 4 + (lane >> 4), ch = lane & 15;
      const u32x4 m = *(const u32x4*)(st + rl * 272 + ch * 16);
      const size_t off = (size_t)(rbase + rl) * D + nt * 128 + ch * 8;
      const u32x4 hv = *(const u32x4*)(hbf + off);
      u32x4 o;
#pragma unroll
      for (int q = 0; q < 4; ++q)
        o[q] = pack_bf16(ALPHA * __uint_as_float(hv[q] << 16) + __uint_as_float(m[q] << 16),
                         ALPHA * __uint_as_float(hv[q] & 0xffff0000u) + __uint_as_float(m[q] & 0xffff0000u));
      *(u32x4*)(z + off) = o;
    }
  }
};

struct EpiPlainF32M {
  float* C;
  __device__ __forceinline__ void operator()(int row, int nt, int h, f32x16 (&acc)[4], char* smem) const {
    const size_t base = (size_t)row * D + nt * 128 + 4 * h;
#pragma unroll
    for (int j = 0; j < 4; ++j)
#pragma unroll
      for (int g = 0; g < 4; ++g)
        *(float4*)(C + base + j * 32 + 8 * g) = make_float4(acc[j][4 * g], acc[j][4 * g + 1], acc[j][4 * g + 2], acc[j][4 * g + 3]);
  }
};


constexpr int NET16[63][2] = {{0,1}, {2,3}, {0,2}, {1,3}, {1,2}, {4,5}, {6,7}, {4,6}, {5,7}, {5,6}, {0,4}, {2,6}, {2,4}, {1,5}, {3,7}, {3,5}, {1,2}, {3,4}, {5,6}, {8,9}, {10,11}, {8,10}, {9,11}, {9,10}, {12,13}, {14,15}, {12,14}, {13,15}, {13,14}, {8,12}, {10,14}, {10,12}, {9,13}, {11,15}, {11,13}, {9,10}, {11,12}, {13,14}, {0,8}, {4,12}, {4,8}, {2,10}, {6,14}, {6,10}, {2,4}, {6,8}, {10,12}, {1,9}, {5,13}, {5,9}, {3,11}, {7,15}, {7,11}, {3,5}, {7,9}, {11,13}, {1,2}, {3,4}, {5,6}, {7,8}, {9,10}, {11,12}, {13,14}};
constexpr int CLEAN16[32][2] = {{0,8}, {1,9}, {2,10}, {3,11}, {4,12}, {5,13}, {6,14}, {7,15}, {0,4}, {1,5}, {2,6}, {3,7}, {8,12}, {9,13}, {10,14}, {11,15}, {0,2}, {1,3}, {4,6}, {5,7}, {8,10}, {9,11}, {12,14}, {13,15}, {0,1}, {2,3}, {4,5}, {6,7}, {8,9}, {10,11}, {12,13}, {14,15}};
constexpr int CAND_REST[34][2] = {{1,0}, {1,1}, {1,2}, {1,3}, {1,4}, {1,5}, {1,6}, {1,7}, {2,0}, {2,1}, {2,2}, {2,3}, {2,4}, {3,0}, {3,1}, {3,2}, {3,3}, {4,0}, {4,1}, {4,2}, {5,0}, {5,1}, {6,0}, {6,1}, {7,0}, {7,1}, {8,0}, {9,0}, {10,0}, {11,0}, {12,0}, {13,0}, {14,0}, {15,0}};
#define CE_DESC(a, b) { const int hi_ = max(a, b), lo_ = min(a, b); a = hi_; b = lo_; }
__device__ __forceinline__ void sort16_desc(int (&x)[16]) {
#pragma unroll
  for (int t = 0; t < 63; ++t) CE_DESC(x[NET16[t][0]], x[NET16[t][1]])
}
__device__ __forceinline__ void merge_top16(int (&a)[16], const int (&b)[16]) {
#pragma unroll
  for (int i = 0; i < 16; ++i) a[i] = max(a[i], b[15 - i]);
#pragma unroll
  for (int t = 0; t < 32; ++t) CE_DESC(a[CLEAN16[t][0]], a[CLEAN16[t][1]])
}
__device__ __forceinline__ int f2ord(float f) { const int b = __float_as_int(f); return b ^ ((b >> 31) & 0x7FFFFFFF); }
__device__ __forceinline__ float ord2f(int k) { return __int_as_float(k ^ ((k >> 31) & 0x7FFFFFFF)); }

struct EpiTopK {
  const bf16_t* subk;
  int* lidx; float* lgate;
  __device__ __forceinline__ void operator()(int row, int p, int h, f32x16 (&acc)[4], char* smem) const {
    const int lane = opaque_tid() & 63, wave = opaque_tid() >> 6, r = lane & 31;
    char* qw = smem + wave * 16384;
    int* sl = (int*)(smem + wave * 16384 + 8192);
#pragma unroll
    for (int j = 0; j < 4; ++j)
#pragma unroll
      for (int g = 0; g < 4; ++g) {
        uint2 w;
        w.x = pack_bf16(acc[j][4 * g], acc[j][4 * g + 1]);
        w.y = pack_bf16(acc[j][4 * g + 2], acc[j][4 * g + 3]);
        *(uint2*)(qw + r * 256 + (((4 * j + g) ^ (r & 15)) << 4) + 8 * h) = w;
      }
    int S[2][16];
#pragma unroll
    for (int c = 0; c < 2; ++c) {
      f32x16 sc[4];
#pragma unroll
      for (int mi = 0; mi < 4; ++mi)
#pragma unroll
        for (int e = 0; e < 16; ++e) sc[mi][e] = 0.f;
      const bf16_t* kb = subk + (size_t)((p * 2 + c) * 128 + r) * 64 + 8 * h;
#pragma unroll
      for (int ks = 0; ks < 4; ++ks) {
        const bf16x8 qf = *(const bf16x8*)(qw + r * 256 + (((8 * c + 2 * ks + h) ^ (r & 15)) << 4));
#pragma unroll
        for (int mi = 0; mi < 4; ++mi) {
          const bf16x8 kf = *(const bf16x8*)(kb + mi * 32 * 64 + ks * 16);
          sc[mi] = __builtin_amdgcn_mfma_f32_32x32x16_bf16(kf, qf, sc[mi], 0, 0, 0);
        }
      }
      int L[16];
#pragma unroll
      for (int mi = 0; mi < 4; ++mi) {
        int x[16];
#pragma unroll
        for (int e = 0; e < 16; ++e) x[e] = (f2ord(sc[mi][e]) & ~127) | (32 * mi + (e & 3) + 8 * (e >> 2) + 4 * h);
        sort16_desc(x);
        if (mi == 0) {
#pragma unroll
          for (int e = 0; e < 16; ++e) L[e] = x[e];
        } else merge_top16(L, x);
      }
      int Pn[16];
#pragma unroll
      for (int e = 0; e < 16; ++e) Pn[e] = __shfl_xor(L[e], 32);
      merge_top16(L, Pn);
#pragma unroll
      for (int e = 0; e < 16; ++e) { S[c][e] = L[e]; sl[(c * 16 + e) * 64 + lane] = L[e]; }
    }
    float f0[16], f1[16];
#pragma unroll
    for (int e = 0; e < 16; ++e) { f0[e] = ord2f(S[0][e]); f1[e] = ord2f(S[1][e]); }
    int T[16];
#pragma unroll
    for (int b = 0; b < 16; ++b) T[b] = (f2ord(f0[0] + f1[b]) & ~255) | (15 - b);
#pragma unroll
    for (int gi = 0; gi < 3; ++gi) {
      int x[16];
#pragma unroll
      for (int e = 0; e < 16; ++e) {
        const int ci = gi * 16 + e;
        if (ci < 34) x[e] = (f2ord(f0[CAND_REST[ci][0]] + f1[CAND_REST[ci][1]]) & ~255) | (CAND_REST[ci][0] << 4) | (15 - CAND_REST[ci][1]);
        else x[e] = (int)0x80000000;
      }
      sort16_desc(x);
      merge_top16(T, x);
    }
    float ev[16], den = 0.f;
    const float vmax = ord2f(T[0]);
#pragma unroll
    for (int k = 0; k < 16; ++k) { ev[k] = __expf(ord2f(T[k]) - vmax); den += ev[k]; }
    const float inv = 1.0f / den;
    int eo[16];
#pragma unroll
    for (int k = 0; k < 16; ++k) {
      const int ab = T[k] & 255;
      const int i1 = sl[(ab >> 4) * 64 + lane] & 127, i2 = sl[(16 + 15 - (ab & 15)) * 64 + lane] & 127;
      eo[k] = i1 * 128 + i2;
    }
    if (h == 0) {
      int* lp = lidx + (size_t)row * 128 + p * 16;
      float* gp = lgate + (size_t)row * 128 + p * 16;
#pragma unroll
      for (int q = 0; q < 4; ++q) {
        *(int4*)(lp + 4 * q) = make_int4(eo[4 * q], eo[4 * q + 1], eo[4 * q + 2], eo[4 * q + 3]);
        *(float4*)(gp + 4 * q) = make_float4(ev[4 * q] * inv, ev[4 * q + 1] * inv, ev[4 * q + 2] * inv, ev[4 * q + 3] * inv);
      }
    }
  }
};

__device__ __forceinline__ void transpose_tile(int kt, int ntile, char* smem, const float* __restrict__ W, int N, int K, bf16_t* __restrict__ Wt) {
  float (*T)[65] = (float (*)[65])smem;
  const int t = opaque_tid();
  __syncthreads();
#pragma unroll
  for (int pss = 0; pss < 4; ++pss) {
    const int kk = pss * 16 + (t >> 4), nn = (t & 15) * 4;
    const float4 v = *(const float4*)(W + (size_t)(kt * 64 + kk) * N + ntile * 64 + nn);
    T[kk][nn] = v.x; T[kk][nn + 1] = v.y; T[kk][nn + 2] = v.z; T[kk][nn + 3] = v.w;
  }
  __syncthreads();
#pragma unroll
  for (int pss = 0; pss < 4; ++pss) {
    const int nn = pss * 16 + (t >> 4), kk = (t & 15) * 4;
    uint2 w;
    w.x = pack_bf16(T[kk][nn], T[kk + 1][nn]);
    w.y = pack_bf16(T[kk + 2][nn], T[kk + 3][nn]);
    *(uint2*)(Wt + (size_t)(ntile * 64 + nn) * K + kt * 64 + kk) = w;
  }
}


__device__ __forceinline__ float wave_max(float v) {
  v = fmaxf(v, lane_xor_f<1>(v)); v = fmaxf(v, lane_xor_f<2>(v)); v = fmaxf(v, lane_xor_f<4>(v));
  v = fmaxf(v, lane_xor_f<8>(v)); v = fmaxf(v, lane_xor_f<16>(v)); v = fmaxf(v, lane_xor_f<32>(v));
  return v;
}

__device__ __forceinline__ float quant_row_regs(const float4 (&v)[4], int lane, uint8_t* __restrict__ dst, bool biased) {
  float m = 0.f;
#pragma unroll
  for (int i = 0; i < 4; ++i) m = fmaxf(m, fmaxf(fmaxf(fabsf(v[i].x), fabsf(v[i].y)), fmaxf(fabsf(v[i].z), fabsf(v[i].w))));
  m = wave_max(m);
  const float scale = m * (1.0f / 127.0f);
  const float inv = m > 0.f ? 127.0f / m : 0.f;
  u32x4 w;
#pragma unroll
  for (int i = 0; i < 4; ++i) {
    int a = (int)rintf(v[i].x * inv), b = (int)rintf(v[i].y * inv), c = (int)rintf(v[i].z * inv), d = (int)rintf(v[i].w * inv);
    if (biased) { a += 128; b += 128; c += 128; d += 128; }
    w[i] = (uint32_t)(a & 255) | ((uint32_t)(b & 255) << 8) | ((uint32_t)(c & 255) << 16) | ((uint32_t)(d & 255) << 24);
  }
  *(u32x4*)(dst + lane * 16) = w;
  return scale;
}

__device__ __forceinline__ void quant_table_row(const float* __restrict__ src, int lane, uint8_t* __restrict__ dst, float* __restrict__ sc, bool biased) {
  float4 v[4];
#pragma unroll
  for (int i = 0; i < 4; ++i) v[i] = *(const float4*)(src + 256 * i + 4 * lane);
  const float scale = quant_row_regs(v, lane, dst, biased);
  if (lane == 0) *sc = scale;
}


template <int NR>
__device__ __forceinline__ void ln_in_rows(const int (&rows)[NR], int lane, const float* __restrict__ xp, const float* __restrict__ xs,
                                           const float* __restrict__ meta, const float* __restrict__ g, const float* __restrict__ b,
                                           bf16_t* __restrict__ hbf) {
  float4 v[NR][4];
#pragma unroll
  for (int n = 0; n < NR; ++n) {
    const int r = rows[n];
    const float* src = r < NPROMPT ? xp + (size_t)r * D : (r < NTOK ? xs + (size_t)(r - NPROMPT) * D : meta + (size_t)(r - NTOK) * D);
#pragma unroll
    for (int i = 0; i < 4; ++i) v[n][i] = *(const float4*)(src + 256 * i + 4 * lane);
  }
  float4 gg[4], bb[4];
#pragma unroll
  for (int i = 0; i < 4; ++i) { gg[i] = *(const float4*)(g + 256 * i + 4 * lane); bb[i] = *(const float4*)(b + 256 * i + 4 * lane); }
#pragma unroll
  for (int n = 0; n < NR; ++n) {
    float sum = 0.f;
#pragma unroll
    for (int i = 0; i < 4; ++i) sum += (v[n][i].x + v[n][i].y) + (v[n][i].z + v[n][i].w);
    const float mean = wave_sum(sum) * (1.0f / D);
    float sq = 0.f;
#pragma unroll
    for (int i = 0; i < 4; ++i) { v[n][i].x -= mean; v[n][i].y -= mean; v[n][i].z -= mean; v[n][i].w -= mean; sq += (v[n][i].x * v[n][i].x + v[n][i].y * v[n][i].y) + (v[n][i].z * v[n][i].z + v[n][i].w * v[n][i].w); }
    const float rstd = rsqrtf(wave_sum(sq) * (1.0f / D) + LN_EPS);
#pragma unroll
    for (int i = 0; i < 4; ++i) {
      uint2 w;
      w.x = pack_bf16(v[n][i].x * rstd * gg[i].x + bb[i].x, v[n][i].y * rstd * gg[i].y + bb[i].y);
      w.y = pack_bf16(v[n][i].z * rstd * gg[i].z + bb[i].z, v[n][i].w * rstd * gg[i].w + bb[i].w);
      *(uint2*)(hbf + (size_t)rows[n] * D + 256 * i + 4 * lane) = w;
    }
  }
}
template <int NR>
__device__ __forceinline__ void ln1_rows(const int (&rows)[NR], int lane, const bf16_t* __restrict__ z, const float* __restrict__ g,
                                         const float* __restrict__ b, bf16_t* __restrict__ h1bf, uint8_t* __restrict__ xq, float* __restrict__ xs) {
  uint2 zz[NR][4];
#pragma unroll
  for (int n = 0; n < NR; ++n)
#pragma unroll
    for (int i = 0; i < 4; ++i) zz[n][i] = *(const uint2*)(z + (size_t)rows[n] * D + 256 * i + 4 * lane);
  float4 gg[4], bb[4];
#pragma unroll
  for (int i = 0; i < 4; ++i) { gg[i] = *(const float4*)(g + 256 * i + 4 * lane); bb[i] = *(const float4*)(b + 256 * i + 4 * lane); }
#pragma unroll
  for (int n = 0; n < NR; ++n) {
    float4 v[4];
    float sum = 0.f;
#pragma unroll
    for (int i = 0; i < 4; ++i) {
      v[i].x = __uint_as_float(zz[n][i].x << 16); v[i].y = __uint_as_float(zz[n][i].x & 0xffff0000u);
      v[i].z = __uint_as_float(zz[n][i].y << 16); v[i].w = __uint_as_float(zz[n][i].y & 0xffff0000u);
      sum += (v[i].x + v[i].y) + (v[i].z + v[i].w);
    }
    const float mean = wave_sum(sum) * (1.0f / D);
    float sq = 0.f;
#pragma unroll
    for (int i = 0; i < 4; ++i) { v[i].x -= mean; v[i].y -= mean; v[i].z -= mean; v[i].w -= mean; sq += (v[i].x * v[i].x + v[i].y * v[i].y) + (v[i].z * v[i].z + v[i].w * v[i].w); }
    const float rstd = rsqrtf(wave_sum(sq) * (1.0f / D) + LN_EPS);
#pragma unroll
    for (int i = 0; i < 4; ++i) {
      v[i].x = v[i].x * rstd * gg[i].x + bb[i].x; v[i].y = v[i].y * rstd * gg[i].y + bb[i].y; v[i].z = v[i].z * rstd * gg[i].z + bb[i].z; v[i].w = v[i].w * rstd * gg[i].w + bb[i].w;
      uint2 w;
      w.x = pack_bf16(v[i].x, v[i].y); w.y = pack_bf16(v[i].z, v[i].w);
      *(uint2*)(h1bf + (size_t)rows[n] * D + 256 * i + 4 * lane) = w;
    }
    const float scale = quant_row_regs(v, lane, xq + (size_t)rows[n] * 1024, false);
    if (lane == 0) xs[rows[n]] = scale;
  }
}

struct SweepArgs {
  const int* lidx; const float* lgate; const uint8_t* U8; const uint8_t* V8; const float* su; const float* sv;
  const uint8_t* xq; const float* xs; const bf16_t* h1; const float* g2; const float* b2; float* y;
};

#ifndef SG_CACHE
#define SG_CACHE ""
#endif
#define SG_KMAX 256
#define SG_K0 192
#define SG_LDS_PER_WAVE (4 * SG_KMAX * 16)
static_assert(SG_KMAX % 16 == 0 && 4 * SG_LDS_PER_WAVE <= 73728, "schedule ring: bubble init covers 16 slots per pass; 4 waves must fit the LDS buffer");

template <int CTRL> __device__ __forceinline__ int dpp_mov_i(int x) { return __builtin_amdgcn_mov_dpp(x, CTRL, 0xF, 0xF, true); }
__device__ __forceinline__ int row_sum_i(int v) {
  v += dpp_mov_i<0x128>(v); v += dpp_mov_i<0x124>(v); v += dpp_mov_i<0x122>(v); v += dpp_mov_i<0x121>(v);
  return v;
}
__device__ __forceinline__ float row_sum_f(float v) {
  v += __int_as_float(dpp_mov_i<0x128>(__float_as_int(v))); v += __int_as_float(dpp_mov_i<0x124>(__float_as_int(v)));
  v += __int_as_float(dpp_mov_i<0x122>(__float_as_int(v))); v += __int_as_float(dpp_mov_i<0x121>(__float_as_int(v)));
  return v;
}
__device__ __forceinline__ int row_xor_i(int x, int m) {
  return m == 1 ? lane_xor_i<1>(x) : (m == 2 ? lane_xor_i<2>(x) : (m == 4 ? lane_xor_i<4>(x) : lane_xor_i<8>(x)));
}

typedef _Float16 h16x2 __attribute__((ext_vector_type(2)));
template <int KP> __device__ __forceinline__ h16x2 ub_pair_f16(uint32_t d) {
  const uint32_t bits = __builtin_amdgcn_perm(0x64646464u, d, (4u << 24) | ((unsigned)(2 * KP + 1) << 16) | (4u << 8) | (unsigned)(2 * KP));
  h16x2 r;
  __builtin_memcpy(&r, &bits, 4);
  return r;
}
__device__ __forceinline__ float sg_fmix_lo(float acc, float w, uint32_t p) { asm("v_fma_mix_f32 %0, %1, %2, %0 op_sel:[0,0,0] op_sel_hi:[0,1,0]" : "+v"(acc) : "v"(w), "v"(p)); return acc; }
__device__ __forceinline__ float sg_fmix_hi(float acc, float w, uint32_t p) { asm("v_fma_mix_f32 %0, %1, %2, %0 op_sel:[0,1,0] op_sel_hi:[0,1,0]" : "+v"(acc) : "v"(w), "v"(p)); return acc; }
template <int KP> __device__ __forceinline__ uint32_t ub_pair_bits(uint32_t d) {
  return __builtin_amdgcn_perm(0x64646464u, d, (4u << 24) | ((unsigned)(2 * KP + 1) << 16) | (4u << 8) | (unsigned)(2 * KP));
}
struct SgBuf { u32x4 u[4]; u32x4 v[4]; };

template <int OFF> __device__ __forceinline__ void asm_bload(u32x4& dst, int voff, const u32x4& rs) {
  asm volatile("buffer_load_dwordx4 %0, %1, %2, 0 offen offset:%3 " SG_CACHE : "+v"(dst) : "v"(voff), "s"(rs), "n"(OFF));
}
__device__ __forceinline__ void sg_issue(const u32x4& ent, int c16, const u32x4& rsU, const u32x4& rsV, SgBuf& b) {
  const int off = (int)ent[0] * 2048 + c16;
  asm_bload<0>(b.u[0], off, rsU); asm_bload<256>(b.u[1], off, rsU); asm_bload<512>(b.u[2], off, rsU); asm_bload<768>(b.u[3], off, rsU);
  asm_bload<0>(b.v[0], off, rsV); asm_bload<256>(b.v[1], off, rsV); asm_bload<512>(b.v[2], off, rsV); asm_bload<768>(b.v[3], off, rsV);
}

template <int VAR>
__device__ __forceinline__ void sg_half(u32x4& ent, const u32x4& entN, SgBuf& b, const u32x4 (&x)[4], f32x16 (&acc)[4], float& corr,
                                        int c16, const u32x4& rsU, const u32x4& rsV) {
  if (VAR != 2) asm volatile("s_waitcnt vmcnt(12)" : "+v"(b.u[0]), "+v"(b.u[1]), "+v"(b.u[2]), "+v"(b.u[3]));
  int d0 = 0, d1 = 0, d2 = 0, d3 = 0;
#pragma unroll
  for (int q = 0; q < 4; ++q) {
    d0 = __builtin_amdgcn_sdot4((int)b.u[0][q], (int)x[0][q], d0, false);
    d1 = __builtin_amdgcn_sdot4((int)b.u[1][q], (int)x[1][q], d1, false);
    d2 = __builtin_amdgcn_sdot4((int)b.u[2][q], (int)x[2][q], d2, false);
    d3 = __builtin_amdgcn_sdot4((int)b.u[3][q], (int)x[3][q], d3, false);
  }
  int dd = (d0 + d1) + (d2 + d3);
  asm volatile("" : "+v"(dd));
  const int offN = (int)entN[0] * 2048 + c16;
  if (VAR != 2) { asm_bload<0>(b.u[0], offN, rsU); asm_bload<256>(b.u[1], offN, rsU); asm_bload<512>(b.u[2], offN, rsU); asm_bload<768>(b.u[3], offN, rsU); }
  else asm volatile("" : "+v"(b.u[0]), "+v"(b.u[1]), "+v"(b.u[2]), "+v"(b.u[3]) : "v"(offN));
  dd = row_sum_i(dd);
  const float pre = (float)dd * __uint_as_float(ent[1]);
  const float uu = 1.5957691216057308f * (pre + 0.044715f * pre * pre * pre);
  const float act = pre * __builtin_amdgcn_rcpf(1.0f + __expf(-uu));
  const float w = act * __uint_as_float(ent[2]);
#define SG_VPIECE(I, OFFB)                                                                   \
  {                                                                                          \
    if (VAR != 2) asm volatile("s_waitcnt vmcnt(15)" : "+v"(b.v[I]));                        \
    if (VAR != 1) _Pragma("unroll") for (int q = 0; q < 4; ++q) {                            \
      const uint32_t d = b.v[I][q];                                                          \
      const uint32_t p0 = ub_pair_bits<0>(d), p1 = ub_pair_bits<1>(d);                       \
      acc[I][4 * q + 0] = sg_fmix_lo(acc[I][4 * q + 0], w, p0);                              \
      acc[I][4 * q + 1] = sg_fmix_hi(acc[I][4 * q + 1], w, p0);                              \
      acc[I][4 * q + 2] = sg_fmix_lo(acc[I][4 * q + 2], w, p1);                              \
      acc[I][4 * q + 3] = sg_fmix_hi(acc[I][4 * q + 3], w, p1);                              \
    }                                                                                        \
    asm volatile("" : "+v"(acc[I]));                                                         \
    if (VAR != 2) asm_bload<OFFB>(b.v[I], offN, rsV);                                        \
    else asm volatile("" : "+v"(b.v[I]));                                                    \
  }
  SG_VPIECE(0, 0) SG_VPIECE(1, 256) SG_VPIECE(2, 512) SG_VPIECE(3, 768)
#undef SG_VPIECE
  corr += w;
  asm volatile("" : "+v"(corr));
  ent = entN;
}

template <bool NOSTORE>
__device__ __forceinline__ void sweep_groups(int tokbase, int lane, char* lds, const SweepArgs& a, int rot = 0, unsigned long long t0 = 0ull, int dticks = 0) {
#if defined(PROBE_CUT) && PROBE_CUT == 0
  if (NOSTORE) return;
#endif
  const int g = lane >> 4, c = lane & 15, c16 = c * 16;
  const int tok = tokbase + g;
  u32x4* sched = (u32x4*)lds + g * SG_KMAX;
  int K[8];
  {
    const int4 e0 = *(const int4*)(a.lidx + (size_t)tok * 128 + c * 8), e1 = *(const int4*)(a.lidx + (size_t)tok * 128 + c * 8 + 4);
    K[0] = (((e0.x - rot) & 16383) << 7) | (c * 8 + 0); K[1] = (((e0.y - rot) & 16383) << 7) | (c * 8 + 1);
    K[2] = (((e0.z - rot) & 16383) << 7) | (c * 8 + 2); K[3] = (((e0.w - rot) & 16383) << 7) | (c * 8 + 3);
    K[4] = (((e1.x - rot) & 16383) << 7) | (c * 8 + 4); K[5] = (((e1.y - rot) & 16383) << 7) | (c * 8 + 5);
    K[6] = (((e1.z - rot) & 16383) << 7) | (c * 8 + 6); K[7] = (((e1.w - rot) & 16383) << 7) | (c * 8 + 7);
  }
#pragma unroll
  for (int k = 2; k <= 128; k <<= 1) {
#pragma unroll
    for (int j = k >> 1; j > 0; j >>= 1) {
      if (j >= 8) {
        const int lj = j >> 3;
        const bool upper = (c & lj) != 0;
        const bool desc = (k < 128) && ((c & (k >> 3)) != 0);
        const bool keepmax = upper != desc;
#pragma unroll
        for (int r = 0; r < 8; ++r) {
          const int o = row_xor_i(K[r], lj);
          const int mn = min(K[r], o), mx = max(K[r], o);
          K[r] = keepmax ? mx : mn;
        }
      } else {
#pragma unroll
        for (int r = 0; r < 8; ++r) {
          if ((r & j) == 0) {
            const int pp = r | j;
            const int mn = min(K[r], K[pp]), mx = max(K[r], K[pp]);
            if (k >= 8) {
              const bool desc = (k < 128) && ((c & (k >> 3)) != 0);
              K[r] = desc ? mx : mn; K[pp] = desc ? mn : mx;
            } else {
              const bool desc = (r & k) != 0;
              K[r] = desc ? mx : mn; K[pp] = desc ? mn : mx;
            }
          }
        }
      }
    }
  }
#if defined(PROBE_CUT) && PROBE_CUT == 1
  if (NOSTORE) { asm volatile("" :: "v"(K[0]), "v"(K[1]), "v"(K[2]), "v"(K[3]), "v"(K[4]), "v"(K[5]), "v"(K[6]), "v"(K[7])); return; }
#endif
  int tt[8];
  {
    int av[8], fw[8], bw[8];
    int run = -100000;
#pragma unroll
    for (int r = 0; r < 8; ++r) {
      av[r] = (((K[r] >> 7) * SG_K0) >> 14) - (c * 8 + r);
      run = max(run, av[r]);
      fw[r] = run;
    }
    int sc = run;
    sc = max(sc, __builtin_amdgcn_update_dpp(-100000, sc, 0x111, 0xF, 0xF, false));
    sc = max(sc, __builtin_amdgcn_update_dpp(-100000, sc, 0x112, 0xF, 0xF, false));
    sc = max(sc, __builtin_amdgcn_update_dpp(-100000, sc, 0x114, 0xF, 0xF, false));
    sc = max(sc, __builtin_amdgcn_update_dpp(-100000, sc, 0x118, 0xF, 0xF, false));
    const int exclF = __builtin_amdgcn_update_dpp(-100000, sc, 0x111, 0xF, 0xF, false);
    int rmin = 100000;
#pragma unroll
    for (int r = 7; r >= 0; --r) { rmin = min(rmin, av[r]); bw[r] = rmin; }
    int sb = rmin;
    sb = min(sb, __builtin_amdgcn_update_dpp(100000, sb, 0x101, 0xF, 0xF, false));
    sb = min(sb, __builtin_amdgcn_update_dpp(100000, sb, 0x102, 0xF, 0xF, false));
    sb = min(sb, __builtin_amdgcn_update_dpp(100000, sb, 0x104, 0xF, 0xF, false));
    sb = min(sb, __builtin_amdgcn_update_dpp(100000, sb, 0x108, 0xF, 0xF, false));
    const int exclB = __builtin_amdgcn_update_dpp(100000, sb, 0x101, 0xF, 0xF, false);
#pragma unroll
    for (int r = 0; r < 8; ++r) tt[r] = c * 8 + r + ((max(fw[r], exclF) + min(bw[r], exclB)) >> 1);
    const int t0g = __builtin_amdgcn_readlane(tt[0], 0), t1g = __builtin_amdgcn_readlane(tt[0], 16), t2g = __builtin_amdgcn_readlane(tt[0], 32), t3g = __builtin_amdgcn_readlane(tt[0], 48);
    const int tg = g == 0 ? t0g : (g == 1 ? t1g : (g == 2 ? t2g : t3g));
    const int sh = tg < 0 ? -tg : 0;
#pragma unroll
    for (int r = 0; r < 8; ++r) tt[r] += sh;
  }
  int Kw = max(max(__builtin_amdgcn_readlane(tt[7], 15), __builtin_amdgcn_readlane(tt[7], 31)),
               max(__builtin_amdgcn_readlane(tt[7], 47), __builtin_amdgcn_readlane(tt[7], 63))) + 1;
  if (Kw > SG_KMAX) {
#pragma unroll
    for (int r = 0; r < 8; ++r) tt[r] = c * 8 + r;
    Kw = 128;
  }
  Kw = (Kw + 1) & ~1;
  {
#pragma unroll
    for (int q = 0; q < SG_KMAX / 16; ++q) {
      const int t = c + 16 * q;
      u32x4 bub; bub[0] = 0u; bub[1] = 0; bub[2] = 0; bub[3] = 0;
      sched[t] = bub;
    }
    const float xsc = a.xs[tok];
#pragma unroll
    for (int r = 0; r < 8; ++r) {
      const int e = ((K[r] >> 7) + rot) & 16383, jp = K[r] & 127;
      u32x4 ent;
#ifdef PROBE_EMASK
      ent[0] = NOSTORE ? ((uint32_t)e & PROBE_EMASK) : (uint32_t)e;
#else
      ent[0] = (uint32_t)e;
#endif
      ent[1] = __float_as_uint(a.su[e] * xsc);
      ent[2] = __float_as_uint(a.lgate[(size_t)tok * 128 + jp] * a.sv[e]);
      ent[3] = 0;
      sched[tt[r]] = ent;
    }
  }
#if defined(PROBE_CUT) && PROBE_CUT == 2
  if (NOSTORE) return;
#endif
  u32x4 x[4];
#pragma unroll
  for (int i = 0; i < 4; ++i) x[i] = *(const u32x4*)(a.xq + (size_t)tok * 1024 + 256 * i + c16);
  f32x16 acc[4];
#pragma unroll
  for (int i = 0; i < 4; ++i)
#pragma unroll
    for (int e = 0; e < 16; ++e) acc[i][e] = 0.f;
  float corr = 0.f;
  u32x4 rsU, rsV;
  {
    const uint64_t pu = (uint64_t)a.U8, pv = (uint64_t)a.V8;
    rsU[0] = (uint32_t)__builtin_amdgcn_readfirstlane((int)(uint32_t)pu); rsU[1] = (uint32_t)__builtin_amdgcn_readfirstlane((int)(uint32_t)(pu >> 32)) & 0xffffu;
    rsU[2] = 16384u * 2048u; rsU[3] = 0x00020000u;
    rsV[0] = (uint32_t)__builtin_amdgcn_readfirstlane((int)(uint32_t)pv); rsV[1] = (uint32_t)__builtin_amdgcn_readfirstlane((int)(uint32_t)(pv >> 32)) & 0xffffu;
    rsV[2] = 16384u * 2048u - 1024u; rsV[3] = 0x00020000u;
  }
  SgBuf bA, bB;
#pragma unroll
  for (int i = 0; i < 4; ++i) { bA.u[i] = make_u32x4_zero(); bA.v[i] = make_u32x4_zero(); bB.u[i] = make_u32x4_zero(); bB.v[i] = make_u32x4_zero(); }
  asm volatile("s_waitcnt vmcnt(0)" ::: "memory");
  u32x4 entA = sched[0], entB = sched[1];
  sg_issue(entA, c16, rsU, rsV, bA);
  sg_issue(entB, c16, rsU, rsV, bB);
#ifdef PROBE_SG_NOLOOP
  if (NOSTORE) Kw = 0;
#endif
#ifdef PROBE_LOOPVAR
  constexpr int LV = NOSTORE ? PROBE_LOOPVAR : 0;
#else
  constexpr int LV = 0;
#endif
  for (int k = 0; k < Kw; k += 2) {
    if (dticks > 0 && (k & 15) == 0) {
      const unsigned long long target = t0 + (unsigned long long)(k * dticks);
      while (__builtin_amdgcn_s_memrealtime() < target) __builtin_amdgcn_s_sleep(2);
    }
    const u32x4 nA = sched[(k + 2 < Kw) ? k + 2 : 0];
    const u32x4 nB = sched[(k + 3 < Kw) ? k + 3 : 0];
    sg_half<LV>(entA, nA, bA, x, acc, corr, c16, rsU, rsV);
    __builtin_amdgcn_sched_barrier(0);
    sg_half<LV>(entB, nB, bB, x, acc, corr, c16, rsU, rsV);
    __builtin_amdgcn_sched_barrier(0);
  }
  asm volatile("s_waitcnt vmcnt(0)" : "+v"(bA.u[0]), "+v"(bA.u[1]), "+v"(bA.u[2]), "+v"(bA.u[3]), "+v"(bA.v[0]), "+v"(bA.v[1]), "+v"(bA.v[2]), "+v"(bA.v[3]));
  asm volatile("" : "+v"(bB.u[0]), "+v"(bB.u[1]), "+v"(bB.u[2]), "+v"(bB.u[3]), "+v"(bB.v[0]), "+v"(bB.v[1]), "+v"(bB.v[2]), "+v"(bB.v[3]));
#if defined(PROBE_CUT) && PROBE_CUT == 3
  if (NOSTORE) { asm volatile("" :: "v"(acc[0]), "v"(acc[1]), "v"(acc[2]), "v"(acc[3]), "v"(corr)); return; }
#endif
  const float c128 = 1152.0f * corr;
  float sum = 0.f;
#pragma unroll
  for (int i = 0; i < 4; ++i)
#pragma unroll
    for (int q = 0; q < 4; ++q) {
      const uint2 hb = *(const uint2*)(a.h1 + (size_t)tok * D + 256 * q + 4 * (16 * i + c));
      const float4 hh = make_float4(__uint_as_float(hb.x << 16), __uint_as_float(hb.x & 0xffff0000u), __uint_as_float(hb.y << 16), __uint_as_float(hb.y & 0xffff0000u));
      acc[i][4 * q + 0] = ALPHA * hh.x + (acc[i][4 * q + 0] - c128);
      acc[i][4 * q + 1] = ALPHA * hh.y + (acc[i][4 * q + 1] - c128);
      acc[i][4 * q + 2] = ALPHA * hh.z + (acc[i][4 * q + 2] - c128);
      acc[i][4 * q + 3] = ALPHA * hh.w + (acc[i][4 * q + 3] - c128);
      sum += (acc[i][4 * q + 0] + acc[i][4 * q + 1]) + (acc[i][4 * q + 2] + acc[i][4 * q + 3]);
    }
  const float mean = row_sum_f(sum) * (1.0f / D);
  float sq = 0.f;
#pragma unroll
  for (int i = 0; i < 4; ++i)
#pragma unroll
    for (int e = 0; e < 16; ++e) { acc[i][e] -= mean; sq += acc[i][e] * acc[i][e]; }
  const float rstd = rsqrtf(row_sum_f(sq) * (1.0f / D) + LN_EPS);
#pragma unroll
  for (int i = 0; i < 4; ++i)
#pragma unroll
    for (int q = 0; q < 4; ++q) {
      const int col = 256 * q + 4 * (16 * i + c);
      const float4 gg = *(const float4*)(a.g2 + col), bb = *(const float4*)(a.b2 + col);
      float4 o;
      o.x = acc[i][4 * q + 0] * rstd * gg.x + bb.x;
      o.y = acc[i][4 * q + 1] * rstd * gg.y + bb.y;
      o.z = acc[i][4 * q + 2] * rstd * gg.z + bb.z;
      o.w = acc[i][4 * q + 3] * rstd * gg.w + bb.w;
      if (!NOSTORE) *(float4*)(a.y + (size_t)tok * D + col) = o;
      else asm volatile("" :: "v"(o.x), "v"(o.y), "v"(o.z), "v"(o.w));
    }
}


__device__ __forceinline__ void sweep_mini(int tok, int lane, int wave, char* smem, const SweepArgs& a) {
  const int g = lane >> 4, c = lane & 15, c16 = c * 16, gi = wave * 4 + g;
  u32x4* sched = (u32x4*)(smem + wave * SG_LDS_PER_WAVE) + g * SG_KMAX;
  __syncthreads();
  if (c < 8) {
    const int jp = gi * 8 + c;
    const int e = a.lidx[(size_t)tok * 128 + jp];
    u32x4 ent;
    ent[0] = (uint32_t)e;
    ent[1] = __float_as_uint(a.su[e] * a.xs[tok]);
    ent[2] = __float_as_uint(a.lgate[(size_t)tok * 128 + jp] * a.sv[e]);
    ent[3] = 0;
    sched[c] = ent;
  }
  u32x4 x[4];
#pragma unroll
  for (int i = 0; i < 4; ++i) x[i] = *(const u32x4*)(a.xq + (size_t)tok * 1024 + 256 * i + c16);
  f32x16 acc[4];
#pragma unroll
  for (int i = 0; i < 4; ++i)
#pragma unroll
    for (int e = 0; e < 16; ++e) acc[i][e] = 0.f;
  float corr = 0.f;
  u32x4 rsU, rsV;
  {
    const uint64_t pu = (uint64_t)a.U8, pv = (uint64_t)a.V8;
    rsU[0] = (uint32_t)__builtin_amdgcn_readfirstlane((int)(uint32_t)pu); rsU[1] = (uint32_t)__builtin_amdgcn_readfirstlane((int)(uint32_t)(pu >> 32)) & 0xffffu;
    rsU[2] = 16384u * 2048u; rsU[3] = 0x00020000u;
    rsV[0] = (uint32_t)__builtin_amdgcn_readfirstlane((int)(uint32_t)pv); rsV[1] = (uint32_t)__builtin_amdgcn_readfirstlane((int)(uint32_t)(pv >> 32)) & 0xffffu;
    rsV[2] = 16384u * 2048u - 1024u; rsV[3] = 0x00020000u;
  }
  SgBuf bA, bB;
#pragma unroll
  for (int i = 0; i < 4; ++i) { bA.u[i] = make_u32x4_zero(); bA.v[i] = make_u32x4_zero(); bB.u[i] = make_u32x4_zero(); bB.v[i] = make_u32x4_zero(); }
  asm volatile("s_waitcnt vmcnt(0)" ::: "memory");
  u32x4 entA = sched[0], entB = sched[1];
  sg_issue(entA, c16, rsU, rsV, bA);
  sg_issue(entB, c16, rsU, rsV, bB);
#pragma unroll 1
  for (int k = 0; k < 8; k += 2) {
    const u32x4 nA = sched[(k + 2 < 8) ? k + 2 : 0];
    const u32x4 nB = sched[(k + 3 < 8) ? k + 3 : 0];
    sg_half<0>(entA, nA, bA, x, acc, corr, c16, rsU, rsV);
    __builtin_amdgcn_sched_barrier(0);
    sg_half<0>(entB, nB, bB, x, acc, corr, c16, rsU, rsV);
    __builtin_amdgcn_sched_barrier(0);
  }
  asm volatile("s_waitcnt vmcnt(0)" : "+v"(bA.u[0]), "+v"(bA.u[1]), "+v"(bA.u[2]), "+v"(bA.u[3]), "+v"(bA.v[0]), "+v"(bA.v[1]), "+v"(bA.v[2]), "+v"(bA.v[3]));
  asm volatile("" : "+v"(bB.u[0]), "+v"(bB.u[1]), "+v"(bB.u[2]), "+v"(bB.u[3]), "+v"(bB.v[0]), "+v"(bB.v[1]), "+v"(bB.v[2]), "+v"(bB.v[3]));
#pragma unroll
  for (int i = 0; i < 4; ++i)
#pragma unroll
    for (int e = 0; e < 16; ++e) { float v = acc[i][e]; v += lane_xor_f<16>(v); v += lane_xor_f<32>(v); acc[i][e] = v; }
  corr += lane_xor_f<16>(corr); corr += lane_xor_f<32>(corr);
  __syncthreads();
  float* part = (float*)smem;
  if (lane < 16) {
#pragma unroll
    for (int i = 0; i < 4; ++i)
#pragma unroll
      for (int e = 0; e < 16; ++e) part[(wave * 16 + c) * 65 + 16 * i + e] = acc[i][e];
    part[(wave * 16 + c) * 65 + 64] = corr;
  }
  __syncthreads();
  if (wave == 0) {
#pragma unroll
    for (int w2 = 1; w2 < 4; ++w2) {
#pragma unroll
      for (int i = 0; i < 4; ++i)
#pragma unroll
        for (int e = 0; e < 16; ++e) acc[i][e] += part[(w2 * 16 + c) * 65 + 16 * i + e];
      corr += part[(w2 * 16 + c) * 65 + 64];
    }
    const float c128 = 1152.0f * corr;
    float sum = 0.f;
#pragma unroll
    for (int i = 0; i < 4; ++i)
#pragma unroll
      for (int q = 0; q < 4; ++q) {
        const uint2 hb = *(const uint2*)(a.h1 + (size_t)tok * D + 256 * q + 4 * (16 * i + c));
        const float4 hh = make_float4(__uint_as_float(hb.x << 16), __uint_as_float(hb.x & 0xffff0000u), __uint_as_float(hb.y << 16), __uint_as_float(hb.y & 0xffff0000u));
        acc[i][4 * q + 0] = ALPHA * hh.x + (acc[i][4 * q + 0] - c128);
        acc[i][4 * q + 1] = ALPHA * hh.y + (acc[i][4 * q + 1] - c128);
        acc[i][4 * q + 2] = ALPHA * hh.z + (acc[i][4 * q + 2] - c128);
        acc[i][4 * q + 3] = ALPHA * hh.w + (acc[i][4 * q + 3] - c128);
        sum += (acc[i][4 * q + 0] + acc[i][4 * q + 1]) + (acc[i][4 * q + 2] + acc[i][4 * q + 3]);
      }
    const float mean = row_sum_f(sum) * (1.0f / D);
    float sq = 0.f;
#pragma unroll
    for (int i = 0; i < 4; ++i)
#pragma unroll
      for (int e = 0; e < 16; ++e) { acc[i][e] -= mean; sq += acc[i][e] * acc[i][e]; }
    const float rstd = rsqrtf(row_sum_f(sq) * (1.0f / D) + LN_EPS);
    if (lane < 16) {
#pragma unroll
      for (int i = 0; i < 4; ++i)
#pragma unroll
        for (int q = 0; q < 4; ++q) {
          const int col = 256 * q + 4 * (16 * i + c);
          const float4 gg = *(const float4*)(a.g2 + col), bb = *(const float4*)(a.b2 + col);
          float4 o;
          o.x = acc[i][4 * q + 0] * rstd * gg.x + bb.x;
          o.y = acc[i][4 * q + 1] * rstd * gg.y + bb.y;
          o.z = acc[i][4 * q + 2] * rstd * gg.z + bb.z;
          o.w = acc[i][4 * q + 3] * rstd * gg.w + bb.w;
          *(float4*)(a.y + (size_t)tok * D + col) = o;
        }
    }
  }
}

__device__ __forceinline__ int unit_row0(int u) { return u < 256 ? (u >> 5) * SEQ + (u & 31) * 64 : NPROMPT + (u - 256) * 64; }

__device__ __forceinline__ void stage_T(char* dst, const bf16_t* __restrict__ src, const float* dec) {
  const int t = opaque_tid(), lane = t & 63, wave = t >> 6, tp = lane & 31;
#pragma unroll
  for (int item = 0; item < 2; ++item) {
    const int fc = (lane >> 5) + 2 * wave + 8 * item;
    const u32x4 a = *(const u32x4*)(src + (size_t)(2 * tp) * PW + fc * 8);
    const u32x4 b = *(const u32x4*)(src + (size_t)(2 * tp + 1) * PW + fc * 8);
    float d0 = 1.f, d1 = 1.f;
    if (dec) { d0 = dec[2 * tp]; d1 = dec[2 * tp + 1]; }
#pragma unroll
    for (int q = 0; q < 4; ++q) {
      uint32_t lo, hi;
      if (dec) {
        lo = pack_bf16(__uint_as_float(a[q] << 16) * d0, __uint_as_float(b[q] << 16) * d1);
        hi = pack_bf16(__uint_as_float(a[q] & 0xffff0000u) * d0, __uint_as_float(b[q] & 0xffff0000u) * d1);
      } else {
        lo = (a[q] & 0xffffu) | (b[q] << 16);
        hi = (a[q] >> 16) | (b[q] & 0xffff0000u);
      }
      const int f = fc * 8 + 2 * q;
      *(uint32_t*)(dst + tile_off(f, tp >> 2) + (tp & 3) * 4) = lo;
      *(uint32_t*)(dst + tile_off(f + 1, tp >> 2) + (tp & 3) * 4) = hi;
    }
  }
}

__device__ __forceinline__ void stage_R(char* dst, const bf16_t* __restrict__ src) {
  const int t = opaque_tid();
#pragma unroll
  for (int i = 0; i < 4; ++i) {
    const int q = t + 256 * i, row = q >> 4, c = q & 15;
    *(u32x4*)(dst + row * 256 + ((c ^ (row & 15)) << 4)) = *(const u32x4*)(src + (size_t)row * PW + c * 8);
  }
}

__device__ __forceinline__ void ret_state_unit(int u, int h, char* smem, const bf16_t* __restrict__ P, bf16_t* __restrict__ ST) {
  const int t = opaque_tid(), lane = t & 63, wave = t >> 6, r = lane & 31, hh = lane >> 5;
  char* RKT = smem;
  char* RVT = smem + 16384;
  float* dec = (float*)(smem + 32768);
  const int row0 = unit_row0(u);
  const float lg2 = log2f(1.0f - exp2f(-5.0f - (float)h));
  __syncthreads();
  if (t < 64) dec[t] = exp2f((float)(63 - t) * lg2);
  __syncthreads();
  stage_T(RKT, P + (size_t)row0 * PW + 1280 + h * 128, dec);
  stage_T(RVT, P + (size_t)row0 * PW + 1792 + h * 128, nullptr);
  __syncthreads();
  f32x16 acc[4];
#pragma unroll
  for (int j = 0; j < 4; ++j)
#pragma unroll
    for (int e = 0; e < 16; ++e) acc[j][e] = 0.f;
#pragma unroll
  for (int ks = 0; ks < 4; ++ks) {
    const bf16x8 af = *(const bf16x8*)(RKT + tile_off(32 * wave + r, 2 * ks + hh));
#pragma unroll
    for (int ej = 0; ej < 4; ++ej) {
      const bf16x8 bfr = *(const bf16x8*)(RVT + tile_off(32 * ej + r, 2 * ks + hh));
      acc[ej] = __builtin_amdgcn_mfma_f32_32x32x16_bf16(af, bfr, acc[ej], 0, 0, 0);
    }
  }
  bf16_t* o = ST + (size_t)(u * 4 + h) * 16384;
#pragma unroll
  for (int ej = 0; ej < 4; ++ej)
#pragma unroll
    for (int g = 0; g < 4; ++g) {
      uint2 w;
      w.x = pack_bf16(acc[ej][4 * g], acc[ej][4 * g + 1]);
      w.y = pack_bf16(acc[ej][4 * g + 2], acc[ej][4 * g + 3]);
      *(uint2*)(o + (32 * ej + r) * 128 + 32 * wave + 8 * g + 4 * hh) = w;
    }
}

__device__ __forceinline__ void unpack4(const uint2 v, float (&f)[4]) {
  f[0] = __uint_as_float(v.x << 16); f[1] = __uint_as_float(v.x & 0xffff0000u); f[2] = __uint_as_float(v.y << 16); f[3] = __uint_as_float(v.y & 0xffff0000u);
}
__device__ __forceinline__ void ret_scan_chain(int ci, const bf16_t* __restrict__ P, const float* __restrict__ state_in, bf16_t* __restrict__ ST, float* __restrict__ out) {
  const int d4 = ci & 31, e = (ci >> 5) & 127, h = (ci >> 12) & 3, b = (ci >> 14) & 7, samp = ci >> 17;
  const float gamma = 1.0f - exp2f(-5.0f - (float)h);
  const float g64 = exp2f(64.0f * log2f(gamma));
  float s[4], av[4];
  if (samp) {
    const bf16_t* ptr = ST + ((size_t)((256 + b) * 4 + h) * 128 + e) * 128 + d4 * 4;
    unpack4(*(const uint2*)ptr, av);
#pragma unroll
    for (int j = 0; j < 4; ++j) {
      const float sv = state_in[((size_t)(b * 4 + h) * 128 + d4 * 4 + j) * 128 + e];
      out[O_RETS + ((size_t)(b * 4 + h) * 128 + d4 * 4 + j) * 128 + e] = g64 * sv + av[j];
    }
    return;
  }
#pragma unroll
  for (int j = 0; j < 4; ++j) s[j] = 0.f;
  for (int k = 0; k < 16; ++k) {
    const bf16_t* pr = P + (size_t)(NTOK + k) * PW;
    const float v = bf2f(pr[1792 + h * 128 + e]);
#pragma unroll
    for (int j = 0; j < 4; ++j) s[j] = gamma * s[j] + bf2f(pr[1280 + h * 128 + d4 * 4 + j]) * v;
  }
  for (int c = 0; c < 32; ++c) {
    bf16_t* ptr = ST + ((size_t)((b * 32 + c) * 4 + h) * 128 + e) * 128 + d4 * 4;
    unpack4(*(const uint2*)ptr, av);
    uint2 w;
    w.x = pack_bf16(s[0], s[1]); w.y = pack_bf16(s[2], s[3]);
    *(uint2*)ptr = w;
#pragma unroll
    for (int j = 0; j < 4; ++j) s[j] = g64 * s[j] + av[j];
  }
#pragma unroll
  for (int j = 0; j < 4; ++j) out[O_RETP + ((size_t)(b * 4 + h) * 128 + d4 * 4 + j) * 128 + e] = s[j];
}

__device__ __forceinline__ void ret_out_unit(int u, int h, char* smem, const bf16_t* __restrict__ P, const bf16_t* __restrict__ Su,
                                             const float* __restrict__ gn_g, bf16_t* __restrict__ mixed) {
  const int t = opaque_tid(), lane = t & 63, wave = t >> 6, r = lane & 31, hh = lane >> 5;
  char* RQ = smem;
  char* RK = smem + 16384;
  char* RVT = smem + 32768;
  char* YL = smem + 49152;
  float* red = (float*)smem;
  const int row0 = unit_row0(u);
  const float lg2 = log2f(1.0f - exp2f(-5.0f - (float)h));
  __syncthreads();
  stage_R(RQ, P + (size_t)row0 * PW + 768 + h * 128);
  stage_R(RK, P + (size_t)row0 * PW + 1280 + h * 128);
  stage_T(RVT, P + (size_t)row0 * PW + 1792 + h * 128, nullptr);
  __syncthreads();
  const int qt = wave & 1, ep = wave >> 1;
  const int q = 32 * qt + r;
  f32x16 X[2];
#pragma unroll
  for (int kt = 0; kt < 2; ++kt) {
#pragma unroll
    for (int e = 0; e < 16; ++e) X[kt][e] = 0.f;
    if (kt <= qt) {
#pragma unroll
      for (int ks = 0; ks < 8; ++ks) {
        const int krow = 32 * kt + r, qrow = 32 * qt + r;
        const bf16x8 kf = *(const bf16x8*)(RK + krow * 256 + (((2 * ks + hh) ^ (krow & 15)) << 4));
        const bf16x8 qf = *(const bf16x8*)(RQ + qrow * 256 + (((2 * ks + hh) ^ (qrow & 15)) << 4));
        X[kt] = __builtin_amdgcn_mfma_f32_32x32x16_bf16(kf, qf, X[kt], 0, 0, 0);
      }
#pragma unroll
      for (int e = 0; e < 16; ++e) {
        const int k = 32 * kt + (e & 3) + 8 * (e >> 2) + 4 * hh;
        X[kt][e] = (q >= k) ? X[kt][e] * exp2f((float)(q - k) * lg2) : 0.f;
      }
    }
  }
  f32x16 O[2];
#pragma unroll
  for (int ei = 0; ei < 2; ++ei) {
#pragma unroll
    for (int e = 0; e < 16; ++e) O[ei][e] = 0.f;
    const int erow = 32 * (2 * ep + ei) + r;
#pragma unroll
    for (int ks = 0; ks < 8; ++ks) {
      const bf16x8 sf = *(const bf16x8*)(Su + erow * 128 + 16 * ks + 8 * hh);
      const int qrow = 32 * qt + r;
      const bf16x8 qf = *(const bf16x8*)(RQ + qrow * 256 + (((2 * ks + hh) ^ (qrow & 15)) << 4));
      O[ei] = __builtin_amdgcn_mfma_f32_32x32x16_bf16(sf, qf, O[ei], 0, 0, 0);
    }
    const float qd = exp2f((float)(q + 1) * lg2);
#pragma unroll
    for (int e = 0; e < 16; ++e) O[ei][e] *= qd;
  }
#pragma unroll
  for (int kt = 0; kt < 2; ++kt) {
    if (kt <= qt) {
#pragma unroll
      for (int sidx = 0; sidx < 2; ++sidx) {
        u32x4 xp;
#pragma unroll
        for (int j = 0; j < 4; ++j) xp[j] = pack_bf16(X[kt][8 * sidx + 2 * j], X[kt][8 * sidx + 2 * j + 1]);
        bf16x8 xf;
        __builtin_memcpy(&xf, &xp, 16);
#pragma unroll
        for (int ei = 0; ei < 2; ++ei) {
          const int erow = 32 * (2 * ep + ei) + r;
          const uint2 a0 = *(const uint2*)(RVT + tile_off(erow, 4 * kt + 2 * sidx) + 8 * hh);
          const uint2 a1 = *(const uint2*)(RVT + tile_off(erow, 4 * kt + 2 * sidx + 1) + 8 * hh);
          u32x4 ap;
          ap[0] = a0.x; ap[1] = a0.y; ap[2] = a1.x; ap[3] = a1.y;
          bf16x8 af;
          __builtin_memcpy(&af, &ap, 16);
          O[ei] = __builtin_amdgcn_mfma_f32_32x32x16_bf16(af, xf, O[ei], 0, 0, 0);
        }
      }
    }
  }
  float s1 = 0.f, s2 = 0.f;
#pragma unroll
  for (int ei = 0; ei < 2; ++ei)
#pragma unroll
    for (int e = 0; e < 16; ++e) { s1 += O[ei][e]; s2 += O[ei][e] * O[ei][e]; }
  s1 += __shfl_xor(s1, 32);
  s2 += __shfl_xor(s2, 32);
  __syncthreads();
  if (hh == 0) { red[(wave * 32 + r) * 2] = s1; red[(wave * 32 + r) * 2 + 1] = s2; }
  __syncthreads();
  {
    const int pw = wave ^ 2;
    s1 += red[(pw * 32 + r) * 2];
    s2 += red[(pw * 32 + r) * 2 + 1];
  }
  const float mean = s1 * (1.0f / 128.0f);
  const float rstd = rsqrtf(fmaxf(s2 * (1.0f / 128.0f) - mean * mean, 0.f) + LN_EPS);
  const bf16_t* rgp = P + (size_t)(row0 + q) * PW + 2304 + h * 128;
#pragma unroll
  for (int ei = 0; ei < 2; ++ei)
#pragma unroll
    for (int g = 0; g < 4; ++g) {
      const int e0 = 32 * (2 * ep + ei) + 8 * g + 4 * hh;
      const uint2 rg = *(const uint2*)(rgp + e0);
      const float4 gg = *(const float4*)(gn_g + h * 128 + e0);
      const float g0 = __uint_as_float(rg.x << 16), g1 = __uint_as_float(rg.x & 0xffff0000u), g2 = __uint_as_float(rg.y << 16), g3 = __uint_as_float(rg.y & 0xffff0000u);
      const float y0 = (O[ei][4 * g + 0] - mean) * rstd * gg.x * (g0 / (1.0f + __expf(-g0)));
      const float y1 = (O[ei][4 * g + 1] - mean) * rstd * gg.y * (g1 / (1.0f + __expf(-g1)));
      const float y2 = (O[ei][4 * g + 2] - mean) * rstd * gg.z * (g2 / (1.0f + __expf(-g2)));
      const float y3 = (O[ei][4 * g + 3] - mean) * rstd * gg.w * (g3 / (1.0f + __expf(-g3)));
      uint2 w;
      w.x = pack_bf16(y0, y1); w.y = pack_bf16(y2, y3);
      const int c = e0 >> 3;
      *(uint2*)(YL + q * 256 + ((c ^ (q & 15)) << 4) + 8 * hh) = w;
    }
  __syncthreads();
#pragma unroll
  for (int i = 0; i < 4; ++i) {
    const int qq = t + 256 * i, row = qq >> 4, c = qq & 15;
    *(u32x4*)(mixed + (size_t)(row0 + row) * D + 512 + h * 128 + c * 8) = *(const u32x4*)(YL + row * 256 + ((c ^ (row & 15)) << 4));
  }
}


constexpr int VT_STRIDE = 456;

struct AttnSrc {
  const bf16_t* P; const float *cmk, *cmv, *csk, *csv;
  int samp, b, c, kvh;
  __device__ __forceinline__ u32x4 load(int kk, int ch, bool isv) const {
    u32x4 z = make_u32x4_zero();
    const bf16_t* src = nullptr;
    const float* fsrc = nullptr;
    const int col = (isv ? 640 : 512) + kvh * 64 + ch * 8;
    if (kk < 16) {
      if (samp) fsrc = (isv ? cmv : cmk) + ((size_t)(b * 16 + kk) * 2 + kvh) * 64 + ch * 8;
      else src = P + (size_t)(NTOK + kk) * PW + col;
    } else if (kk < 208) {
      const int jb = kk - 16;
      if (samp) {
        if (jb < 128) fsrc = (isv ? csv : csk) + ((size_t)(b * 128 + jb) * 2 + kvh) * 64 + ch * 8;
        else src = P + (size_t)(NPROMPT + b * 64 + (jb - 128)) * PW + col;
      } else {
        const int f = (c - 2) * 64 + jb;
        if (f >= 0) src = P + (size_t)(b * SEQ + f) * PW + col;
      }
    }
    if (src) z = *(const u32x4*)src;
    else if (fsrc) {
      const float4 a = *(const float4*)fsrc, bq = *(const float4*)(fsrc + 4);
      z[0] = pack_bf16(a.x, a.y); z[1] = pack_bf16(a.z, a.w); z[2] = pack_bf16(bq.x, bq.y); z[3] = pack_bf16(bq.z, bq.w);
    }
    return z;
  }
};

__device__ __forceinline__ void attn_unit(int u, int kvh, int qt_lo, int qt_hi, char* smem, const bf16_t* __restrict__ P, const float* __restrict__ cmk,
                                          const float* __restrict__ cmv, const float* __restrict__ csk, const float* __restrict__ csv,
                                          const float* __restrict__ rel_bias, const float* __restrict__ sinks, bf16_t* __restrict__ mixed) {
  const int t = opaque_tid(), lane = t & 63, g = t >> 6, r = lane & 31, hh = lane >> 5;
  char* KT = smem;
  char* VT = smem + 28672;
  float* TB = (float*)(smem + 28672 + 64 * VT_STRIDE) + g * 384;
  AttnSrc as;
  as.P = P; as.cmk = cmk; as.cmv = cmv; as.csk = csk; as.csv = csv;
  as.samp = u >= 256; as.b = as.samp ? u - 256 : u >> 5; as.c = as.samp ? 32 : (u & 31); as.kvh = kvh;
  const int H = kvh * 4 + g;
  const int row0 = unit_row0(u);
  __syncthreads();
#pragma unroll
  for (int i = 0; i < 7; ++i) {
    const int qidx = t + 256 * i, key = qidx >> 3, ch = qidx & 7;
    *(u32x4*)(KT + tile_off(key, ch)) = as.load(key, ch, false);
  }
  for (int item = t; item < 896; item += 256) {
    const int fc = item / 112, tp = item - fc * 112;
    const u32x4 a = as.load(2 * tp, fc, true), bq = as.load(2 * tp + 1, fc, true);
#pragma unroll
    for (int q = 0; q < 4; ++q) {
      *(uint32_t*)(VT + (fc * 8 + 2 * q) * VT_STRIDE + tp * 4) = (a[q] & 0xffffu) | (bq[q] << 16);
      *(uint32_t*)(VT + (fc * 8 + 2 * q + 1) * VT_STRIDE + tp * 4) = (a[q] >> 16) | (bq[q] & 0xffff0000u);
    }
  }
  for (int idx = lane; idx < 383; idx += 64) TB[idx] = rel_bias[t5_bucket(idx - 191) * 8 + H];
  __syncthreads();
  const float sink = sinks[H];
#pragma unroll 1
  for (int qt = qt_lo; qt < qt_hi; ++qt) {
    bf16x8 qf[4];
#pragma unroll
    for (int ks = 0; ks < 4; ++ks) qf[ks] = *(const bf16x8*)(P + (size_t)(row0 + 32 * qt + r) * PW + H * 64 + ks * 16 + 8 * hh);
    f32x16 S[7];
#pragma unroll
    for (int kt = 0; kt < 7; ++kt) {
#pragma unroll
      for (int e = 0; e < 16; ++e) S[kt][e] = 0.f;
#pragma unroll
      for (int ks = 0; ks < 4; ++ks) {
        const bf16x8 kf = *(const bf16x8*)(KT + tile_off(32 * kt + r, 2 * ks + hh));
        S[kt] = __builtin_amdgcn_mfma_f32_32x32x16_bf16(kf, qf[ks], S[kt], 0, 0, 0);
      }
    }
    const int i = 32 * qt + r, posq = 16 + as.c * 64 + i;
    float mx = -3.0e38f;
    const float* tbl = TB + (47 - i + 4 * hh);
    const int kmin = as.samp ? 16 : (as.c >= 2 ? 16 : 144 - 64 * as.c);
#pragma unroll
    for (int kt = 0; kt < 7; ++kt)
#pragma unroll
      for (int e = 0; e < 16; ++e) {
        const int kb = 32 * kt + (e & 3) + 8 * (e >> 2);
        float sv;
        if (kb < 16) {
          const int rel = kb + 4 * hh - posq;
          sv = S[kt][e] * 0.125f + TB[(rel < -191 ? -191 : rel) + 191];
        } else if (kb >= 208) {
          sv = -1.0e30f;
        } else {
          const float bv = tbl[kb];
          sv = (kb >= kmin) ? S[kt][e] * 0.125f + bv : -1.0e30f;
        }
        S[kt][e] = sv;
        mx = fmaxf(mx, sv);
        if (e == 15) __builtin_amdgcn_sched_barrier(0);
      }
    mx = fmaxf(mx, __shfl_xor(mx, 32));
    const float m = fmaxf(mx, sink);
    float ls = 0.f;
#pragma unroll
    for (int kt = 0; kt < 7; ++kt)
#pragma unroll
      for (int e = 0; e < 16; ++e) {
        const float pv = __expf(S[kt][e] - m);
        S[kt][e] = pv;
        ls += pv;
        if (e == 15) __builtin_amdgcn_sched_barrier(0);
      }
    ls += __shfl_xor(ls, 32);
    const float inv = 1.0f / (ls + __expf(sink - m));
    f32x16 O[2];
#pragma unroll
    for (int dt = 0; dt < 2; ++dt)
#pragma unroll
      for (int e = 0; e < 16; ++e) O[dt][e] = 0.f;
#pragma unroll
    for (int kt = 0; kt < 7; ++kt)
#pragma unroll
      for (int sidx = 0; sidx < 2; ++sidx) {
        u32x4 xp;
#pragma unroll
        for (int j = 0; j < 4; ++j) xp[j] = pack_bf16(S[kt][8 * sidx + 2 * j], S[kt][8 * sidx + 2 * j + 1]);
        bf16x8 xf;
        __builtin_memcpy(&xf, &xp, 16);
#pragma unroll
        for (int dt = 0; dt < 2; ++dt) {
          const char* vp = VT + (32 * dt + r) * VT_STRIDE + (32 * kt + 16 * sidx + 4 * hh) * 2;
          const uint2 a0 = *(const uint2*)vp, a1 = *(const uint2*)(vp + 16);
          u32x4 ap;
          ap[0] = a0.x; ap[1] = a0.y; ap[2] = a1.x; ap[3] = a1.y;
          bf16x8 af;
          __builtin_memcpy(&af, &ap, 16);
          O[dt] = __builtin_amdgcn_mfma_f32_32x32x16_bf16(af, xf, O[dt], 0, 0, 0);
        }
      }
    bf16_t* op = mixed + (size_t)(row0 + i) * D + H * 64 + 4 * hh;
#pragma unroll
    for (int dt = 0; dt < 2; ++dt)
#pragma unroll
      for (int g4 = 0; g4 < 4; ++g4) {
        uint2 w;
        w.x = pack_bf16(O[dt][4 * g4] * inv, O[dt][4 * g4 + 1] * inv);
        w.y = pack_bf16(O[dt][4 * g4 + 2] * inv, O[dt][4 * g4 + 3] * inv);
        *(uint2*)(op + 32 * dt + 8 * g4) = w;
      }
  }
}


#define XB_TMO      128
#define XB_XCNT(j)  (256  + 64 * (j))
#define XB_XSUB(j)  (1280 + 64 * (j))
#define XB_XGEN(j)  (2304 + 64 * (j))
#define XB_TOP      3328
#define XB_TOPGEN   3392
#define XCD_BAR_WORDS 3456
#define XB_SPIN_CAP (1u << 18)
#define LAS __attribute__((address_space(3)))
__device__ __forceinline__ unsigned xb_ld(unsigned* p)              { return __hip_atomic_load(p, __ATOMIC_RELAXED, __HIP_MEMORY_SCOPE_AGENT); }
__device__ __forceinline__ unsigned xb_add(unsigned* p, unsigned v) { return __hip_atomic_fetch_add(p, v, __ATOMIC_RELAXED, __HIP_MEMORY_SCOPE_AGENT); }
__device__ __forceinline__ unsigned xb_xcc_id() { return (unsigned)__builtin_amdgcn_s_getreg((3 << 11) | 20) & 0xFu; }
#define XB_SPIN(cond, bar) do { unsigned _sp = 0; while (cond) { __builtin_amdgcn_s_sleep(1); \
    if ((++_sp & 255u) == 0u) { if (xb_ld(&(bar)[XB_TMO])) break; if (_sp > XB_SPIN_CAP) { atomicAdd(&(bar)[XB_TMO], 1u); break; } } } } while (0)
struct XcdBarrier { unsigned* bar; unsigned x; volatile LAS unsigned* st; };
__device__ __forceinline__ XcdBarrier xcd_barrier_post(unsigned* bar, volatile LAS unsigned* st) {
  XcdBarrier b; b.bar = bar; b.x = xb_xcc_id(); b.st = st;
  if (threadIdx.x == 0) (void)xb_add(&bar[XB_XCNT(b.x)], 1u);
  return b;
}
__device__ __forceinline__ void xcd_barrier_complete(unsigned* bar, unsigned x, unsigned& nloc, unsigned& nx) {
  const unsigned G = gridDim.x * gridDim.y * gridDim.z;
  unsigned sum, cnt, mine, sp = 0u;
  for (;;) {
    sum = 0u; cnt = 0u; mine = 0u;
#pragma unroll
    for (unsigned j = 0; j < 16; ++j) { const unsigned c = xb_ld(&bar[XB_XCNT(j)]); sum += c; cnt += (c > 0u) ? 1u : 0u; mine = (j == x) ? c : mine; }
    if (sum == G) break;
    __builtin_amdgcn_s_sleep(1);
    if ((++sp & 255u) == 0u) { if (xb_ld(&bar[XB_TMO])) break; if (sp > XB_SPIN_CAP) { atomicAdd(&bar[XB_TMO], 1u); break; } }
  }
  nloc = mine > 0u ? mine : 1u; nx = cnt > 0u ? cnt : 1u;
}
__device__ __forceinline__ void xcd_barrier(const XcdBarrier& b) {
  asm volatile("s_waitcnt vmcnt(0)" ::: "memory");
  __syncthreads();
  if (threadIdx.x == 0) {
    unsigned* bar = b.bar;
    __builtin_amdgcn_s_waitcnt(0);
    unsigned nloc = b.st[0], nx = b.st[1];
    if (nloc == 0u) { xcd_barrier_complete(bar, b.x, nloc, nx); b.st[0] = nloc; b.st[1] = nx; }
    const unsigned old = xb_add(&bar[XB_XSUB(b.x)], 1u);
    const unsigned gen = old / nloc;
    if (old + 1u == (gen + 1u) * nloc) {
      __builtin_amdgcn_fence(__ATOMIC_RELEASE, "agent");
      asm volatile("s_waitcnt vmcnt(0)" ::: "memory");
      const unsigned og = xb_add(&bar[XB_TOP], 1u);
      const unsigned tg = og / nx;
      if (og + 1u == (tg + 1u) * nx) xb_add(&bar[XB_TOPGEN], 1u);
      else XB_SPIN(xb_ld(&bar[XB_TOPGEN]) == tg, bar);
      __builtin_amdgcn_fence(__ATOMIC_ACQUIRE, "agent");
      xb_add(&bar[XB_XGEN(b.x)], 1u);
      asm volatile("s_waitcnt vmcnt(0)" ::: "memory");
    } else {
      XB_SPIN(xb_ld(&bar[XB_XGEN(b.x)]) == gen, bar);
      __builtin_amdgcn_fence(__ATOMIC_ACQUIRE, "agent");
      asm volatile("s_waitcnt vmcnt(0)" ::: "memory");
    }
  }
  __syncthreads();
}

struct Params {
  const float *x_prompt, *x_sample, *cmk, *cmv, *csk, *csv, *state_ret, *meta_tokens, *ln_in_g, *ln_in_b, *rel_bias, *w_in,
      *w_out, *sinks, *gn_g, *ln1_g, *ln1_b, *peer_wq, *subk, *peer_u, *peer_v, *ln2_g, *ln2_b;
  float* out;
  char* ws;
};

#ifndef PHASE_MASK
#define PHASE_MASK 0x1ff
#endif
#ifndef PHASE_TWICE
#define PHASE_TWICE 0
#endif
#define PH_ON(n) (((PHASE_MASK) >> (n)) & 1)
#define PH_REP(n) for (int rep_ = 0; rep_ < 1 + (((PHASE_TWICE) >> (n)) & 1); ++rep_)

__global__ void __launch_bounds__(256, 2) mega_kernel(Params p) {
  __shared__ __attribute__((aligned(16))) char smem[73728 + 16];
  if (threadIdx.x < 4) ((unsigned*)(smem + 73728))[threadIdx.x] = 0u;
  __syncthreads();
  const XcdBarrier xb = xcd_barrier_post((unsigned*)(p.ws + W_BAR), (volatile LAS unsigned*)(smem + 73728));
  const int G = gridDim.x, bid = blockIdx.x;
  bf16_t* hbf = (bf16_t*)(p.ws + W_HBF);
  bf16_t* P = (bf16_t*)(p.ws + W_P);
  bf16_t* z = (bf16_t*)(p.ws + W_P);
  bf16_t* mixed = (bf16_t*)(p.ws + W_MIXED);
  int* lidx = (int*)(p.ws + W_LIDX);
  float* lgate = (float*)(p.ws + W_LGATE);
  bf16_t* wt_in = (bf16_t*)(p.ws + W_WTIN);
  bf16_t* wt_out = (bf16_t*)(p.ws + W_WTOUT);
  bf16_t* wt_q = (bf16_t*)(p.ws + W_WTQ);
  float2* rope = (float2*)(p.ws + W_ROPE);
  bf16_t* h1bf = mixed;
  uint8_t* U8 = (uint8_t*)(p.ws + W_U8);
  uint8_t* V8 = (uint8_t*)(p.ws + W_U8) + 1024;
  float* su = (float*)(p.ws + W_SU);
  float* sv = (float*)(p.ws + W_SV);
  uint8_t* xq = (uint8_t*)(p.ws + W_XQ);
  bf16_t* subk_bf = (bf16_t*)(p.ws + W_SUBK);
  float* xs = (float*)(p.ws + W_XS);
  bf16_t* ST = (bf16_t*)p.out;
  bf16_t* STs = (bf16_t*)(p.ws + W_LIDX);
  const int nw = blockDim.x >> 6, W = G * nw;

  if (PH_ON(0)) PH_REP(0) {
    const int lane = opaque_tid() & 63, gw = bid * nw + (opaque_tid() >> 6);
    {
      int r = gw;
      for (; r + 3 * W < NROWS; r += 4 * W) { const int rows[4] = {r, r + W, r + 2 * W, r + 3 * W}; ln_in_rows<4>(rows, lane, p.x_prompt, p.x_sample, p.meta_tokens, p.ln_in_g, p.ln_in_b, hbf); }
      for (; r < NROWS; r += W) { const int rows[1] = {r}; ln_in_rows<1>(rows, lane, p.x_prompt, p.x_sample, p.meta_tokens, p.ln_in_g, p.ln_in_b, hbf); }
    }
    for (int u = bid; u < 704; u += G) transpose_tile(u % 16, u / 16, smem, p.w_in, PW, D, wt_in);
    for (int idx = bid * 256 + opaque_tid(); idx < 2128 * 64; idx += G * 256) {
      const int pos = idx >> 6, d = idx & 63;
      const float inv = powf(10000.0f, -(float)d / 64.0f);
      float sn, cs;
      sincosf((float)pos * inv, &sn, &cs);
      rope[idx] = make_float2(cs, sn);
    }
  }
  xcd_barrier(xb);
#ifdef PROBE_GEMM
  for (int u = bid; u < 22 * 133; u += G) gemm_mfma_tile_v<PROBE_GEMM>(u / 22, u % 22, smem, hbf, NROWS, wt_in, D, EpiInProjM{P, p.out, rope});
#endif
  if (PH_ON(1)) PH_REP(1)
  {
    const int lane = opaque_tid() & 63, gw = bid * nw + (opaque_tid() >> 6);
    int qr = gw;
    for (int u0 = bid; u0 < ((11 * 133 + G - 1) / G) * G; u0 += G) {
      const int u = (u0 - bid) + ((G & 7) == 0 ? (bid & 7) * (G >> 3) + (bid >> 3) : bid);
      if (u >= 11 * 133) continue;
      gemm_mfma_tile_n256(u / 11, u % 11, smem, hbf, NROWS, wt_in, D, EpiInProjM{P, p.out, rope});
      for (int it = 0; it < 6 && qr < 32768; ++it, qr += W) {
        if (qr < 16384) quant_table_row(p.peer_u + (size_t)qr * D, lane, U8 + (size_t)qr * 2048, su + qr, false);
        else quant_table_row(p.peer_v + (size_t)(qr - 16384) * D, lane, V8 + (size_t)(qr - 16384) * 2048, sv + (qr - 16384), true);
      }
    }
    for (; qr < 32768; qr += W) {
      if (qr < 16384) quant_table_row(p.peer_u + (size_t)qr * D, lane, U8 + (size_t)qr * 2048, su + qr, false);
      else quant_table_row(p.peer_v + (size_t)(qr - 16384) * D, lane, V8 + (size_t)(qr - 16384) * 2048, sv + (qr - 16384), true);
    }
  }
  xcd_barrier(xb);
  if (PH_ON(2)) PH_REP(2)
    for (int u = bid; u < 1056; u += G) ret_state_unit(u >> 2, u & 3, smem, P, ST);
  for (int idx = bid * 256 + opaque_tid(); idx < 32 * 16384; idx += G * 256) {
    const int d = idx & 127, e = (idx >> 7) & 127, bh = idx >> 14;
    STs[idx] = f2bf(p.state_ret[((size_t)bh * 128 + d) * 128 + e]);
  }
  xcd_barrier(xb);
#ifdef PROBE_ATTN
  for (int rep = 0; rep < PROBE_ATTN; ++rep)
    for (int u = bid; u < 528; u += G) attn_unit(u >> 1, u & 1, 0, 2, smem, P, p.cmk, p.cmv, p.csk, p.csv, p.rel_bias, p.sinks, mixed);
  xcd_barrier(xb);
#endif
  if (PH_ON(3)) {
    const int lane = opaque_tid() & 63, gw = bid * nw + (opaque_tid() >> 6);
    const bool attn_first = (bid & 1) != 0;
    for (int half = 0; half < 2; ++half) {
      if ((half == 0) == attn_first) {
        for (int u = G - 1 - bid; u < 32; u += G) ret_out_unit(256 + (u >> 2), u & 3, smem, P, STs + (size_t)u * 16384, p.gn_g, mixed);
        for (int u = bid; u < 512 + 32; u += G) {
          if (u < 512) attn_unit(u >> 1, u & 1, 0, 2, smem, P, p.cmk, p.cmv, p.csk, p.csv, p.rel_bias, p.sinks, mixed);
          else { const int v = u - 512; attn_unit(256 + (v >> 2), (v >> 1) & 1, v & 1, (v & 1) + 1, smem, P, p.cmk, p.cmv, p.csk, p.csv, p.rel_bias, p.sinks, mixed); }
        }
      } else {
        for (int ci = bid * 256 + opaque_tid(); ci < 262144; ci += G * 256) ret_scan_chain(ci, P, p.state_ret, ST, p.out);
        for (int u = bid; u < 512; u += G) {
          if (u < 256) transpose_tile(u % 16, u / 16, smem, p.w_out, D, D, wt_out);
          else transpose_tile((u - 256) % 16, (u - 256) / 16, smem, p.peer_wq, D, D, wt_q);
        }
        for (int idx = bid * 256 + opaque_tid(); idx < 131072; idx += G * 256) subk_bf[idx] = f2bf(p.subk[idx]);
      }
    }
  }
  xcd_barrier(xb);
  if (PH_ON(4)) PH_REP(4)
    for (int u = bid; u < 1024; u += G) ret_out_unit(u >> 2, u & 3, smem, P, ST + (size_t)u * 16384, p.gn_g, mixed);
  xcd_barrier(xb);
  if (PH_ON(5)) PH_REP(5)
    for (int u0 = bid; u0 < ((8 * 132 + G - 1) / G) * G; u0 += G) {
      const int u = (u0 - bid) + ((G & 7) == 0 ? (bid & 7) * (G >> 3) + (bid >> 3) : bid);
      if (u >= 8 * 132) continue;
      gemm_mfma_tile(u / 8, u % 8, smem, mixed, NTOK, wt_out, D, EpiOutProjM{hbf, z});
    }
  xcd_barrier(xb);
  if (PH_ON(6)) {
    const int lane = opaque_tid() & 63, gw = bid * nw + (opaque_tid() >> 6);
    int r = gw;
    for (; r + 3 * W < NTOK; r += 4 * W) { const int rows[4] = {r, r + W, r + 2 * W, r + 3 * W}; ln1_rows<4>(rows, lane, z, p.ln1_g, p.ln1_b, h1bf, xq, xs); }
    for (; r < NTOK; r += W) { const int rows[1] = {r}; ln1_rows<1>(rows, lane, z, p.ln1_g, p.ln1_b, h1bf, xq, xs); }
  }
  xcd_barrier(xb);
#ifdef PROBE_PQ
  for (int u = bid; u < 8 * 132; u += G) gemm_mfma_tile_v<PROBE_PQ>(u / 8, u % 8, smem, h1bf, NTOK, wt_q, D, EpiTopK{subk_bf, lidx, lgate});
#endif
  if (PH_ON(7)) PH_REP(7)
    for (int u0 = bid; u0 < ((8 * 132 + G - 1) / G) * G; u0 += G) {
      const int u = (u0 - bid) + ((G & 7) == 0 ? (bid & 7) * (G >> 3) + (bid >> 3) : bid);
      if (u >= 8 * 132) continue;
      gemm_mfma_tile(u / 8, u % 8, smem, h1bf, NTOK, wt_q, D, EpiTopK{subk_bf, lidx, lgate});
    }
  xcd_barrier(xb);
  if (PH_ON(8)) PH_REP(8) {
    const int lane = opaque_tid() & 63, wave = opaque_tid() >> 6, gw = bid * nw + wave;
    const SweepArgs sa{lidx, lgate, U8, V8, su, sv, xq, xs, h1bf, p.ln2_g, p.ln2_b, p.out};
    const int TPP = W * 4;
    const int NPF = NTOK / TPP;
    for (int pass = 0; pass < NPF; ++pass)
      sweep_groups<false>(pass * TPP + gw * 4, lane, smem + wave * SG_LDS_PER_WAVE, sa);
#ifdef PROBE_SG
    {
#ifdef PROBE_PACE
      const unsigned long long tstart = __builtin_amdgcn_s_memrealtime();
      for (int pass = 0; pass < NPF; ++pass)
        sweep_groups<true>(pass * TPP + gw * 4, lane, smem + wave * SG_LDS_PER_WAVE, sa, 0, tstart + 1500ull + (unsigned long long)pass * (175ull * PROBE_PACE + 1500ull), PROBE_PACE);
#else
      for (int pass = 0; pass < NPF; ++pass)
#ifdef PROBE_ROT
        sweep_groups<true>(pass * TPP + gw * 4, lane, smem + wave * SG_LDS_PER_WAVE, sa, (int)(xb_xcc_id() & 7u) * PROBE_ROT);
#else
        sweep_groups<true>(pass * TPP + gw * 4, lane, smem + wave * SG_LDS_PER_WAVE, sa);
#endif
#endif
    }
#endif
    for (int tk = NPF * TPP + bid; tk < NTOK; tk += G)
      sweep_mini(tk, lane, wave, smem, sa);
  }
#ifdef PROBE_SYNCS
  for (int i = 0; i < PROBE_SYNCS; ++i) xcd_barrier(xb);
#endif
}

}

extern "C" void kernel_launch(void* const* d_in, const int* in_sizes, int n_in, void* d_out, int out_size, void* d_ws,
                              size_t ws_size, hipStream_t stream) {
  static int grid_blocks = 0;
  if (!grid_blocks) {
    int dev = 0, cus = 0, per_cu = 0;
    (void)hipGetDevice(&dev);
    (void)hipDeviceGetAttribute(&cus, hipDeviceAttributeMultiprocessorCount, dev);
    (void)hipOccupancyMaxActiveBlocksPerMultiprocessor(&per_cu, mega_kernel, 256, 0);
    if (per_cu > 2) per_cu = 2;
    if (per_cu < 1) per_cu = 1;
    grid_blocks = cus * per_cu;
  }
  Params p{};
  const float** pp = (const float**)&p;
  for (int i = 0; i < 23; ++i) pp[i] = (const float*)d_in[i];
  p.out = (float*)d_out;
  p.ws = (char*)d_ws;
  void* args[] = {&p};
  (void)hipMemsetAsync((char*)d_ws + W_BAR, 0, 3456 * 4, stream);
  hipError_t e = hipLaunchCooperativeKernel((void*)mega_kernel, dim3(grid_blocks), dim3(256), args, 0, stream);
  if (e != hipSuccess) fprintf(stderr, "cooperative launch failed: %s (grid %d)\n", hipGetErrorString(e), grid_blocks);
}
```

```cpp
#include <hip/hip_runtime.h>
#include <hip/hip_cooperative_groups.h>
#include <stdint.h>
#include <cstdio>
namespace cg = cooperative_groups;

namespace {

constexpr int D = 1024;
constexpr int NB = 8, SEQ = 2048, DSEQ = 64;
constexpr int NPROMPT = NB * SEQ;
constexpr int NSAMPLE = NB * DSEQ;
constexpr int NTOK = NPROMPT + NSAMPLE;
constexpr int NMETA = 16;
constexpr int NROWS = NTOK + NMETA;
constexpr int PW = 2816;
constexpr float LN_EPS = 1e-5f;
constexpr float ALPHA = 1.18920711500272f;

constexpr size_t O_Y = 0;
constexpr size_t O_METAK = 17301504;
constexpr size_t O_METAV = O_METAK + 16384;
constexpr size_t O_SWAKP = O_METAV + 16384;
constexpr size_t O_SWAVP = O_SWAKP + 131072;
constexpr size_t O_RETP = O_SWAVP + 131072;
constexpr size_t O_SWAKS = O_RETP + 524288;
constexpr size_t O_SWAVS = O_SWAKS + 65536;
constexpr size_t O_RETS = O_SWAVS + 65536;

constexpr size_t W_HBF = 0;
constexpr size_t W_P = W_HBF + (size_t)NROWS * D * 2;
constexpr size_t W_MIXED = W_P + (size_t)NROWS * PW * 2;
constexpr size_t W_LIDX = W_MIXED + (size_t)NTOK * D * 2;
constexpr size_t W_LGATE = W_LIDX + (size_t)NTOK * 128 * 4;
constexpr size_t W_WTIN = W_LGATE + (size_t)NTOK * 128 * 4;
constexpr size_t W_WTOUT = W_WTIN + (size_t)PW * D * 2;
constexpr size_t W_WTQ = W_WTOUT + (size_t)D * D * 2;
constexpr size_t W_ROPE = W_WTQ + (size_t)D * D * 2;
constexpr size_t W_U8 = W_ROPE + (size_t)2128 * 64 * 8;
constexpr size_t W_V8 = W_U8 + (size_t)16384 * 1024;
constexpr size_t W_SU = W_V8 + (size_t)16384 * 1024;
constexpr size_t W_SV = W_SU + 65536;
constexpr size_t W_XQ = W_SV + 65536;
constexpr size_t W_XS = W_XQ + (size_t)NTOK * 1024;
constexpr size_t W_SUBK = W_XS + (size_t)NTOK * 4 + 256;
constexpr size_t W_BAR = W_SUBK + 131072 * 2;
constexpr size_t W_END = W_BAR + 3456 * 4;
static_assert(W_END <= (size_t)256 * 1024 * 1024, "workspace overflow");

typedef uint16_t bf16_t;

__device__ __forceinline__ int opaque_tid() { int t = (int)threadIdx.x; asm volatile("" : "+v"(t)); return t; }

__device__ __forceinline__ bf16_t f2bf(float f) {
  uint32_t u = __float_as_uint(f);
  u += 0x7FFFu + ((u >> 16) & 1u);
  return (bf16_t)(u >> 16);
}
__device__ __forceinline__ float bf2f(bf16_t h) { return __uint_as_float(((uint32_t)h) << 16); }

__device__ __forceinline__ int row_pos(int r) {
  if (r < NPROMPT) return 16 + (r & 2047);
  if (r < NTOK) return 16 + 2048 + ((r - NPROMPT) & 63);
  return r - NTOK;
}


template <int M> __device__ __forceinline__ int lane_xor_i(int x) {
  if (M == 1) return __builtin_amdgcn_mov_dpp(x, 0xB1, 0xF, 0xF, true);
  else if (M == 2) return __builtin_amdgcn_mov_dpp(x, 0x4E, 0xF, 0xF, true);
  else if (M == 4) return __builtin_amdgcn_mov_dpp(__builtin_amdgcn_mov_dpp(x, 0x141, 0xF, 0xF, true), 0x1B, 0xF, 0xF, true);
  else if (M == 8) return __builtin_amdgcn_mov_dpp(__builtin_amdgcn_mov_dpp(x, 0x140, 0xF, 0xF, true), 0x141, 0xF, 0xF, true);
  else if (M == 16) return __builtin_amdgcn_ds_swizzle(x, 0x401F);
  else {
    const auto r = __builtin_amdgcn_permlane32_swap((unsigned)x, (unsigned)x, false, false);
    return (int)((__builtin_amdgcn_mbcnt_hi(~0u, __builtin_amdgcn_mbcnt_lo(~0u, 0u)) < 32u) ? r[1] : r[0]);
  }
}
template <int M> __device__ __forceinline__ float lane_xor_f(float x) { return __int_as_float(lane_xor_i<M>(__float_as_int(x))); }

__device__ __forceinline__ float wave_sum(float v) {
  v += lane_xor_f<1>(v); v += lane_xor_f<2>(v); v += lane_xor_f<4>(v); v += lane_xor_f<8>(v); v += lane_xor_f<16>(v); v += lane_xor_f<32>(v);
  return v;
}


__device__ __forceinline__ int t5_bucket(int rel) {
  int n = rel < 0 ? -rel : rel;
  int b;
  if (n < 8) b = n;
  else {
    int l = 2 + 31 - __clz(n * n);
    b = l > 15 ? 15 : l;
  }
  return (rel > 0 ? 16 : 0) + b;
}

__device__ __forceinline__ float gelu_tanh(float x) {
  float u = 0.7978845608028654f * (x + 0.044715f * x * x * x);
  return 0.5f * x * (1.0f + tanhf(u));
}


typedef short bf16x8 __attribute__((ext_vector_type(8)));
typedef float f32x16 __attribute__((ext_vector_type(16)));
typedef uint32_t u32x4 __attribute__((ext_vector_type(4)));
__device__ __forceinline__ u32x4 make_u32x4_zero() { u32x4 r; r[0] = 0; r[1] = 0; r[2] = 0; r[3] = 0; return r; }

__device__ __forceinline__ uint32_t pack_bf16(float lo, float hi) { return (uint32_t)f2bf(lo) | ((uint32_t)f2bf(hi) << 16); }

__device__ __forceinline__ int tile_off(int row, int c) {
  const int s = row >> 1;
  const int sc = ((row & 1) << 3) | c;
  return s * 256 + ((sc ^ (s & 15)) << 4);
}

template <int GV, class EPI>
__device__ __forceinline__ void gemm_mfma_tile_v(int mt, int nt, char* smem, const bf16_t* __restrict__ A, int M,
                                               const bf16_t* __restrict__ Bt, int K, const EPI& epi) {
  const int t = opaque_tid(), lane = t & 63, wave = t >> 6, r = lane & 31, h = lane >> 5;
  const int m0 = mt * 128, n0 = nt * 128;
  const bf16_t* ag[4];
  const bf16_t* bg[4];
#pragma unroll
  for (int i = 0; i < 4; ++i) {
    const int o = (wave * 4 + i) * 1024 + lane * 16;
    const int sr = o >> 8, scp = (o >> 4) & 15, sc = scp ^ (sr & 15);
    const int row = 2 * sr + (sc >> 3), c = sc & 7;
    int ar = m0 + row;
    ar = ar < M ? ar : M - 1;
    ag[i] = A + (size_t)ar * K + c * 8;
    bg[i] = Bt + (size_t)(n0 + row) * K + c * 8;
  }
  int roff[4];
#pragma unroll
  for (int ks = 0; ks < 4; ++ks) roff[ks] = tile_off(r, ks * 2 + h);
  f32x16 acc[4];
#pragma unroll
  for (int j = 0; j < 4; ++j)
#pragma unroll
    for (int e = 0; e < 16; ++e) acc[j][e] = 0.f;
  __syncthreads();
#pragma unroll
  for (int i = 0; i < 4; ++i) {
    __builtin_amdgcn_global_load_lds((const unsigned*)ag[i], (unsigned*)(smem + (wave * 4 + i) * 1024), 16, 0, 0);
    __builtin_amdgcn_global_load_lds((const unsigned*)bg[i], (unsigned*)(smem + 16384 + (wave * 4 + i) * 1024), 16, 0, 0);
  }
  __syncthreads();
  const int nk = K >> 6;
  for (int kt = 0; kt < nk; ++kt) {
    char* cur = smem + (kt & 1) * 32768;
    char* nxt = smem + ((kt + 1) & 1) * 32768;
    if (GV != 1 && kt + 1 < nk) {
#pragma unroll
      for (int i = 0; i < 4; ++i) {
        __builtin_amdgcn_global_load_lds((const unsigned*)(ag[i] + (kt + 1) * 64), (unsigned*)(nxt + (wave * 4 + i) * 1024), 16, 0, 0);
        __builtin_amdgcn_global_load_lds((const unsigned*)(bg[i] + (kt + 1) * 64), (unsigned*)(nxt + 16384 + (wave * 4 + i) * 1024), 16, 0, 0);
      }
    }
    const char* sa = cur + wave * 4096;
    const char* sb = cur + 16384;
    if (GV != 2) {
#pragma unroll
    for (int ks = 0; ks < 4; ++ks) {
      const bf16x8 af = *(const bf16x8*)(sa + roff[ks]);
#pragma unroll
      for (int j = 0; j < 4; ++j) {
        const bf16x8 bfr = *(const bf16x8*)(sb + j * 4096 + roff[ks]);
        acc[j] = __builtin_amdgcn_mfma_f32_32x32x16_bf16(bfr, af, acc[j], 0, 0, 0);
      }
    }
    }
    __syncthreads();
  }
  const int row = m0 + wave * 32 + r;
  if (GV == 4) { epi(row, 0, h, acc, smem); return; }
  if (GV == 5) { epi(row, 6 + (nt & 7), h, acc, smem); return; }
  if (GV != 0) { asm volatile("" :: "v"(acc[0]), "v"(acc[1]), "v"(acc[2]), "v"(acc[3])); return; }
  epi(row, nt, h, acc, smem);
}
template <class EPI>
__device__ __forceinline__ void gemm_mfma_tile(int mt, int nt, char* smem, const bf16_t* __restrict__ A, int M,
                                               const bf16_t* __restrict__ Bt, int K, const EPI& epi) {
  gemm_mfma_tile_v<0, EPI>(mt, nt, smem, A, M, Bt, K, epi);
}


template <class EPI>
__device__ __forceinline__ void gemm_mfma_tile_n256(int mt, int nt2, char* smem, const bf16_t* __restrict__ A, int M,
                                                    const bf16_t* __restrict__ Bt, int K, const EPI& epi) {
  const int t = opaque_tid(), lane = t & 63, wave = t >> 6, r = lane & 31, h = lane >> 5;
  const int m0 = mt * 128, n0 = nt2 * 256;
  const bf16_t* gsrc[6];
  int ldst[6];
#pragma unroll
  for (int i = 0; i < 6; ++i) {
    const int q = wave * 6 + i;
    const int rowl = lane >> 2, pc = lane & 3;
    const bool isA = q < 8;
    const int row = 16 * (isA ? q : q - 8) + rowl;
    const int c = pc ^ ((row >> 2) & 3);
    int ar = m0 + row;
    ar = ar < M ? ar : M - 1;
    gsrc[i] = isA ? A + (size_t)ar * K + c * 8 : Bt + (size_t)(n0 + row) * K + c * 8;
    ldst[i] = q * 1024;
  }
  int roff[2];
#pragma unroll
  for (int ks = 0; ks < 2; ++ks) roff[ks] = r * 64 + (((2 * ks + h) ^ ((r >> 2) & 3)) << 4);
  f32x16 acc[8];
#pragma unroll
  for (int j = 0; j < 8; ++j)
#pragma unroll
    for (int e = 0; e < 16; ++e) acc[j][e] = 0.f;
  __syncthreads();
  const int nk = K >> 5;
#pragma unroll
  for (int i = 0; i < 6; ++i) __builtin_amdgcn_global_load_lds((const unsigned*)gsrc[i], (unsigned*)(smem + ldst[i]), 16, 0, 0);
#pragma unroll
  for (int i = 0; i < 6; ++i) __builtin_amdgcn_global_load_lds((const unsigned*)(gsrc[i] + 32), (unsigned*)(smem + 24576 + ldst[i]), 16, 0, 0);
  asm volatile("s_waitcnt vmcnt(6)" ::: "memory");
  asm volatile("s_waitcnt lgkmcnt(0)" ::: "memory");
  __builtin_amdgcn_s_barrier();
  int cs = 0;
  for (int kt = 0; kt < nk; ++kt) {
    char* cur = smem + cs * 24576;
    const int ns = cs >= 1 ? cs - 1 : 2;
    if (kt + 2 < nk) {
      char* nxt = smem + ns * 24576;
#pragma unroll
      for (int i = 0; i < 6; ++i) __builtin_amdgcn_global_load_lds((const unsigned*)(gsrc[i] + (kt + 2) * 32), (unsigned*)(nxt + ldst[i]), 16, 0, 0);
    }
    const char* sa = cur + wave * 2048;
    const char* sb = cur + 8192;
    bf16x8 af[2], bfr[2][8];
#pragma unroll
    for (int ks = 0; ks < 2; ++ks) {
      af[ks] = *(const bf16x8*)(sa + roff[ks]);
#pragma unroll
      for (int j = 0; j < 8; ++j) bfr[ks][j] = *(const bf16x8*)(sb + j * 2048 + roff[ks]);
    }
    asm volatile("" : "+v"(af[0]), "+v"(af[1]), "+v"(bfr[0][0]), "+v"(bfr[0][1]), "+v"(bfr[0][2]), "+v"(bfr[0][3]), "+v"(bfr[0][4]), "+v"(bfr[0][5]), "+v"(bfr[0][6]), "+v"(bfr[0][7]));
    asm volatile("" : "+v"(bfr[1][0]), "+v"(bfr[1][1]), "+v"(bfr[1][2]), "+v"(bfr[1][3]), "+v"(bfr[1][4]), "+v"(bfr[1][5]), "+v"(bfr[1][6]), "+v"(bfr[1][7]));
#pragma unroll
    for (int ks = 0; ks < 2; ++ks)
#pragma unroll
      for (int j = 0; j < 8; ++j) acc[j] = __builtin_amdgcn_mfma_f32_32x32x16_bf16(bfr[ks][j], af[ks], acc[j], 0, 0, 0);
    __builtin_amdgcn_sched_barrier(0);
    if (kt + 2 < nk) asm volatile("s_waitcnt vmcnt(6)" ::: "memory");
    else asm volatile("s_waitcnt vmcnt(0)" ::: "memory");
    asm volatile("s_waitcnt lgkmcnt(0)" ::: "memory");
    __builtin_amdgcn_s_barrier();
    cs = cs == 2 ? 0 : cs + 1;
  }
  const int row = m0 + wave * 32 + r;
  epi(row, 2 * nt2, h, *reinterpret_cast<f32x16(*)[4]>(&acc[0]), smem);
  epi(row, 2 * nt2 + 1, h, *reinterpret_cast<f32x16(*)[4]>(&acc[4]), smem);
}

template <class EPI>
__device__ __forceinline__ void gemm_mfma_tile_m256(int mt2, int nt, char* smem, const bf16_t* __restrict__ A, int M,
                                                    const bf16_t* __restrict__ Bt, int K, const EPI& epi) {
  const int t = opaque_tid(), lane = t & 63, wave = t >> 6, r = lane & 31, h = lane >> 5;
  const int m0 = mt2 * 256, n0 = nt * 128;
  const bf16_t* gsrc[6];
  int ldst[6];
#pragma unroll
  for (int i = 0; i < 6; ++i) {
    const int q = wave * 6 + i;
    const int rowl = lane >> 2, pc = lane & 3;
    const bool isA = q < 16;
    const int row = 16 * (isA ? q : q - 16) + rowl;
    const int c = pc ^ ((row >> 2) & 3);
    int ar = m0 + row;
    ar = ar < M ? ar : M - 1;
    gsrc[i] = isA ? A + (size_t)ar * K + c * 8 : Bt + (size_t)(n0 + row) * K + c * 8;
    ldst[i] = q * 1024;
  }
  int roff[2];
#pragma unroll
  for (int ks = 0; ks < 2; ++ks) roff[ks] = r * 64 + (((2 * ks + h) ^ ((r >> 2) & 3)) << 4);
  f32x16 acc[8];
#pragma unroll
  for (int j = 0; j < 8; ++j)
#pragma unroll
    for (int e = 0; e < 16; ++e) acc[j][e] = 0.f;
  __syncthreads();
  const int nk = K >> 5;
#pragma unroll
  for (int i = 0; i < 6; ++i) __builtin_amdgcn_global_load_lds((const unsigned*)gsrc[i], (unsigned*)(smem + ldst[i]), 16, 0, 0);
#pragma unroll
  for (int i = 0; i < 6; ++i) __builtin_amdgcn_global_load_lds((const unsigned*)(gsrc[i] + 32), (unsigned*)(smem + 24576 + ldst[i]), 16, 0, 0);
  asm volatile("s_waitcnt vmcnt(6)" ::: "memory");
  asm volatile("s_waitcnt lgkmcnt(0)" ::: "memory");
  __builtin_amdgcn_s_barrier();
  int cs = 0;
  for (int kt = 0; kt < nk; ++kt) {
    char* cur = smem + cs * 24576;
    const int ns = cs >= 1 ? cs - 1 : 2;
    if (kt + 2 < nk) {
      char* nxt = smem + ns * 24576;
#pragma unroll
      for (int i = 0; i < 6; ++i) __builtin_amdgcn_global_load_lds((const unsigned*)(gsrc[i] + (kt + 2) * 32), (unsigned*)(nxt + ldst[i]), 16, 0, 0);
    }
    const char* sa = cur + wave * 4096;
    const char* sb = cur + 16384;
    bf16x8 af[2][2], bfr[2][4];
#pragma unroll
    for (int ks = 0; ks < 2; ++ks) {
      af[ks][0] = *(const bf16x8*)(sa + roff[ks]);
      af[ks][1] = *(const bf16x8*)(sa + 2048 + roff[ks]);
#pragma unroll
      for (int j = 0; j < 4; ++j) bfr[ks][j] = *(const bf16x8*)(sb + j * 2048 + roff[ks]);
    }
    asm volatile("" : "+v"(af[0][0]), "+v"(af[0][1]), "+v"(af[1][0]), "+v"(af[1][1]), "+v"(bfr[0][0]), "+v"(bfr[0][1]), "+v"(bfr[0][2]), "+v"(bfr[0][3]), "+v"(bfr[1][0]), "+v"(bfr[1][1]), "+v"(bfr[1][2]), "+v"(bfr[1][3]));
#pragma unroll
    for (int ks = 0; ks < 2; ++ks)
#pragma unroll
      for (int mi = 0; mi < 2; ++mi)
#pragma unroll
        for (int j = 0; j < 4; ++j) acc[4 * mi + j] = __builtin_amdgcn_mfma_f32_32x32x16_bf16(bfr[ks][j], af[ks][mi], acc[4 * mi + j], 0, 0, 0);
    __builtin_amdgcn_sched_barrier(0);
    if (kt + 2 < nk) asm volatile("s_waitcnt vmcnt(6)" ::: "memory");
    else asm volatile("s_waitcnt vmcnt(0)" ::: "memory");
    asm volatile("s_waitcnt lgkmcnt(0)" ::: "memory");
    __builtin_amdgcn_s_barrier();
    cs = cs == 2 ? 0 : cs + 1;
  }
  const int row = m0 + wave * 64 + r;
  epi(row, nt, h, *reinterpret_cast<f32x16(*)[4]>(&acc[0]), smem);
  epi(row + 32, nt, h, *reinterpret_cast<f32x16(*)[4]>(&acc[4]), smem);
}

struct EpiInProjM {
  bf16_t* P; float* out; const float2* rope;
  __device__ __forceinline__ void operator()(int row, int nt, int h, f32x16 (&acc)[4], char* smem) const {
    if (nt >= 6 && nt < 14) {
      const float sc = nt >= 10 ? 0.08838834764831845f : 1.0f;
      const float2* rp = rope + (size_t)row_pos(row) * 64;
#pragma unroll
      for (int j = 0; j < 2; ++j)
#pragma unroll
        for (int g = 0; g < 4; ++g)
#pragma unroll
          for (int i = 0; i < 4; ++i) {
            const float2 cs = rp[j * 32 + 8 * g + 4 * h + i];
            const float x1 = acc[j][4 * g + i], x2 = acc[j + 2][4 * g + i];
            acc[j][4 * g + i] = (x1 * cs.x - x2 * cs.y) * sc;
            acc[j + 2][4 * g + i] = (x1 * cs.y + x2 * cs.x) * sc;
          }
    }
    {
      const int lane = opaque_tid() & 63, wave = opaque_tid() >> 6, r = lane & 31;
      char* st = smem + wave * 8704;
#pragma unroll
      for (int j = 0; j < 4; ++j)
#pragma unroll
        for (int g = 0; g < 4; ++g) {
          uint2 w;
          w.x = pack_bf16(acc[j][4 * g], acc[j][4 * g + 1]);
          w.y = pack_bf16(acc[j][4 * g + 2], acc[j][4 * g + 3]);
          *(uint2*)(st + r * 272 + (j * 32 + 8 * g + 4 * h) * 2) = w;
        }
      const int rbase = row - r;
#pragma unroll
      for (int it = 0; it < 8; ++it) {
        const int rl = it * 4 + (lane >> 4), ch = lane & 15;
        const u32x4 v = *(const u32x4*)(st + rl * 272 + ch * 16);
        if (rbase + rl < NROWS) *(u32x4*)(P + (size_t)(rbase + rl) * PW + nt * 128 + ch * 8) = v;
      }
    }
    if (row >= NROWS) return;
    if (nt == 4 || nt == 5) {
      const bool isv = nt == 5;
#pragma unroll
      for (int j = 0; j < 4; ++j)
#pragma unroll
        for (int g = 0; g < 4; ++g) {
          const int col = j * 32 + 8 * g + 4 * h;
          const float4 val = make_float4(acc[j][4 * g], acc[j][4 * g + 1], acc[j][4 * g + 2], acc[j][4 * g + 3]);
          if (row < NPROMPT) {
            const int b = row >> 11, sidx = row & 2047;
            if (sidx >= SEQ - 128) *(float4*)(out + (isv ? O_SWAVP : O_SWAKP) + (size_t)(b * 128 + (sidx - (SEQ - 128))) * 128 + col) = val;
          } else if (row < NTOK) {
            *(float4*)(out + (isv ? O_SWAVS : O_SWAKS) + (size_t)(row - NPROMPT) * 128 + col) = val;
          } else {
            const int m = row - NTOK;
            for (int b = 0; b < NB; ++b) *(float4*)(out + (isv ? O_METAV : O_METAK) + (size_t)(b * 16 + m) * 128 + col) = val;
          }
        }
    }
  }
};

struct EpiOutProjM {
  const bf16_t* hbf; bf16_t* z;
  __device__ __forceinline__ void operator()(int row, int nt, int h, f32x16 (&acc)[4], char* smem) const {
    const int lane = opaque_tid() & 63, wave = opaque_tid() >> 6, r = lane & 31;
    char* st = smem + wave * 8704;
#pragma unroll
    for (int j = 0; j < 4; ++j)
#pragma unroll
      for (int g = 0; g < 4; ++g) {
        uint2 w;
        w.x = pack_bf16(acc[j][4 * g], acc[j][4 * g + 1]);
        w.y = pack_bf16(acc[j][4 * g + 2], acc[j][4 * g + 3]);
        *(uint2*)(st + r * 272 + (j * 32 + 8 * g + 4 * h) * 2) = w;
      }
    const int rbase = row - r;
#pragma unroll
    for (int it = 0; it < 8; ++it) {
      const int rl = it * 4 + (lane >> 4), ch = lane & 15;
      const u32x4 m = *(const u32x4*)(st + rl * 272 + ch * 16);
      const size_t off = (size_t)(rbase + rl) * D + nt * 128 + ch * 8;
      const u32x4 hv = *(const u32x4*)(hbf + off);
      u32x4 o;
#pragma unroll
      for (int q = 0; q < 4; ++q)
        o[q] = pack_bf16(ALPHA * __uint_as_float(hv[q] << 16) + __uint_as_float(m[q] << 16),
                         ALPHA * __uint_as_float(hv[q] & 0xffff0000u) + __uint_as_float(m[q] & 0xffff0000u));
      *(u32x4*)(z + off) = o;
    }
  }
};

struct EpiPlainF32M {
  float* C;
  __device__ __forceinline__ void operator()(int row, int nt, int h, f32x16 (&acc)[4], char* smem) const {
    const size_t base = (size_t)row * D + nt * 128 + 4 * h;
#pragma unroll
    for (int j = 0; j < 4; ++j)
#pragma unroll
      for (int g = 0; g < 4; ++g)
        *(float4*)(C + base + j * 32 + 8 * g) = make_float4(acc[j][4 * g], acc[j][4 * g + 1], acc[j][4 * g + 2], acc[j][4 * g + 3]);
  }
};


constexpr int NET16[63][2] = {{0,1}, {2,3}, {0,2}, {1,3}, {1,2}, {4,5}, {6,7}, {4,6}, {5,7}, {5,6}, {0,4}, {2,6}, {2,4}, {1,5}, {3,7}, {3,5}, {1,2}, {3,4}, {5,6}, {8,9}, {10,11}, {8,10}, {9,11}, {9,10}, {12,13}, {14,15}, {12,14}, {13,15}, {13,14}, {8,12}, {10,14}, {10,12}, {9,13}, {11,15}, {11,13}, {9,10}, {11,12}, {13,14}, {0,8}, {4,12}, {4,8}, {2,10}, {6,14}, {6,10}, {2,4}, {6,8}, {10,12}, {1,9}, {5,13}, {5,9}, {3,11}, {7,15}, {7,11}, {3,5}, {7,9}, {11,13}, {1,2}, {3,4}, {5,6}, {7,8}, {9,10}, {11,12}, {13,14}};
constexpr int CLEAN16[32][2] = {{0,8}, {1,9}, {2,10}, {3,11}, {4,12}, {5,13}, {6,14}, {7,15}, {0,4}, {1,5}, {2,6}, {3,7}, {8,12}, {9,13}, {10,14}, {11,15}, {0,2}, {1,3}, {4,6}, {5,7}, {8,10}, {9,11}, {12,14}, {13,15}, {0,1}, {2,3}, {4,5}, {6,7}, {8,9}, {10,11}, {12,13}, {14,15}};
constexpr int CAND_REST[34][2] = {{1,0}, {1,1}, {1,2}, {1,3}, {1,4}, {1,5}, {1,6}, {1,7}, {2,0}, {2,1}, {2,2}, {2,3}, {2,4}, {3,0}, {3,1}, {3,2}, {3,3}, {4,0}, {4,1}, {4,2}, {5,0}, {5,1}, {6,0}, {6,1}, {7,0}, {7,1}, {8,0}, {9,0}, {10,0}, {11,0}, {12,0}, {13,0}, {14,0}, {15,0}};
#define CE_DESC(a, b) { const int hi_ = max(a, b), lo_ = min(a, b); a = hi_; b = lo_; }
__device__ __forceinline__ void sort16_desc(int (&x)[16]) {
#pragma unroll
  for (int t = 0; t < 63; ++t) CE_DESC(x[NET16[t][0]], x[NET16[t][1]])
}
__device__ __forceinline__ void merge_top16(int (&a)[16], const int (&b)[16]) {
#pragma unroll
  for (int i = 0; i < 16; ++i) a[i] = max(a[i], b[15 - i]);
#pragma unroll
  for (int t = 0; t < 32; ++t) CE_DESC(a[CLEAN16[t][0]], a[CLEAN16[t][1]])
}
__device__ __forceinline__ int f2ord(float f) { const int b = __float_as_int(f); return b ^ ((b >> 31) & 0x7FFFFFFF); }
__device__ __forceinline__ float ord2f(int k) { return __int_as_float(k ^ ((k >> 31) & 0x7FFFFFFF)); }

struct EpiTopK {
  const bf16_t* subk;
  int* lidx; float* lgate;
  __device__ __forceinline__ void operator()(int row, int p, int h, f32x16 (&acc)[4], char* smem) const {
    const int tid = opaque_tid(), lane = tid & 63, wave = tid >> 6, r = lane & 31;
    char* qw = smem + wave * 8192;
    uint8_t* sl = (uint8_t*)(smem + 32768 + wave * 2048);
    char* SK = smem + 40960;
#pragma unroll
    for (int i = 0; i < 8; ++i) {
      const int qi = tid + 256 * i, c2 = qi >> 10, key = (qi >> 3) & 127, ch = qi & 7;
      *(u32x4*)(SK + c2 * 16384 + tile_off(key, ch)) = *(const u32x4*)(subk + (size_t)((p * 2 + c2) * 128 + key) * 64 + ch * 8);
    }
#pragma unroll
    for (int j = 0; j < 4; ++j)
#pragma unroll
      for (int g = 0; g < 4; ++g) {
        uint2 w;
        w.x = pack_bf16(acc[j][4 * g], acc[j][4 * g + 1]);
        w.y = pack_bf16(acc[j][4 * g + 2], acc[j][4 * g + 3]);
        *(uint2*)(qw + r * 256 + (((4 * j + g) ^ (r & 15)) << 4) + 8 * h) = w;
      }
    __syncthreads();
    int S[2][16];
#pragma unroll
    for (int c = 0; c < 2; ++c) {
      f32x16 sc[4];
#pragma unroll
      for (int mi = 0; mi < 4; ++mi)
#pragma unroll
        for (int e = 0; e < 16; ++e) sc[mi][e] = 0.f;
#pragma unroll
      for (int ks = 0; ks < 4; ++ks) {
        const bf16x8 qf = *(const bf16x8*)(qw + r * 256 + (((8 * c + 2 * ks + h) ^ (r & 15)) << 4));
#pragma unroll
        for (int mi = 0; mi < 4; ++mi) {
          const bf16x8 kf = *(const bf16x8*)(SK + c * 16384 + tile_off(32 * mi + r, 2 * ks + h));
          sc[mi] = __builtin_amdgcn_mfma_f32_32x32x16_bf16(kf, qf, sc[mi], 0, 0, 0);
        }
      }
      int L[16];
#pragma unroll
      for (int mi = 0; mi < 4; ++mi) {
        int x[16];
#pragma unroll
        for (int e = 0; e < 16; ++e) x[e] = (f2ord(sc[mi][e]) & ~127) | (32 * mi + (e & 3) + 8 * (e >> 2) + 4 * h);
        sort16_desc(x);
        if (mi == 0) {
#pragma unroll
          for (int e = 0; e < 16; ++e) L[e] = x[e];
        } else merge_top16(L, x);
      }
      int Pn[16];
#pragma unroll
      for (int e = 0; e < 16; ++e) Pn[e] = __shfl_xor(L[e], 32);
      merge_top16(L, Pn);
#pragma unroll
      for (int e = 0; e < 16; ++e) { S[c][e] = L[e]; sl[(c * 16 + e) * 64 + lane] = (uint8_t)(L[e] & 127); }
    }
    float f0[16], f1[16];
#pragma unroll
    for (int e = 0; e < 16; ++e) { f0[e] = ord2f(S[0][e]); f1[e] = ord2f(S[1][e]); }
    int T[16];
#pragma unroll
    for (int b = 0; b < 16; ++b) T[b] = (f2ord(f0[0] + f1[b]) & ~255) | (15 - b);
#pragma unroll
    for (int gi = 0; gi < 3; ++gi) {
      int x[16];
#pragma unroll
      for (int e = 0; e < 16; ++e) {
        const int ci = gi * 16 + e;
        if (ci < 34) x[e] = (f2ord(f0[CAND_REST[ci][0]] + f1[CAND_REST[ci][1]]) & ~255) | (CAND_REST[ci][0] << 4) | (15 - CAND_REST[ci][1]);
        else x[e] = (int)0x80000000;
      }
      sort16_desc(x);
      merge_top16(T, x);
    }
    float ev[16], den = 0.f;
    const float vmax = ord2f(T[0]);
#pragma unroll
    for (int k = 0; k < 16; ++k) { ev[k] = __expf(ord2f(T[k]) - vmax); den += ev[k]; }
    const float inv = 1.0f / den;
    int eo[16];
#pragma unroll
    for (int k = 0; k < 16; ++k) {
      const int ab = T[k] & 255;
      const int i1 = sl[(ab >> 4) * 64 + lane], i2 = sl[(16 + 15 - (ab & 15)) * 64 + lane];
      eo[k] = i1 * 128 + i2;
    }
    if (h == 0) {
      int* lp = lidx + (size_t)row * 128 + p * 16;
      float* gp = lgate + (size_t)row * 128 + p * 16;
#pragma unroll
      for (int q = 0; q < 4; ++q) {
        *(int4*)(lp + 4 * q) = make_int4(eo[4 * q], eo[4 * q + 1], eo[4 * q + 2], eo[4 * q + 3]);
        *(float4*)(gp + 4 * q) = make_float4(ev[4 * q] * inv, ev[4 * q + 1] * inv, ev[4 * q + 2] * inv, ev[4 * q + 3] * inv);
      }
    }
  }
};

__device__ __forceinline__ void transpose_tile(int kt, int ntile, char* smem, const float* __restrict__ W, int N, int K, bf16_t* __restrict__ Wt) {
  float (*T)[65] = (float (*)[65])smem;
  const int t = opaque_tid();
  __syncthreads();
#pragma unroll
  for (int pss = 0; pss < 4; ++pss) {
    const int kk = pss * 16 + (t >> 4), nn = (t & 15) * 4;
    const float4 v = *(const float4*)(W + (size_t)(kt * 64 + kk) * N + ntile * 64 + nn);
    T[kk][nn] = v.x; T[kk][nn + 1] = v.y; T[kk][nn + 2] = v.z; T[kk][nn + 3] = v.w;
  }
  __syncthreads();
#pragma unroll
  for (int pss = 0; pss < 4; ++pss) {
    const int nn = pss * 16 + (t >> 4), kk = (t & 15) * 4;
    uint2 w;
    w.x = pack_bf16(T[kk][nn], T[kk + 1][nn]);
    w.y = pack_bf16(T[kk + 2][nn], T[kk + 3][nn]);
    *(uint2*)(Wt + (size_t)(ntile * 64 + nn) * K + kt * 64 + kk) = w;
  }
}


__device__ __forceinline__ float wave_max(float v) {
  v = fmaxf(v, lane_xor_f<1>(v)); v = fmaxf(v, lane_xor_f<2>(v)); v = fmaxf(v, lane_xor_f<4>(v));
  v = fmaxf(v, lane_xor_f<8>(v)); v = fmaxf(v, lane_xor_f<16>(v)); v = fmaxf(v, lane_xor_f<32>(v));
  return v;
}

__device__ __forceinline__ float quant_row_regs(const float4 (&v)[4], int lane, uint8_t* __restrict__ dst, bool biased) {
  float m = 0.f;
#pragma unroll
  for (int i = 0; i < 4; ++i) m = fmaxf(m, fmaxf(fmaxf(fabsf(v[i].x), fabsf(v[i].y)), fmaxf(fabsf(v[i].z), fabsf(v[i].w))));
  m = wave_max(m);
  const float scale = m * (1.0f / 127.0f);
  const float inv = m > 0.f ? 127.0f / m : 0.f;
  u32x4 w;
#pragma unroll
  for (int i = 0; i < 4; ++i) {
    int a = (int)rintf(v[i].x * inv), b = (int)rintf(v[i].y * inv), c = (int)rintf(v[i].z * inv), d = (int)rintf(v[i].w * inv);
    if (biased) { a += 128; b += 128; c += 128; d += 128; }
    w[i] = (uint32_t)(a & 255) | ((uint32_t)(b & 255) << 8) | ((uint32_t)(c & 255) << 16) | ((uint32_t)(d & 255) << 24);
  }
  *(u32x4*)(dst + lane * 16) = w;
  return scale;
}

__device__ __forceinline__ void quant_table_row(const float* __restrict__ src, int lane, uint8_t* __restrict__ dst, float* __restrict__ sc, bool biased) {
  float4 v[4];
#pragma unroll
  for (int i = 0; i < 4; ++i) v[i] = *(const float4*)(src + 256 * i + 4 * lane);
  const float scale = quant_row_regs(v, lane, dst, biased);
  if (lane == 0) *sc = scale;
}


template <int NR>
__device__ __forceinline__ void ln_in_rows(const int (&rows)[NR], int lane, const float* __restrict__ xp, const float* __restrict__ xs,
                                           const float* __restrict__ meta, const float* __restrict__ g, const float* __restrict__ b,
                                           bf16_t* __restrict__ hbf) {
  float4 v[NR][4];
#pragma unroll
  for (int n = 0; n < NR; ++n) {
    const int r = rows[n];
    const float* src = r < NPROMPT ? xp + (size_t)r * D : (r < NTOK ? xs + (size_t)(r - NPROMPT) * D : meta + (size_t)(r - NTOK) * D);
#pragma unroll
    for (int i = 0; i < 4; ++i) v[n][i] = *(const float4*)(src + 256 * i + 4 * lane);
  }
  float4 gg[4], bb[4];
#pragma unroll
  for (int i = 0; i < 4; ++i) { gg[i] = *(const float4*)(g + 256 * i + 4 * lane); bb[i] = *(const float4*)(b + 256 * i + 4 * lane); }
#pragma unroll
  for (int n = 0; n < NR; ++n) {
    float sum = 0.f;
#pragma unroll
    for (int i = 0; i < 4; ++i) sum += (v[n][i].x + v[n][i].y) + (v[n][i].z + v[n][i].w);
    const float mean = wave_sum(sum) * (1.0f / D);
    float sq = 0.f;
#pragma unroll
    for (int i = 0; i < 4; ++i) { v[n][i].x -= mean; v[n][i].y -= mean; v[n][i].z -= mean; v[n][i].w -= mean; sq += (v[n][i].x * v[n][i].x + v[n][i].y * v[n][i].y) + (v[n][i].z * v[n][i].z + v[n][i].w * v[n][i].w); }
    const float rstd = rsqrtf(wave_sum(sq) * (1.0f / D) + LN_EPS);
#pragma unroll
    for (int i = 0; i < 4; ++i) {
      uint2 w;
      w.x = pack_bf16(v[n][i].x * rstd * gg[i].x + bb[i].x, v[n][i].y * rstd * gg[i].y + bb[i].y);
      w.y = pack_bf16(v[n][i].z * rstd * gg[i].z + bb[i].z, v[n][i].w * rstd * gg[i].w + bb[i].w);
      *(uint2*)(hbf + (size_t)rows[n] * D + 256 * i + 4 * lane) = w;
    }
  }
}
template <int NR>
__device__ __forceinline__ void ln1_rows(const int (&rows)[NR], int lane, const bf16_t* __restrict__ z, const float* __restrict__ g,
                                         const float* __restrict__ b, bf16_t* __restrict__ h1bf, uint8_t* __restrict__ xq, float* __restrict__ xs) {
  uint2 zz[NR][4];
#pragma unroll
  for (int n = 0; n < NR; ++n)
#pragma unroll
    for (int i = 0; i < 4; ++i) zz[n][i] = *(const uint2*)(z + (size_t)rows[n] * D + 256 * i + 4 * lane);
  float4 gg[4], bb[4];
#pragma unroll
  for (int i = 0; i < 4; ++i) { gg[i] = *(const float4*)(g + 256 * i + 4 * lane); bb[i] = *(const float4*)(b + 256 * i + 4 * lane); }
#pragma unroll
  for (int n = 0; n < NR; ++n) {
    float4 v[4];
    float sum = 0.f;
#pragma unroll
    for (int i = 0; i < 4; ++i) {
      v[i].x = __uint_as_float(zz[n][i].x << 16); v[i].y = __uint_as_float(zz[n][i].x & 0xffff0000u);
      v[i].z = __uint_as_float(zz[n][i].y << 16); v[i].w = __uint_as_float(zz[n][i].y & 0xffff0000u);
      sum += (v[i].x + v[i].y) + (v[i].z + v[i].w);
    }
    const float mean = wave_sum(sum) * (1.0f / D);
    float sq = 0.f;
#pragma unroll
    for (int i = 0; i < 4; ++i) { v[i].x -= mean; v[i].y -= mean; v[i].z -= mean; v[i].w -= mean; sq += (v[i].x * v[i].x + v[i].y * v[i].y) + (v[i].z * v[i].z + v[i].w * v[i].w); }
    const float rstd = rsqrtf(wave_sum(sq) * (1.0f / D) + LN_EPS);
#pragma unroll
    for (int i = 0; i < 4; ++i) {
      v[i].x = v[i].x * rstd * gg[i].x + bb[i].x; v[i].y = v[i].y * rstd * gg[i].y + bb[i].y; v[i].z = v[i].z * rstd * gg[i].z + bb[i].z; v[i].w = v[i].w * rstd * gg[i].w + bb[i].w;
      uint2 w;
      w.x = pack_bf16(v[i].x, v[i].y); w.y = pack_bf16(v[i].z, v[i].w);
      *(uint2*)(h1bf + (size_t)rows[n] * D + 256 * i + 4 * lane) = w;
    }
    const float scale = quant_row_regs(v, lane, xq + (size_t)rows[n] * 1024, false);
    if (lane == 0) xs[rows[n]] = scale;
  }
}

struct SweepArgs {
  const int* lidx; const float* lgate; const uint8_t* U8; const uint8_t* V8; const float* su; const float* sv;
  const uint8_t* xq; const float* xs; const bf16_t* h1; const float* g2; const float* b2; float* y;
};

#ifndef SG_CACHE
#define SG_CACHE ""
#endif
#define SG_KMAX 256
#define SG_K0 192
#define SG_LDS_PER_WAVE (4 * SG_KMAX * 16)
static_assert(SG_KMAX % 16 == 0 && 4 * SG_LDS_PER_WAVE <= 73728, "schedule ring: bubble init covers 16 slots per pass; 4 waves must fit the LDS buffer");

template <int CTRL> __device__ __forceinline__ int dpp_mov_i(int x) { return __builtin_amdgcn_mov_dpp(x, CTRL, 0xF, 0xF, true); }
__device__ __forceinline__ int row_sum_i(int v) {
  v += dpp_mov_i<0x128>(v); v += dpp_mov_i<0x124>(v); v += dpp_mov_i<0x122>(v); v += dpp_mov_i<0x121>(v);
  return v;
}
__device__ __forceinline__ float row_sum_f(float v) {
  v += __int_as_float(dpp_mov_i<0x128>(__float_as_int(v))); v += __int_as_float(dpp_mov_i<0x124>(__float_as_int(v)));
  v += __int_as_float(dpp_mov_i<0x122>(__float_as_int(v))); v += __int_as_float(dpp_mov_i<0x121>(__float_as_int(v)));
  return v;
}
__device__ __forceinline__ int row_xor_i(int x, int m) {
  return m == 1 ? lane_xor_i<1>(x) : (m == 2 ? lane_xor_i<2>(x) : (m == 4 ? lane_xor_i<4>(x) : lane_xor_i<8>(x)));
}

typedef _Float16 h16x2 __attribute__((ext_vector_type(2)));
template <int KP> __device__ __forceinline__ h16x2 ub_pair_f16(uint32_t d) {
  const uint32_t bits = __builtin_amdgcn_perm(0x64646464u, d, (4u << 24) | ((unsigned)(2 * KP + 1) << 16) | (4u << 8) | (unsigned)(2 * KP));
  h16x2 r;
  __builtin_memcpy(&r, &bits, 4);
  return r;
}
__device__ __forceinline__ float sg_fmix_lo(float acc, float w, uint32_t p) { asm("v_fma_mix_f32 %0, %1, %2, %0 op_sel:[0,0,0] op_sel_hi:[0,1,0]" : "+v"(acc) : "v"(w), "v"(p)); return acc; }
__device__ __forceinline__ float sg_fmix_hi(float acc, float w, uint32_t p) { asm("v_fma_mix_f32 %0, %1, %2, %0 op_sel:[0,1,0] op_sel_hi:[0,1,0]" : "+v"(acc) : "v"(w), "v"(p)); return acc; }
template <int KP> __device__ __forceinline__ uint32_t ub_pair_bits(uint32_t d) {
  return __builtin_amdgcn_perm(0x64646464u, d, (4u << 24) | ((unsigned)(2 * KP + 1) << 16) | (4u << 8) | (unsigned)(2 * KP));
}
struct SgBuf { u32x4 u[4]; u32x4 v[4]; };

template <int OFF> __device__ __forceinline__ void asm_bload(u32x4& dst, int voff, const u32x4& rs) {
  asm volatile("buffer_load_dwordx4 %0, %1, %2, 0 offen offset:%3 " SG_CACHE : "+v"(dst) : "v"(voff), "s"(rs), "n"(OFF));
}
__device__ __forceinline__ void sg_issue(const u32x4& ent, int c16, const u32x4& rsU, const u32x4& rsV, SgBuf& b) {
  const int off = (int)ent[0] * 2048 + c16;
  asm_bload<0>(b.u[0], off, rsU); asm_bload<256>(b.u[1], off, rsU); asm_bload<512>(b.u[2], off, rsU); asm_bload<768>(b.u[3], off, rsU);
  asm_bload<0>(b.v[0], off, rsV); asm_bload<256>(b.v[1], off, rsV); asm_bload<512>(b.v[2], off, rsV); asm_bload<768>(b.v[3], off, rsV);
}

template <int VAR>
__device__ __forceinline__ void sg_half(u32x4& ent, const u32x4& entN, SgBuf& b, const u32x4 (&x)[4], f32x16 (&acc)[4], float& corr,
                                        int c16, const u32x4& rsU, const u32x4& rsV) {
  if (VAR != 2) asm volatile("s_waitcnt vmcnt(12)" : "+v"(b.u[0]), "+v"(b.u[1]), "+v"(b.u[2]), "+v"(b.u[3]));
  int d0 = 0, d1 = 0, d2 = 0, d3 = 0;
#pragma unroll
  for (int q = 0; q < 4; ++q) {
    d0 = __builtin_amdgcn_sdot4((int)b.u[0][q], (int)x[0][q], d0, false);
    d1 = __builtin_amdgcn_sdot4((int)b.u[1][q], (int)x[1][q], d1, false);
    d2 = __builtin_amdgcn_sdot4((int)b.u[2][q], (int)x[2][q], d2, false);
    d3 = __builtin_amdgcn_sdot4((int)b.u[3][q], (int)x[3][q], d3, false);
  }
  int dd = (d0 + d1) + (d2 + d3);
  asm volatile("" : "+v"(dd));
  const int offN = (int)entN[0] * 2048 + c16;
  if (VAR != 2) { asm_bload<0>(b.u[0], offN, rsU); asm_bload<256>(b.u[1], offN, rsU); asm_bload<512>(b.u[2], offN, rsU); asm_bload<768>(b.u[3], offN, rsU); }
  else asm volatile("" : "+v"(b.u[0]), "+v"(b.u[1]), "+v"(b.u[2]), "+v"(b.u[3]) : "v"(offN));
  dd = row_sum_i(dd);
  const float pre = (float)dd * __uint_as_float(ent[1]);
  const float uu = 1.5957691216057308f * (pre + 0.044715f * pre * pre * pre);
  const float act = pre * __builtin_amdgcn_rcpf(1.0f + __expf(-uu));
  const float w = act * __uint_as_float(ent[2]);
#define SG_VPIECE(I, OFFB)                                                                   \
  {                                                                                          \
    if (VAR != 2) asm volatile("s_waitcnt vmcnt(15)" : "+v"(b.v[I]));                        \
    if (VAR != 1) _Pragma("unroll") for (int q = 0; q < 4; ++q) {                            \
      const uint32_t d = b.v[I][q];                                                          \
      const uint32_t p0 = ub_pair_bits<0>(d), p1 = ub_pair_bits<1>(d);                       \
      acc[I][4 * q + 0] = sg_fmix_lo(acc[I][4 * q + 0], w, p0);                              \
      acc[I][4 * q + 1] = sg_fmix_hi(acc[I][4 * q + 1], w, p0);                              \
      acc[I][4 * q + 2] = sg_fmix_lo(acc[I][4 * q + 2], w, p1);                              \
      acc[I][4 * q + 3] = sg_fmix_hi(acc[I][4 * q + 3], w, p1);                              \
    }                                                                                        \
    asm volatile("" : "+v"(acc[I]));                                                         \
    if (VAR != 2) asm_bload<OFFB>(b.v[I], offN, rsV);                                        \
    else asm volatile("" : "+v"(b.v[I]));                                                    \
  }
  SG_VPIECE(0, 0) SG_VPIECE(1, 256) SG_VPIECE(2, 512) SG_VPIECE(3, 768)
#undef SG_VPIECE
  corr += w;
  asm volatile("" : "+v"(corr));
  ent = entN;
}

template <bool NOSTORE>
__device__ __forceinline__ void sweep_groups(int tokbase, int lane, char* lds, const SweepArgs& a, int rot = 0, unsigned long long t0 = 0ull, int dticks = 0) {
#if defined(PROBE_CUT) && PROBE_CUT == 0
  if (NOSTORE) return;
#endif
  const int g = lane >> 4, c = lane & 15, c16 = c * 16;
  const int tok = tokbase + g;
  u32x4* sched = (u32x4*)lds + g * SG_KMAX;
  int K[8];
  {
    const int4 e0 = *(const int4*)(a.lidx + (size_t)tok * 128 + c * 8), e1 = *(const int4*)(a.lidx + (size_t)tok * 128 + c * 8 + 4);
    K[0] = (((e0.x - rot) & 16383) << 7) | (c * 8 + 0); K[1] = (((e0.y - rot) & 16383) << 7) | (c * 8 + 1);
    K[2] = (((e0.z - rot) & 16383) << 7) | (c * 8 + 2); K[3] = (((e0.w - rot) & 16383) << 7) | (c * 8 + 3);
    K[4] = (((e1.x - rot) & 16383) << 7) | (c * 8 + 4); K[5] = (((e1.y - rot) & 16383) << 7) | (c * 8 + 5);
    K[6] = (((e1.z - rot) & 16383) << 7) | (c * 8 + 6); K[7] = (((e1.w - rot) & 16383) << 7) | (c * 8 + 7);
  }
#pragma unroll
  for (int k = 2; k <= 128; k <<= 1) {
#pragma unroll
    for (int j = k >> 1; j > 0; j >>= 1) {
      if (j >= 8) {
        const int lj = j >> 3;
        const bool upper = (c & lj) != 0;
        const bool desc = (k < 128) && ((c & (k >> 3)) != 0);
        const bool keepmax = upper != desc;
#pragma unroll
        for (int r = 0; r < 8; ++r) {
          const int o = row_xor_i(K[r], lj);
          const int mn = min(K[r], o), mx = max(K[r], o);
          K[r] = keepmax ? mx : mn;
        }
      } else {
#pragma unroll
        for (int r = 0; r < 8; ++r) {
          if ((r & j) == 0) {
            const int pp = r | j;
            const int mn = min(K[r], K[pp]), mx = max(K[r], K[pp]);
            if (k >= 8) {
              const bool desc = (k < 128) && ((c & (k >> 3)) != 0);
              K[r] = desc ? mx : mn; K[pp] = desc ? mn : mx;
            } else {
              const bool desc = (r & k) != 0;
              K[r] = desc ? mx : mn; K[pp] = desc ? mn : mx;
            }
          }
        }
      }
    }
  }
#if defined(PROBE_CUT) && PROBE_CUT == 1
  if (NOSTORE) { asm volatile("" :: "v"(K[0]), "v"(K[1]), "v"(K[2]), "v"(K[3]), "v"(K[4]), "v"(K[5]), "v"(K[6]), "v"(K[7])); return; }
#endif
  int tt[8];
  {
    int av[8], fw[8], bw[8];
    int run = -100000;
#pragma unroll
    for (int r = 0; r < 8; ++r) {
      av[r] = (((K[r] >> 7) * SG_K0) >> 14) - (c * 8 + r);
      run = max(run, av[r]);
      fw[r] = run;
    }
    int sc = run;
    sc = max(sc, __builtin_amdgcn_update_dpp(-100000, sc, 0x111, 0xF, 0xF, false));
    sc = max(sc, __builtin_amdgcn_update_dpp(-100000, sc, 0x112, 0xF, 0xF, false));
    sc = max(sc, __builtin_amdgcn_update_dpp(-100000, sc, 0x114, 0xF, 0xF, false));
    sc = max(sc, __builtin_amdgcn_update_dpp(-100000, sc, 0x118, 0xF, 0xF, false));
    const int exclF = __builtin_amdgcn_update_dpp(-100000, sc, 0x111, 0xF, 0xF, false);
    int rmin = 100000;
#pragma unroll
    for (int r = 7; r >= 0; --r) { rmin = min(rmin, av[r]); bw[r] = rmin; }
    int sb = rmin;
    sb = min(sb, __builtin_amdgcn_update_dpp(100000, sb, 0x101, 0xF, 0xF, false));
    sb = min(sb, __builtin_amdgcn_update_dpp(100000, sb, 0x102, 0xF, 0xF, false));
    sb = min(sb, __builtin_amdgcn_update_dpp(100000, sb, 0x104, 0xF, 0xF, false));
    sb = min(sb, __builtin_amdgcn_update_dpp(100000, sb, 0x108, 0xF, 0xF, false));
    const int exclB = __builtin_amdgcn_update_dpp(100000, sb, 0x101, 0xF, 0xF, false);
#pragma unroll
    for (int r = 0; r < 8; ++r) tt[r] = c * 8 + r + ((max(fw[r], exclF) + min(bw[r], exclB)) >> 1);
    const int t0g = __builtin_amdgcn_readlane(tt[0], 0), t1g = __builtin_amdgcn_readlane(tt[0], 16), t2g = __builtin_amdgcn_readlane(tt[0], 32), t3g = __builtin_amdgcn_readlane(tt[0], 48);
    const int tg = g == 0 ? t0g : (g == 1 ? t1g : (g == 2 ? t2g : t3g));
    const int sh = tg < 0 ? -tg : 0;
#pragma unroll
    for (int r = 0; r < 8; ++r) tt[r] += sh;
  }
  int Kw = max(max(__builtin_amdgcn_readlane(tt[7], 15), __builtin_amdgcn_readlane(tt[7], 31)),
               max(__builtin_amdgcn_readlane(tt[7], 47), __builtin_amdgcn_readlane(tt[7], 63))) + 1;
  if (Kw > SG_KMAX) {
#pragma unroll
    for (int r = 0; r < 8; ++r) tt[r] = c * 8 + r;
    Kw = 128;
  }
  Kw = (Kw + 1) & ~1;
  {
#pragma unroll
    for (int q = 0; q < SG_KMAX / 16; ++q) {
      const int t = c + 16 * q;
      u32x4 bub; bub[0] = 0u; bub[1] = 0; bub[2] = 0; bub[3] = 0;
      sched[t] = bub;
    }
    const float xsc = a.xs[tok];
#pragma unroll
    for (int r = 0; r < 8; ++r) {
      const int e = ((K[r] >> 7) + rot) & 16383, jp = K[r] & 127;
      u32x4 ent;
#ifdef PROBE_EMASK
      ent[0] = NOSTORE ? ((uint32_t)e & PROBE_EMASK) : (uint32_t)e;
#else
      ent[0] = (uint32_t)e;
#endif
      ent[1] = __float_as_uint(a.su[e] * xsc);
      ent[2] = __float_as_uint(a.lgate[(size_t)tok * 128 + jp] * a.sv[e]);
      ent[3] = 0;
      sched[tt[r]] = ent;
    }
  }
#if defined(PROBE_CUT) && PROBE_CUT == 2
  if (NOSTORE) return;
#endif
  u32x4 x[4];
#pragma unroll
  for (int i = 0; i < 4; ++i) x[i] = *(const u32x4*)(a.xq + (size_t)tok * 1024 + 256 * i + c16);
  f32x16 acc[4];
#pragma unroll
  for (int i = 0; i < 4; ++i)
#pragma unroll
    for (int e = 0; e < 16; ++e) acc[i][e] = 0.f;
  float corr = 0.f;
  u32x4 rsU, rsV;
  {
    const uint64_t pu = (uint64_t)a.U8, pv = (uint64_t)a.V8;
    rsU[0] = (uint32_t)__builtin_amdgcn_readfirstlane((int)(uint32_t)pu); rsU[1] = (uint32_t)__builtin_amdgcn_readfirstlane((int)(uint32_t)(pu >> 32)) & 0xffffu;
    rsU[2] = 16384u * 2048u; rsU[3] = 0x00020000u;
    rsV[0] = (uint32_t)__builtin_amdgcn_readfirstlane((int)(uint32_t)pv); rsV[1] = (uint32_t)__builtin_amdgcn_readfirstlane((int)(uint32_t)(pv >> 32)) & 0xffffu;
    rsV[2] = 16384u * 2048u - 1024u; rsV[3] = 0x00020000u;
  }
  SgBuf bA, bB;
#pragma unroll
  for (int i = 0; i < 4; ++i) { bA.u[i] = make_u32x4_zero(); bA.v[i] = make_u32x4_zero(); bB.u[i] = make_u32x4_zero(); bB.v[i] = make_u32x4_zero(); }
  asm volatile("s_waitcnt vmcnt(0)" ::: "memory");
  u32x4 entA = sched[0], entB = sched[1];
  sg_issue(entA, c16, rsU, rsV, bA);
  sg_issue(entB, c16, rsU, rsV, bB);
#ifdef PROBE_SG_NOLOOP
  if (NOSTORE) Kw = 0;
#endif
#ifdef PROBE_LOOPVAR
  constexpr int LV = NOSTORE ? PROBE_LOOPVAR : 0;
#else
  constexpr int LV = 0;
#endif
  for (int k = 0; k < Kw; k += 2) {
    if (dticks > 0 && (k & 15) == 0) {
      const unsigned long long target = t0 + (unsigned long long)(k * dticks);
      while (__builtin_amdgcn_s_memrealtime() < target) __builtin_amdgcn_s_sleep(2);
    }
    const u32x4 nA = sched[(k + 2 < Kw) ? k + 2 : 0];
    const u32x4 nB = sched[(k + 3 < Kw) ? k + 3 : 0];
    sg_half<LV>(entA, nA, bA, x, acc, corr, c16, rsU, rsV);
    __builtin_amdgcn_sched_barrier(0);
    sg_half<LV>(entB, nB, bB, x, acc, corr, c16, rsU, rsV);
    __builtin_amdgcn_sched_barrier(0);
  }
  asm volatile("s_waitcnt vmcnt(0)" : "+v"(bA.u[0]), "+v"(bA.u[1]), "+v"(bA.u[2]), "+v"(bA.u[3]), "+v"(bA.v[0]), "+v"(bA.v[1]), "+v"(bA.v[2]), "+v"(bA.v[3]));
  asm volatile("" : "+v"(bB.u[0]), "+v"(bB.u[1]), "+v"(bB.u[2]), "+v"(bB.u[3]), "+v"(bB.v[0]), "+v"(bB.v[1]), "+v"(bB.v[2]), "+v"(bB.v[3]));
#if defined(PROBE_CUT) && PROBE_CUT == 3
  if (NOSTORE) { asm volatile("" :: "v"(acc[0]), "v"(acc[1]), "v"(acc[2]), "v"(acc[3]), "v"(corr)); return; }
#endif
  const float c128 = 1152.0f * corr;
  float sum = 0.f;
#pragma unroll
  for (int i = 0; i < 4; ++i)
#pragma unroll
    for (int q = 0; q < 4; ++q) {
      const uint2 hb = *(const uint2*)(a.h1 + (size_t)tok * D + 256 * q + 4 * (16 * i + c));
      const float4 hh = make_float4(__uint_as_float(hb.x << 16), __uint_as_float(hb.x & 0xffff0000u), __uint_as_float(hb.y << 16), __uint_as_float(hb.y & 0xffff0000u));
      acc[i][4 * q + 0] = ALPHA * hh.x + (acc[i][4 * q + 0] - c128);
      acc[i][4 * q + 1] = ALPHA * hh.y + (acc[i][4 * q + 1] - c128);
      acc[i][4 * q + 2] = ALPHA * hh.z + (acc[i][4 * q + 2] - c128);
      acc[i][4 * q + 3] = ALPHA * hh.w + (acc[i][4 * q + 3] - c128);
      sum += (acc[i][4 * q + 0] + acc[i][4 * q + 1]) + (acc[i][4 * q + 2] + acc[i][4 * q + 3]);
    }
  const float mean = row_sum_f(sum) * (1.0f / D);
  float sq = 0.f;
#pragma unroll
  for (int i = 0; i < 4; ++i)
#pragma unroll
    for (int e = 0; e < 16; ++e) { acc[i][e] -= mean; sq += acc[i][e] * acc[i][e]; }
  const float rstd = rsqrtf(row_sum_f(sq) * (1.0f / D) + LN_EPS);
#pragma unroll
  for (int i = 0; i < 4; ++i)
#pragma unroll
    for (int q = 0; q < 4; ++q) {
      const int col = 256 * q + 4 * (16 * i + c);
      const float4 gg = *(const float4*)(a.g2 + col), bb = *(const float4*)(a.b2 + col);
      float4 o;
      o.x = acc[i][4 * q + 0] * rstd * gg.x + bb.x;
      o.y = acc[i][4 * q + 1] * rstd * gg.y + bb.y;
      o.z = acc[i][4 * q + 2] * rstd * gg.z + bb.z;
      o.w = acc[i][4 * q + 3] * rstd * gg.w + bb.w;
      if (!NOSTORE) *(float4*)(a.y + (size_t)tok * D + col) = o;
      else asm volatile("" :: "v"(o.x), "v"(o.y), "v"(o.z), "v"(o.w));
    }
}


__device__ __forceinline__ void sweep_mini(int tok, int lane, int wave, char* smem, const SweepArgs& a) {
  const int g = lane >> 4, c = lane & 15, c16 = c * 16, gi = wave * 4 + g;
  u32x4* sched = (u32x4*)(smem + wave * SG_LDS_PER_WAVE) + g * SG_KMAX;
  __syncthreads();
  if (c < 8) {
    const int jp = gi * 8 + c;
    const int e = a.lidx[(size_t)tok * 128 + jp];
    u32x4 ent;
    ent[0] = (uint32_t)e;
    ent[1] = __float_as_uint(a.su[e] * a.xs[tok]);
    ent[2] = __float_as_uint(a.lgate[(size_t)tok * 128 + jp] * a.sv[e]);
    ent[3] = 0;
    sched[c] = ent;
  }
  u32x4 x[4];
#pragma unroll
  for (int i = 0; i < 4; ++i) x[i] = *(const u32x4*)(a.xq + (size_t)tok * 1024 + 256 * i + c16);
  f32x16 acc[4];
#pragma unroll
  for (int i = 0; i < 4; ++i)
#pragma unroll
    for (int e = 0; e < 16; ++e) acc[i][e] = 0.f;
  float corr = 0.f;
  u32x4 rsU, rsV;
  {
    const uint64_t pu = (uint64_t)a.U8, pv = (uint64_t)a.V8;
    rsU[0] = (uint32_t)__builtin_amdgcn_readfirstlane((int)(uint32_t)pu); rsU[1] = (uint32_t)__builtin_amdgcn_readfirstlane((int)(uint32_t)(pu >> 32)) & 0xffffu;
    rsU[2] = 16384u * 2048u; rsU[3] = 0x00020000u;
    rsV[0] = (uint32_t)__builtin_amdgcn_readfirstlane((int)(uint32_t)pv); rsV[1] = (uint32_t)__builtin_amdgcn_readfirstlane((int)(uint32_t)(pv >> 32)) & 0xffffu;
    rsV[2] = 16384u * 2048u - 1024u; rsV[3] = 0x00020000u;
  }
  SgBuf bA, bB;
#pragma unroll
  for (int i = 0; i < 4; ++i) { bA.u[i] = make_u32x4_zero(); bA.v[i] = make_u32x4_zero(); bB.u[i] = make_u32x4_zero(); bB.v[i] = make_u32x4_zero(); }
  asm volatile("s_waitcnt vmcnt(0)" ::: "memory");
  u32x4 entA = sched[0], entB = sched[1];
  sg_issue(entA, c16, rsU, rsV, bA);
  sg_issue(entB, c16, rsU, rsV, bB);
#pragma unroll 1
  for (int k = 0; k < 8; k += 2) {
    const u32x4 nA = sched[(k + 2 < 8) ? k + 2 : 0];
    const u32x4 nB = sched[(k + 3 < 8) ? k + 3 : 0];
    sg_half<0>(entA, nA, bA, x, acc, corr, c16, rsU, rsV);
    __builtin_amdgcn_sched_barrier(0);
    sg_half<0>(entB, nB, bB, x, acc, corr, c16, rsU, rsV);
    __builtin_amdgcn_sched_barrier(0);
  }
  asm volatile("s_waitcnt vmcnt(0)" : "+v"(bA.u[0]), "+v"(bA.u[1]), "+v"(bA.u[2]), "+v"(bA.u[3]), "+v"(bA.v[0]), "+v"(bA.v[1]), "+v"(bA.v[2]), "+v"(bA.v[3]));
  asm volatile("" : "+v"(bB.u[0]), "+v"(bB.u[1]), "+v"(bB.u[2]), "+v"(bB.u[3]), "+v"(bB.v[0]), "+v"(bB.v[1]), "+v"(bB.v[2]), "+v"(bB.v[3]));
#pragma unroll
  for (int i = 0; i < 4; ++i)
#pragma unroll
    for (int e = 0; e < 16; ++e) { float v = acc[i][e]; v += lane_xor_f<16>(v); v += lane_xor_f<32>(v); acc[i][e] = v; }
  corr += lane_xor_f<16>(corr); corr += lane_xor_f<32>(corr);
  __syncthreads();
  float* part = (float*)smem;
  if (lane < 16) {
#pragma unroll
    for (int i = 0; i < 4; ++i)
#pragma unroll
      for (int e = 0; e < 16; ++e) part[(wave * 16 + c) * 65 + 16 * i + e] = acc[i][e];
    part[(wave * 16 + c) * 65 + 64] = corr;
  }
  __syncthreads();
  if (wave == 0) {
#pragma unroll
    for (int w2 = 1; w2 < 4; ++w2) {
#pragma unroll
      for (int i = 0; i < 4; ++i)
#pragma unroll
        for (int e = 0; e < 16; ++e) acc[i][e] += part[(w2 * 16 + c) * 65 + 16 * i + e];
      corr += part[(w2 * 16 + c) * 65 + 64];
    }
    const float c128 = 1152.0f * corr;
    float sum = 0.f;
#pragma unroll
    for (int i = 0; i < 4; ++i)
#pragma unroll
      for (int q = 0; q < 4; ++q) {
        const uint2 hb = *(const uint2*)(a.h1 + (size_t)tok * D + 256 * q + 4 * (16 * i + c));
        const float4 hh = make_float4(__uint_as_float(hb.x << 16), __uint_as_float(hb.x & 0xffff0000u), __uint_as_float(hb.y << 16), __uint_as_float(hb.y & 0xffff0000u));
        acc[i][4 * q + 0] = ALPHA * hh.x + (acc[i][4 * q + 0] - c128);
        acc[i][4 * q + 1] = ALPHA * hh.y + (acc[i][4 * q + 1] - c128);
        acc[i][4 * q + 2] = ALPHA * hh.z + (acc[i][4 * q + 2] - c128);
        acc[i][4 * q + 3] = ALPHA * hh.w + (acc[i][4 * q + 3] - c128);
        sum += (acc[i][4 * q + 0] + acc[i][4 * q + 1]) + (acc[i][4 * q + 2] + acc[i][4 * q + 3]);
      }
    const float mean = row_sum_f(sum) * (1.0f / D);
    float sq = 0.f;
#pragma unroll
    for (int i = 0; i < 4; ++i)
#pragma unroll
      for (int e = 0; e < 16; ++e) { acc[i][e] -= mean; sq += acc[i][e] * acc[i][e]; }
    const float rstd = rsqrtf(row_sum_f(sq) * (1.0f / D) + LN_EPS);
    if (lane < 16) {
#pragma unroll
      for (int i = 0; i < 4; ++i)
#pragma unroll
        for (int q = 0; q < 4; ++q) {
          const int col = 256 * q + 4 * (16 * i + c);
          const float4 gg = *(const float4*)(a.g2 + col), bb = *(const float4*)(a.b2 + col);
          float4 o;
          o.x = acc[i][4 * q + 0] * rstd * gg.x + bb.x;
          o.y = acc[i][4 * q + 1] * rstd * gg.y + bb.y;
          o.z = acc[i][4 * q + 2] * rstd * gg.z + bb.z;
          o.w = acc[i][4 * q + 3] * rstd * gg.w + bb.w;
          *(float4*)(a.y + (size_t)tok * D + col) = o;
        }
    }
  }
}

__device__ __forceinline__ int unit_row0(int u) { return u < 256 ? (u >> 5) * SEQ + (u & 31) * 64 : NPROMPT + (u - 256) * 64; }

__device__ __forceinline__ void stage_T(char* dst, const bf16_t* __restrict__ src, const float* dec) {
  const int t = opaque_tid(), lane = t & 63, wave = t >> 6, tp = lane & 31;
#pragma unroll
  for (int item = 0; item < 2; ++item) {
    const int fc = (lane >> 5) + 2 * wave + 8 * item;
    const u32x4 a = *(const u32x4*)(src + (size_t)(2 * tp) * PW + fc * 8);
    const u32x4 b = *(const u32x4*)(src + (size_t)(2 * tp + 1) * PW + fc * 8);
    float d0 = 1.f, d1 = 1.f;
    if (dec) { d0 = dec[2 * tp]; d1 = dec[2 * tp + 1]; }
#pragma unroll
    for (int q = 0; q < 4; ++q) {
      uint32_t lo, hi;
      if (dec) {
        lo = pack_bf16(__uint_as_float(a[q] << 16) * d0, __uint_as_float(b[q] << 16) * d1);
        hi = pack_bf16(__uint_as_float(a[q] & 0xffff0000u) * d0, __uint_as_float(b[q] & 0xffff0000u) * d1);
      } else {
        lo = (a[q] & 0xffffu) | (b[q] << 16);
        hi = (a[q] >> 16) | (b[q] & 0xffff0000u);
      }
      const int f = fc * 8 + 2 * q;
      *(uint32_t*)(dst + tile_off(f, tp >> 2) + (tp & 3) * 4) = lo;
      *(uint32_t*)(dst + tile_off(f + 1, tp >> 2) + (tp & 3) * 4) = hi;
    }
  }
}

__device__ __forceinline__ void stage_R(char* dst, const bf16_t* __restrict__ src) {
  const int t = opaque_tid();
#pragma unroll
  for (int i = 0; i < 4; ++i) {
    const int q = t + 256 * i, row = q >> 4, c = q & 15;
    *(u32x4*)(dst + row * 256 + ((c ^ (row & 15)) << 4)) = *(const u32x4*)(src + (size_t)row * PW + c * 8);
  }
}

__device__ __forceinline__ void ret_state_unit(int u, int h, char* smem, const bf16_t* __restrict__ P, bf16_t* __restrict__ ST) {
  const int t = opaque_tid(), lane = t & 63, wave = t >> 6, r = lane & 31, hh = lane >> 5;
  char* RKT = smem;
  char* RVT = smem + 16384;
  float* dec = (float*)(smem + 32768);
  const int row0 = unit_row0(u);
  const float lg2 = log2f(1.0f - exp2f(-5.0f - (float)h));
  __syncthreads();
  if (t < 64) dec[t] = exp2f((float)(63 - t) * lg2);
  __syncthreads();
  stage_T(RKT, P + (size_t)row0 * PW + 1280 + h * 128, dec);
  stage_T(RVT, P + (size_t)row0 * PW + 1792 + h * 128, nullptr);
  __syncthreads();
  f32x16 acc[4];
#pragma unroll
  for (int j = 0; j < 4; ++j)
#pragma unroll
    for (int e = 0; e < 16; ++e) acc[j][e] = 0.f;
#pragma unroll
  for (int ks = 0; ks < 4; ++ks) {
    const bf16x8 af = *(const bf16x8*)(RKT + tile_off(32 * wave + r, 2 * ks + hh));
#pragma unroll
    for (int ej = 0; ej < 4; ++ej) {
      const bf16x8 bfr = *(const bf16x8*)(RVT + tile_off(32 * ej + r, 2 * ks + hh));
      acc[ej] = __builtin_amdgcn_mfma_f32_32x32x16_bf16(af, bfr, acc[ej], 0, 0, 0);
    }
  }
  bf16_t* o = ST + (size_t)(u * 4 + h) * 16384;
#pragma unroll
  for (int ej = 0; ej < 4; ++ej)
#pragma unroll
    for (int g = 0; g < 4; ++g) {
      uint2 w;
      w.x = pack_bf16(acc[ej][4 * g], acc[ej][4 * g + 1]);
      w.y = pack_bf16(acc[ej][4 * g + 2], acc[ej][4 * g + 3]);
      *(uint2*)(o + (32 * ej + r) * 128 + 32 * wave + 8 * g + 4 * hh) = w;
    }
}

__device__ __forceinline__ void unpack4(const uint2 v, float (&f)[4]) {
  f[0] = __uint_as_float(v.x << 16); f[1] = __uint_as_float(v.x & 0xffff0000u); f[2] = __uint_as_float(v.y << 16); f[3] = __uint_as_float(v.y & 0xffff0000u);
}
__device__ __forceinline__ void ret_scan_chain(int ci, const bf16_t* __restrict__ P, const float* __restrict__ state_in, bf16_t* __restrict__ ST, float* __restrict__ out) {
  const int d4 = ci & 31, e = (ci >> 5) & 127, h = (ci >> 12) & 3, b = (ci >> 14) & 7, samp = ci >> 17;
  const float gamma = 1.0f - exp2f(-5.0f - (float)h);
  const float g64 = exp2f(64.0f * log2f(gamma));
  float s[4], av[4];
  if (samp) {
    const bf16_t* ptr = ST + ((size_t)((256 + b) * 4 + h) * 128 + e) * 128 + d4 * 4;
    unpack4(*(const uint2*)ptr, av);
#pragma unroll
    for (int j = 0; j < 4; ++j) {
      const float sv = state_in[((size_t)(b * 4 + h) * 128 + d4 * 4 + j) * 128 + e];
      out[O_RETS + ((size_t)(b * 4 + h) * 128 + d4 * 4 + j) * 128 + e] = g64 * sv + av[j];
    }
    return;
  }
#pragma unroll
  for (int j = 0; j < 4; ++j) s[j] = 0.f;
  for (int k = 0; k < 16; ++k) {
    const bf16_t* pr = P + (size_t)(NTOK + k) * PW;
    const float v = bf2f(pr[1792 + h * 128 + e]);
#pragma unroll
    for (int j = 0; j < 4; ++j) s[j] = gamma * s[j] + bf2f(pr[1280 + h * 128 + d4 * 4 + j]) * v;
  }
  for (int c = 0; c < 32; ++c) {
    bf16_t* ptr = ST + ((size_t)((b * 32 + c) * 4 + h) * 128 + e) * 128 + d4 * 4;
    unpack4(*(const uint2*)ptr, av);
    uint2 w;
    w.x = pack_bf16(s[0], s[1]); w.y = pack_bf16(s[2], s[3]);
    *(uint2*)ptr = w;
#pragma unroll
    for (int j = 0; j < 4; ++j) s[j] = g64 * s[j] + av[j];
  }
#pragma unroll
  for (int j = 0; j < 4; ++j) out[O_RETP + ((size_t)(b * 4 + h) * 128 + d4 * 4 + j) * 128 + e] = s[j];
}

__device__ __forceinline__ void ret_out_unit(int u, int h, char* smem, const bf16_t* __restrict__ P, const bf16_t* __restrict__ Su,
                                             const float* __restrict__ gn_g, bf16_t* __restrict__ mixed) {
  const int t = opaque_tid(), lane = t & 63, wave = t >> 6, r = lane & 31, hh = lane >> 5;
  char* RQ = smem;
  char* RK = smem + 16384;
  char* RVT = smem + 32768;
  char* YL = smem + 49152;
  float* red = (float*)smem;
  const int row0 = unit_row0(u);
  const float lg2 = log2f(1.0f - exp2f(-5.0f - (float)h));
  __syncthreads();
  stage_R(RQ, P + (size_t)row0 * PW + 768 + h * 128);
  stage_R(RK, P + (size_t)row0 * PW + 1280 + h * 128);
  stage_T(RVT, P + (size_t)row0 * PW + 1792 + h * 128, nullptr);
  __syncthreads();
  const int qt = wave & 1, ep = wave >> 1;
  const int q = 32 * qt + r;
  f32x16 X[2];
#pragma unroll
  for (int kt = 0; kt < 2; ++kt) {
#pragma unroll
    for (int e = 0; e < 16; ++e) X[kt][e] = 0.f;
    if (kt <= qt) {
#pragma unroll
      for (int ks = 0; ks < 8; ++ks) {
        const int krow = 32 * kt + r, qrow = 32 * qt + r;
        const bf16x8 kf = *(const bf16x8*)(RK + krow * 256 + (((2 * ks + hh) ^ (krow & 15)) << 4));
        const bf16x8 qf = *(const bf16x8*)(RQ + qrow * 256 + (((2 * ks + hh) ^ (qrow & 15)) << 4));
        X[kt] = __builtin_amdgcn_mfma_f32_32x32x16_bf16(kf, qf, X[kt], 0, 0, 0);
      }
#pragma unroll
      for (int e = 0; e < 16; ++e) {
        const int k = 32 * kt + (e & 3) + 8 * (e >> 2) + 4 * hh;
        X[kt][e] = (q >= k) ? X[kt][e] * exp2f((float)(q - k) * lg2) : 0.f;
      }
    }
  }
  f32x16 O[2];
#pragma unroll
  for (int ei = 0; ei < 2; ++ei) {
#pragma unroll
    for (int e = 0; e < 16; ++e) O[ei][e] = 0.f;
    const int erow = 32 * (2 * ep + ei) + r;
#pragma unroll
    for (int ks = 0; ks < 8; ++ks) {
      const bf16x8 sf = *(const bf16x8*)(Su + erow * 128 + 16 * ks + 8 * hh);
      const int qrow = 32 * qt + r;
      const bf16x8 qf = *(const bf16x8*)(RQ + qrow * 256 + (((2 * ks + hh) ^ (qrow & 15)) << 4));
      O[ei] = __builtin_amdgcn_mfma_f32_32x32x16_bf16(sf, qf, O[ei], 0, 0, 0);
    }
    const float qd = exp2f((float)(q + 1) * lg2);
#pragma unroll
    for (int e = 0; e < 16; ++e) O[ei][e] *= qd;
  }
#pragma unroll
  for (int kt = 0; kt < 2; ++kt) {
    if (kt <= qt) {
#pragma unroll
      for (int sidx = 0; sidx < 2; ++sidx) {
        u32x4 xp;
#pragma unroll
        for (int j = 0; j < 4; ++j) xp[j] = pack_bf16(X[kt][8 * sidx + 2 * j], X[kt][8 * sidx + 2 * j + 1]);
        bf16x8 xf;
        __builtin_memcpy(&xf, &xp, 16);
#pragma unroll
        for (int ei = 0; ei < 2; ++ei) {
          const int erow = 32 * (2 * ep + ei) + r;
          const uint2 a0 = *(const uint2*)(RVT + tile_off(erow, 4 * kt + 2 * sidx) + 8 * hh);
          const uint2 a1 = *(const uint2*)(RVT + tile_off(erow, 4 * kt + 2 * sidx + 1) + 8 * hh);
          u32x4 ap;
          ap[0] = a0.x; ap[1] = a0.y; ap[2] = a1.x; ap[3] = a1.y;
          bf16x8 af;
          __builtin_memcpy(&af, &ap, 16);
          O[ei] = __builtin_amdgcn_mfma_f32_32x32x16_bf16(af, xf, O[ei], 0, 0, 0);
        }
      }
    }
  }
  float s1 = 0.f, s2 = 0.f;
#pragma unroll
  for (int ei = 0; ei < 2; ++ei)
#pragma unroll
    for (int e = 0; e < 16; ++e) { s1 += O[ei][e]; s2 += O[ei][e] * O[ei][e]; }
  s1 += __shfl_xor(s1, 32);
  s2 += __shfl_xor(s2, 32);
  __syncthreads();
  if (hh == 0) { red[(wave * 32 + r) * 2] = s1; red[(wave * 32 + r) * 2 + 1] = s2; }
  __syncthreads();
  {
    const int pw = wave ^ 2;
    s1 += red[(pw * 32 + r) * 2];
    s2 += red[(pw * 32 + r) * 2 + 1];
  }
  const float mean = s1 * (1.0f / 128.0f);
  const float rstd = rsqrtf(fmaxf(s2 * (1.0f / 128.0f) - mean * mean, 0.f) + LN_EPS);
  const bf16_t* rgp = P + (size_t)(row0 + q) * PW + 2304 + h * 128;
#pragma unroll
  for (int ei = 0; ei < 2; ++ei)
#pragma unroll
    for (int g = 0; g < 4; ++g) {
      const int e0 = 32 * (2 * ep + ei) + 8 * g + 4 * hh;
      const uint2 rg = *(const uint2*)(rgp + e0);
      const float4 gg = *(const float4*)(gn_g + h * 128 + e0);
      const float g0 = __uint_as_float(rg.x << 16), g1 = __uint_as_float(rg.x & 0xffff0000u), g2 = __uint_as_float(rg.y << 16), g3 = __uint_as_float(rg.y & 0xffff0000u);
      const float y0 = (O[ei][4 * g + 0] - mean) * rstd * gg.x * (g0 / (1.0f + __expf(-g0)));
      const float y1 = (O[ei][4 * g + 1] - mean) * rstd * gg.y * (g1 / (1.0f + __expf(-g1)));
      const float y2 = (O[ei][4 * g + 2] - mean) * rstd * gg.z * (g2 / (1.0f + __expf(-g2)));
      const float y3 = (O[ei][4 * g + 3] - mean) * rstd * gg.w * (g3 / (1.0f + __expf(-g3)));
      uint2 w;
      w.x = pack_bf16(y0, y1); w.y = pack_bf16(y2, y3);
      const int c = e0 >> 3;
      *(uint2*)(YL + q * 256 + ((c ^ (q & 15)) << 4) + 8 * hh) = w;
    }
  __syncthreads();
#pragma unroll
  for (int i = 0; i < 4; ++i) {
    const int qq = t + 256 * i, row = qq >> 4, c = qq & 15;
    *(u32x4*)(mixed + (size_t)(row0 + row) * D + 512 + h * 128 + c * 8) = *(const u32x4*)(YL + row * 256 + ((c ^ (row & 15)) << 4));
  }
}


constexpr int VT_STRIDE = 456;

struct AttnSrc {
  const bf16_t* P; const float *cmk, *cmv, *csk, *csv;
  int samp, b, c, kvh;
  __device__ __forceinline__ u32x4 load(int kk, int ch, bool isv) const {
    u32x4 z = make_u32x4_zero();
    const bf16_t* src = nullptr;
    const float* fsrc = nullptr;
    const int col = (isv ? 640 : 512) + kvh * 64 + ch * 8;
    if (kk < 16) {
      if (samp) fsrc = (isv ? cmv : cmk) + ((size_t)(b * 16 + kk) * 2 + kvh) * 64 + ch * 8;
      else src = P + (size_t)(NTOK + kk) * PW + col;
    } else if (kk < 208) {
      const int jb = kk - 16;
      if (samp) {
        if (jb < 128) fsrc = (isv ? csv : csk) + ((size_t)(b * 128 + jb) * 2 + kvh) * 64 + ch * 8;
        else src = P + (size_t)(NPROMPT + b * 64 + (jb - 128)) * PW + col;
      } else {
        const int f = (c - 2) * 64 + jb;
        if (f >= 0) src = P + (size_t)(b * SEQ + f) * PW + col;
      }
    }
    if (src) z = *(const u32x4*)src;
    else if (fsrc) {
      const float4 a = *(const float4*)fsrc, bq = *(const float4*)(fsrc + 4);
      z[0] = pack_bf16(a.x, a.y); z[1] = pack_bf16(a.z, a.w); z[2] = pack_bf16(bq.x, bq.y); z[3] = pack_bf16(bq.z, bq.w);
    }
    return z;
  }
};

__device__ __forceinline__ void attn_unit(int u, int kvh, int qt_lo, int qt_hi, char* smem, const bf16_t* __restrict__ P, const float* __restrict__ cmk,
                                          const float* __restrict__ cmv, const float* __restrict__ csk, const float* __restrict__ csv,
                                          const float* __restrict__ rel_bias, const float* __restrict__ sinks, bf16_t* __restrict__ mixed) {
  const int t = opaque_tid(), lane = t & 63, g = t >> 6, r = lane & 31, hh = lane >> 5;
  char* KT = smem;
  char* VT = smem + 28672;
  float* TB = (float*)(smem + 28672 + 64 * VT_STRIDE) + g * 384;
  AttnSrc as;
  as.P = P; as.cmk = cmk; as.cmv = cmv; as.csk = csk; as.csv = csv;
  as.samp = u >= 256; as.b = as.samp ? u - 256 : u >> 5; as.c = as.samp ? 32 : (u & 31); as.kvh = kvh;
  const int H = kvh * 4 + g;
  const int row0 = unit_row0(u);
  __syncthreads();
#pragma unroll
  for (int i = 0; i < 7; ++i) {
    const int qidx = t + 256 * i, key = qidx >> 3, ch = qidx & 7;
    *(u32x4*)(KT + tile_off(key, ch)) = as.load(key, ch, false);
  }
  for (int item = t; item < 896; item += 256) {
    const int fc = item / 112, tp = item - fc * 112;
    const u32x4 a = as.load(2 * tp, fc, true), bq = as.load(2 * tp + 1, fc, true);
#pragma unroll
    for (int q = 0; q < 4; ++q) {
      *(uint32_t*)(VT + (fc * 8 + 2 * q) * VT_STRIDE + tp * 4) = (a[q] & 0xffffu) | (bq[q] << 16);
      *(uint32_t*)(VT + (fc * 8 + 2 * q + 1) * VT_STRIDE + tp * 4) = (a[q] >> 16) | (bq[q] & 0xffff0000u);
    }
  }
  for (int idx = lane; idx < 383; idx += 64) TB[idx] = rel_bias[t5_bucket(idx - 191) * 8 + H];
  __syncthreads();
  const float sink = sinks[H];
#pragma unroll 1
  for (int qt = qt_lo; qt < qt_hi; ++qt) {
    bf16x8 qf[4];
#pragma unroll
    for (int ks = 0; ks < 4; ++ks) qf[ks] = *(const bf16x8*)(P + (size_t)(row0 + 32 * qt + r) * PW + H * 64 + ks * 16 + 8 * hh);
    f32x16 S[7];
#pragma unroll
    for (int kt = 0; kt < 7; ++kt) {
#pragma unroll
      for (int e = 0; e < 16; ++e) S[kt][e] = 0.f;
#pragma unroll
      for (int ks = 0; ks < 4; ++ks) {
        const bf16x8 kf = *(const bf16x8*)(KT + tile_off(32 * kt + r, 2 * ks + hh));
        S[kt] = __builtin_amdgcn_mfma_f32_32x32x16_bf16(kf, qf[ks], S[kt], 0, 0, 0);
      }
    }
    const int i = 32 * qt + r, posq = 16 + as.c * 64 + i;
    float mx = -3.0e38f;
    const float* tbl = TB + (47 - i + 4 * hh);
    const int kmin = as.samp ? 16 : (as.c >= 2 ? 16 : 144 - 64 * as.c);
#pragma unroll
    for (int kt = 0; kt < 7; ++kt)
#pragma unroll
      for (int e = 0; e < 16; ++e) {
        const int kb = 32 * kt + (e & 3) + 8 * (e >> 2);
        float sv;
        if (kb < 16) {
          const int rel = kb + 4 * hh - posq;
          sv = S[kt][e] * 0.125f + TB[(rel < -191 ? -191 : rel) + 191];
        } else if (kb >= 208) {
          sv = -1.0e30f;
        } else {
          const float bv = tbl[kb];
          sv = (kb >= kmin) ? S[kt][e] * 0.125f + bv : -1.0e30f;
        }
        S[kt][e] = sv;
        mx = fmaxf(mx, sv);
        if (e == 15) __builtin_amdgcn_sched_barrier(0);
      }
    mx = fmaxf(mx, __shfl_xor(mx, 32));
    const float m = fmaxf(mx, sink);
    float ls = 0.f;
#pragma unroll
    for (int kt = 0; kt < 7; ++kt)
#pragma unroll
      for (int e = 0; e < 16; ++e) {
        const float pv = __expf(S[kt][e] - m);
        S[kt][e] = pv;
        ls += pv;
        if (e == 15) __builtin_amdgcn_sched_barrier(0);
      }
    ls += __shfl_xor(ls, 32);
    const float inv = 1.0f / (ls + __expf(sink - m));
    f32x16 O[2];
#pragma unroll
    for (int dt = 0; dt < 2; ++dt)
#pragma unroll
      for (int e = 0; e < 16; ++e) O[dt][e] = 0.f;
#pragma unroll
    for (int kt = 0; kt < 7; ++kt)
#pragma unroll
      for (int sidx = 0; sidx < 2; ++sidx) {
        u32x4 xp;
#pragma unroll
        for (int j = 0; j < 4; ++j) xp[j] = pack_bf16(S[kt][8 * sidx + 2 * j], S[kt][8 * sidx + 2 * j + 1]);
        bf16x8 xf;
        __builtin_memcpy(&xf, &xp, 16);
#pragma unroll
        for (int dt = 0; dt < 2; ++dt) {
          const char* vp = VT + (32 * dt + r) * VT_STRIDE + (32 * kt + 16 * sidx + 4 * hh) * 2;
          const uint2 a0 = *(const uint2*)vp, a1 = *(const uint2*)(vp + 16);
          u32x4 ap;
          ap[0] = a0.x; ap[1] = a0.y; ap[2] = a1.x; ap[3] = a1.y;
          bf16x8 af;
          __builtin_memcpy(&af, &ap, 16);
          O[dt] = __builtin_amdgcn_mfma_f32_32x32x16_bf16(af, xf, O[dt], 0, 0, 0);
        }
      }
    bf16_t* op = mixed + (size_t)(row0 + i) * D + H * 64 + 4 * hh;
#pragma unroll
    for (int dt = 0; dt < 2; ++dt)
#pragma unroll
      for (int g4 = 0; g4 < 4; ++g4) {
        uint2 w;
        w.x = pack_bf16(O[dt][4 * g4] * inv, O[dt][4 * g4 + 1] * inv);
        w.y = pack_bf16(O[dt][4 * g4 + 2] * inv, O[dt][4 * g4 + 3] * inv);
        *(uint2*)(op + 32 * dt + 8 * g4) = w;
      }
  }
}


#define XB_TMO      128
#define XB_XCNT(j)  (256  + 64 * (j))
#define XB_XSUB(j)  (1280 + 64 * (j))
#define XB_XGEN(j)  (2304 + 64 * (j))
#define XB_TOP      3328
#define XB_TOPGEN   3392
#define XCD_BAR_WORDS 3456
#define XB_SPIN_CAP (1u << 18)
#define LAS __attribute__((address_space(3)))
__device__ __forceinline__ unsigned xb_ld(unsigned* p)              { return __hip_atomic_load(p, __ATOMIC_RELAXED, __HIP_MEMORY_SCOPE_AGENT); }
__device__ __forceinline__ unsigned xb_add(unsigned* p, unsigned v) { return __hip_atomic_fetch_add(p, v, __ATOMIC_RELAXED, __HIP_MEMORY_SCOPE_AGENT); }
__device__ __forceinline__ unsigned xb_xcc_id() { return (unsigned)__builtin_amdgcn_s_getreg((3 << 11) | 20) & 0xFu; }
#define XB_SPIN(cond, bar) do { unsigned _sp = 0; while (cond) { __builtin_amdgcn_s_sleep(1); \
    if ((++_sp & 255u) == 0u) { if (xb_ld(&(bar)[XB_TMO])) break; if (_sp > XB_SPIN_CAP) { atomicAdd(&(bar)[XB_TMO], 1u); break; } } } } while (0)
struct XcdBarrier { unsigned* bar; unsigned x; volatile LAS unsigned* st; };
__device__ __forceinline__ XcdBarrier xcd_barrier_post(unsigned* bar, volatile LAS unsigned* st) {
  XcdBarrier b; b.bar = bar; b.x = xb_xcc_id(); b.st = st;
  if (threadIdx.x == 0) (void)xb_add(&bar[XB_XCNT(b.x)], 1u);
  return b;
}
__device__ __forceinline__ void xcd_barrier_complete(unsigned* bar, unsigned x, unsigned& nloc, unsigned& nx) {
  const unsigned G = gridDim.x * gridDim.y * gridDim.z;
  unsigned sum, cnt, mine, sp = 0u;
  for (;;) {
    sum = 0u; cnt = 0u; mine = 0u;
#pragma unroll
    for (unsigned j = 0; j < 16; ++j) { const unsigned c = xb_ld(&bar[XB_XCNT(j)]); sum += c; cnt += (c > 0u) ? 1u : 0u; mine = (j == x) ? c : mine; }
    if (sum == G) break;
    __builtin_amdgcn_s_sleep(1);
    if ((++sp & 255u) == 0u) { if (xb_ld(&bar[XB_TMO])) break; if (sp > XB_SPIN_CAP) { atomicAdd(&bar[XB_TMO], 1u); break; } }
  }
  nloc = mine > 0u ? mine : 1u; nx = cnt > 0u ? cnt : 1u;
}
__device__ __forceinline__ void xcd_barrier(const XcdBarrier& b) {
  asm volatile("s_waitcnt vmcnt(0)" ::: "memory");
  __syncthreads();
  if (threadIdx.x == 0) {
    unsigned* bar = b.bar;
    __builtin_amdgcn_s_waitcnt(0);
    unsigned nloc = b.st[0], nx = b.st[1];
    if (nloc == 0u) { xcd_barrier_complete(bar, b.x, nloc, nx); b.st[0] = nloc; b.st[1] = nx; }
    const unsigned old = xb_add(&bar[XB_XSUB(b.x)], 1u);
    const unsigned gen = old / nloc;
    if (old + 1u == (gen + 1u) * nloc) {
      __builtin_amdgcn_fence(__ATOMIC_RELEASE, "agent");
      asm volatile("s_waitcnt vmcnt(0)" ::: "memory");
      const unsigned og = xb_add(&bar[XB_TOP], 1u);
      const unsigned tg = og / nx;
      if (og + 1u == (tg + 1u) * nx) xb_add(&bar[XB_TOPGEN], 1u);
      else XB_SPIN(xb_ld(&bar[XB_TOPGEN]) == tg, bar);
      __builtin_amdgcn_fence(__ATOMIC_ACQUIRE, "agent");
      xb_add(&bar[XB_XGEN(b.x)], 1u);
      asm volatile("s_waitcnt vmcnt(0)" ::: "memory");
    } else {
      XB_SPIN(xb_ld(&bar[XB_XGEN(b.x)]) == gen, bar);
      __builtin_amdgcn_fence(__ATOMIC_ACQUIRE, "agent");
      asm volatile("s_waitcnt vmcnt(0)" ::: "memory");
    }
  }
  __syncthreads();
}

struct Params {
  const float *x_prompt, *x_sample, *cmk, *cmv, *csk, *csv, *state_ret, *meta_tokens, *ln_in_g, *ln_in_b, *rel_bias, *w_in,
      *w_out, *sinks, *gn_g, *ln1_g, *ln1_b, *peer_wq, *subk, *peer_u, *peer_v, *ln2_g, *ln2_b;
  float* out;
  char* ws;
};

#ifndef PHASE_MASK
#define PHASE_MASK 0x1ff
#endif
#ifndef PHASE_TWICE
#define PHASE_TWICE 0
#endif
#define PH_ON(n) (((PHASE_MASK) >> (n)) & 1)
#define PH_REP(n) for (int rep_ = 0; rep_ < 1 + (((PHASE_TWICE) >> (n)) & 1); ++rep_)

__global__ void __launch_bounds__(256, 2) mega_kernel(Params p) {
  __shared__ __attribute__((aligned(16))) char smem[73728 + 16];
  if (threadIdx.x < 4) ((unsigned*)(smem + 73728))[threadIdx.x] = 0u;
  __syncthreads();
  const XcdBarrier xb = xcd_barrier_post((unsigned*)(p.ws + W_BAR), (volatile LAS unsigned*)(smem + 73728));
  const int G = gridDim.x, bid = blockIdx.x;
  bf16_t* hbf = (bf16_t*)(p.ws + W_HBF);
  bf16_t* P = (bf16_t*)(p.ws + W_P);
  bf16_t* z = (bf16_t*)(p.ws + W_P);
  bf16_t* mixed = (bf16_t*)(p.ws + W_MIXED);
  int* lidx = (int*)(p.ws + W_LIDX);
  float* lgate = (float*)(p.ws + W_LGATE);
  bf16_t* wt_in = (bf16_t*)(p.ws + W_WTIN);
  bf16_t* wt_out = (bf16_t*)(p.ws + W_WTOUT);
  bf16_t* wt_q = (bf16_t*)(p.ws + W_WTQ);
  float2* rope = (float2*)(p.ws + W_ROPE);
  bf16_t* h1bf = mixed;
  uint8_t* U8 = (uint8_t*)(p.ws + W_U8);
  uint8_t* V8 = (uint8_t*)(p.ws + W_U8) + 1024;
  float* su = (float*)(p.ws + W_SU);
  float* sv = (float*)(p.ws + W_SV);
  uint8_t* xq = (uint8_t*)(p.ws + W_XQ);
  bf16_t* subk_bf = (bf16_t*)(p.ws + W_SUBK);
  float* xs = (float*)(p.ws + W_XS);
  bf16_t* ST = (bf16_t*)p.out;
  bf16_t* STs = (bf16_t*)(p.ws + W_LIDX);
  const int nw = blockDim.x >> 6, W = G * nw;

  if (PH_ON(0)) PH_REP(0) {
    const int lane = opaque_tid() & 63, gw = bid * nw + (opaque_tid() >> 6);
    {
      int r = gw;
      for (; r + 3 * W < NROWS; r += 4 * W) { const int rows[4] = {r, r + W, r + 2 * W, r + 3 * W}; ln_in_rows<4>(rows, lane, p.x_prompt, p.x_sample, p.meta_tokens, p.ln_in_g, p.ln_in_b, hbf); }
      for (; r < NROWS; r += W) { const int rows[1] = {r}; ln_in_rows<1>(rows, lane, p.x_prompt, p.x_sample, p.meta_tokens, p.ln_in_g, p.ln_in_b, hbf); }
    }
    for (int u = bid; u < 704; u += G) transpose_tile(u % 16, u / 16, smem, p.w_in, PW, D, wt_in);
    for (int idx = bid * 256 + opaque_tid(); idx < 2128 * 64; idx += G * 256) {
      const int pos = idx >> 6, d = idx & 63;
      const float inv = powf(10000.0f, -(float)d / 64.0f);
      float sn, cs;
      sincosf((float)pos * inv, &sn, &cs);
      rope[idx] = make_float2(cs, sn);
    }
  }
  xcd_barrier(xb);
#ifdef PROBE_GEMM
  for (int u = bid; u < 22 * 133; u += G) gemm_mfma_tile_v<PROBE_GEMM>(u / 22, u % 22, smem, hbf, NROWS, wt_in, D, EpiInProjM{P, p.out, rope});
#endif
  if (PH_ON(1)) PH_REP(1)
  {
    const int lane = opaque_tid() & 63, gw = bid * nw + (opaque_tid() >> 6);
    int qr = gw;
    for (int u0 = bid; u0 < ((22 * 67 + G - 1) / G) * G; u0 += G) {
      const int u = (u0 - bid) + ((G & 7) == 0 ? (bid & 7) * (G >> 3) + (bid >> 3) : bid);
      if (u >= 22 * 67) continue;
      gemm_mfma_tile_m256(u / 22, u % 22, smem, hbf, NROWS, wt_in, D, EpiInProjM{P, p.out, rope});
      for (int it = 0; it < 6 && qr < 32768; ++it, qr += W) {
        if (qr < 16384) quant_table_row(p.peer_u + (size_t)qr * D, lane, U8 + (size_t)qr * 2048, su + qr, false);
        else quant_table_row(p.peer_v + (size_t)(qr - 16384) * D, lane, V8 + (size_t)(qr - 16384) * 2048, sv + (qr - 16384), true);
      }
    }
    for (; qr < 32768; qr += W) {
      if (qr < 16384) quant_table_row(p.peer_u + (size_t)qr * D, lane, U8 + (size_t)qr * 2048, su + qr, false);
      else quant_table_row(p.peer_v + (size_t)(qr - 16384) * D, lane, V8 + (size_t)(qr - 16384) * 2048, sv + (qr - 16384), true);
    }
  }
  xcd_barrier(xb);
  if (PH_ON(2)) PH_REP(2)
    for (int u = bid; u < 1056; u += G) ret_state_unit(u >> 2, u & 3, smem, P, ST);
  for (int idx = bid * 256 + opaque_tid(); idx < 32 * 16384; idx += G * 256) {
    const int d = idx & 127, e = (idx >> 7) & 127, bh = idx >> 14;
    STs[idx] = f2bf(p.state_ret[((size_t)bh * 128 + d) * 128 + e]);
  }
  xcd_barrier(xb);
#ifdef PROBE_ATTN
  for (int rep = 0; rep < PROBE_ATTN; ++rep)
    for (int u = bid; u < 528; u += G) attn_unit(u >> 1, u & 1, 0, 2, smem, P, p.cmk, p.cmv, p.csk, p.csv, p.rel_bias, p.sinks, mixed);
  xcd_barrier(xb);
#endif
  if (PH_ON(3)) {
    const int lane = opaque_tid() & 63, gw = bid * nw + (opaque_tid() >> 6);
    const bool attn_first = (bid & 1) != 0;
    for (int half = 0; half < 2; ++half) {
      if ((half == 0) == attn_first) {
        for (int u = G - 1 - bid; u < 32; u += G) ret_out_unit(256 + (u >> 2), u & 3, smem, P, STs + (size_t)u * 16384, p.gn_g, mixed);
        for (int u = bid; u < 512 + 32; u += G) {
          if (u < 512) attn_unit(u >> 1, u & 1, 0, 2, smem, P, p.cmk, p.cmv, p.csk, p.csv, p.rel_bias, p.sinks, mixed);
          else { const int v = u - 512; attn_unit(256 + (v >> 2), (v >> 1) & 1, v & 1, (v & 1) + 1, smem, P, p.cmk, p.cmv, p.csk, p.csv, p.rel_bias, p.sinks, mixed); }
        }
      } else {
        for (int ci = bid * 256 + opaque_tid(); ci < 262144; ci += G * 256) ret_scan_chain(ci, P, p.state_ret, ST, p.out);
        for (int u = bid; u < 512; u += G) {
          if (u < 256) transpose_tile(u % 16, u / 16, smem, p.w_out, D, D, wt_out);
          else transpose_tile((u - 256) % 16, (u - 256) / 16, smem, p.peer_wq, D, D, wt_q);
        }
        for (int idx = bid * 256 + opaque_tid(); idx < 131072; idx += G * 256) subk_bf[idx] = f2bf(p.subk[idx]);
      }
    }
  }
  xcd_barrier(xb);
  if (PH_ON(4)) PH_REP(4)
    for (int u = bid; u < 1024; u += G) ret_out_unit(u >> 2, u & 3, smem, P, ST + (size_t)u * 16384, p.gn_g, mixed);
  xcd_barrier(xb);
  if (PH_ON(5)) PH_REP(5)
    for (int u0 = bid; u0 < ((8 * 132 + G - 1) / G) * G; u0 += G) {
      const int u = (u0 - bid) + ((G & 7) == 0 ? (bid & 7) * (G >> 3) + (bid >> 3) : bid);
      if (u >= 8 * 132) continue;
      gemm_mfma_tile(u / 8, u % 8, smem, mixed, NTOK, wt_out, D, EpiOutProjM{hbf, z});
    }
  xcd_barrier(xb);
  if (PH_ON(6)) {
    const int lane = opaque_tid() & 63, gw = bid * nw + (opaque_tid() >> 6);
    int r = gw;
    for (; r + 3 * W < NTOK; r += 4 * W) { const int rows[4] = {r, r + W, r + 2 * W, r + 3 * W}; ln1_rows<4>(rows, lane, z, p.ln1_g, p.ln1_b, h1bf, xq, xs); }
    for (; r < NTOK; r += W) { const int rows[1] = {r}; ln1_rows<1>(rows, lane, z, p.ln1_g, p.ln1_b, h1bf, xq, xs); }
  }
  xcd_barrier(xb);
#ifdef PROBE_PQ
  for (int u = bid; u < 8 * 132; u += G) gemm_mfma_tile_v<PROBE_PQ>(u / 8, u % 8, smem, h1bf, NTOK, wt_q, D, EpiTopK{subk_bf, lidx, lgate});
#endif
  if (PH_ON(7)) PH_REP(7)
    for (int u0 = bid; u0 < ((8 * 132 + G - 1) / G) * G; u0 += G) {
      const int u = (u0 - bid) + ((G & 7) == 0 ? (bid & 7) * (G >> 3) + (bid >> 3) : bid);
      if (u >= 8 * 132) continue;
      gemm_mfma_tile(u / 8, u % 8, smem, h1bf, NTOK, wt_q, D, EpiTopK{subk_bf, lidx, lgate});
    }
  xcd_barrier(xb);
  if (PH_ON(8)) PH_REP(8) {
    const int lane = opaque_tid() & 63, wave = opaque_tid() >> 6, gw = bid * nw + wave;
    const SweepArgs sa{lidx, lgate, U8, V8, su, sv, xq, xs, h1bf, p.ln2_g, p.ln2_b, p.out};
    const int TPP = W * 4;
    const int NPF = NTOK / TPP;
    for (int pass = 0; pass < NPF; ++pass)
      sweep_groups<false>(pass * TPP + gw * 4, lane, smem + wave * SG_LDS_PER_WAVE, sa);
#ifdef PROBE_SG
    {
#ifdef PROBE_PACE
      const unsigned long long tstart = __builtin_amdgcn_s_memrealtime();
      for (int pass = 0; pass < NPF; ++pass)
        sweep_groups<true>(pass * TPP + gw * 4, lane, smem + wave * SG_LDS_PER_WAVE, sa, 0, tstart + 1500ull + (unsigned long long)pass * (175ull * PROBE_PACE + 1500ull), PROBE_PACE);
#else
      for (int pass = 0; pass < NPF; ++pass)
#ifdef PROBE_ROT
        sweep_groups<true>(pass * TPP + gw * 4, lane, smem + wave * SG_LDS_PER_WAVE, sa, (int)(xb_xcc_id() & 7u) * PROBE_ROT);
#else
        sweep_groups<true>(pass * TPP + gw * 4, lane, smem + wave * SG_LDS_PER_WAVE, sa);
#endif
#endif
    }
#endif
    for (int tk = NPF * TPP + bid; tk < NTOK; tk += G)
      sweep_mini(tk, lane, wave, smem, sa);
  }
#ifdef PROBE_SYNCS
  for (int i = 0; i < PROBE_SYNCS; ++i) xcd_barrier(xb);
#endif
}

}

extern "C" void kernel_launch(void* const* d_in, const int* in_sizes, int n_in, void* d_out, int out_size, void* d_ws,
                              size_t ws_size, hipStream_t stream) {
  static int grid_blocks = 0;
  if (!grid_blocks) {
    int dev = 0, cus = 0, per_cu = 0;
    (void)hipGetDevice(&dev);
    (void)hipDeviceGetAttribute(&cus, hipDeviceAttributeMultiprocessorCount, dev);
    (void)hipOccupancyMaxActiveBlocksPerMultiprocessor(&per_cu, mega_kernel, 256, 0);
    if (per_cu > 2) per_cu = 2;
    if (per_cu < 1) per_cu = 1;
    grid_blocks = cus * per_cu;
  }
  Params p{};
  const float** pp = (const float**)&p;
  for (int i = 0; i < 23; ++i) pp[i] = (const float*)d_in[i];
  p.out = (float*)d_out;
  p.ws = (char*)d_ws;
  void* args[] = {&p};
  (void)hipMemsetAsync((char*)d_ws + W_BAR, 0, 3456 * 4, stream);
  hipError_t e = hipLaunchCooperativeKernel((void*)mega_kernel, dim3(grid_blocks), dim3(256), args, 0, stream);
  if (e != hipSuccess) fprintf(stderr, "cooperative launch failed: %s (grid %d)\n", hipGetErrorString(e), grid_blocks);
}
```
